# Optimizing an MI355X kernel written in HIP

```python
import jax, jax.numpy as jnp
from jax import lax
import numpy as np

D_MODEL = 1024
BATCH = 8
SEQ = 8192
DEPTH = 4

N_MIXERS = 2
N_LRU_LAYERS = (DEPTH + N_MIXERS - 1) // N_MIXERS
N_ATTN_LAYERS = DEPTH // N_MIXERS
N_META = 16
GRID_W = 64
RMS_EPS = 1e-6

D_RNN = D_MODEL
LRU_BLOCKS = 8
LRU_BLOCK_W = D_RNN // LRU_BLOCKS
CONV_W = 4
CONV_PAD_LEFT = 2
LRU_C = 8.0

HEAD_DIM = 128
N_HEADS = D_MODEL // HEAD_DIM
N_KV_HEADS = 2
GQA_GROUP = N_HEADS // N_KV_HEADS
ROPE_AXIS_DIM = HEAD_DIM // 2
ROPE_PAIRS = ROPE_AXIS_DIM // 2
ROPE_THETA = 10000.0
Q_BLOCK = 128
QKV_DIM = (N_HEADS + 2 * N_KV_HEADS) * HEAD_DIM

D_FF = -(-(8 * D_MODEL) // (3 * 256)) * 256

kernel_name = "bidir_hybrid_rglru_axial_gqa_swiglu"


def _rmsnorm(x, g):
    xf = x.astype(jnp.float32)
    y = xf * lax.rsqrt(jnp.mean(xf * xf, axis=-1, keepdims=True) + RMS_EPS)
    return (y * g.astype(jnp.float32)).astype(x.dtype)


def _linear_scan(a, b):
    def combine(left, right):
        a_l, b_l = left
        a_r, b_r = right
        return a_l * a_r, a_r * b_l + b_r
    _, h = lax.associative_scan(combine, (a, b), axis=1)
    return h


def _rglru_direction(u, gate_w, gate_b, lam):
    B, L, _ = u.shape
    ub = u.reshape(B, L, LRU_BLOCKS, LRU_BLOCK_W)
    g = jnp.einsum('blnc,gncd->gblnd', ub, gate_w).reshape(2, B, L, D_RNN)
    g = jax.nn.sigmoid(g.astype(jnp.float32) + gate_b.astype(jnp.float32)[:, None, None, :])
    r, i = g[0], g[1]
    log_a = -LRU_C * r * jax.nn.softplus(-lam.astype(jnp.float32))
    a = jnp.exp(log_a)
    b = jnp.sqrt(-jnp.expm1(2.0 * log_a)) * (i * u.astype(jnp.float32))
    return _linear_scan(a, b)


def _rglru_mixer(h, w_in, conv_w, conv_b, gate_w, gate_b, lam, w_out):
    L = h.shape[1]
    proj = h @ w_in
    y_branch = jax.nn.gelu(proj[..., :D_RNN])
    x_branch = proj[..., D_RNN:]
    xp = jnp.pad(x_branch, ((0, 0), (CONV_PAD_LEFT, CONV_W - 1 - CONV_PAD_LEFT), (0, 0)))
    xc = conv_b
    for k in range(CONV_W):
        xc = xc + xp[:, k:k + L] * conv_w[k]
    fwd = _rglru_direction(xc, gate_w[0], gate_b[0], lam[0])
    bwd = jnp.flip(_rglru_direction(jnp.flip(xc, axis=1), gate_w[1], gate_b[1], lam[1]), axis=1)
    rec = (fwd + bwd).astype(h.dtype)
    return (rec * y_branch) @ w_out


def _axial_rope_angles(n_tokens):
    rows = n_tokens // GRID_W
    inv_freq = ROPE_THETA ** (-jnp.arange(0, ROPE_AXIS_DIM, 2, dtype=jnp.float32) / ROPE_AXIS_DIM)
    ang_r = jnp.arange(rows, dtype=jnp.float32)[:, None] * inv_freq
    ang_c = jnp.arange(GRID_W, dtype=jnp.float32)[:, None] * inv_freq
    ang = jnp.stack([jnp.broadcast_to(ang_r[:, None, :], (rows, GRID_W, ROPE_PAIRS)),
                     jnp.broadcast_to(ang_c[None, :, :], (rows, GRID_W, ROPE_PAIRS))], axis=2)
    ang = ang.reshape(rows * GRID_W, 2, ROPE_PAIRS)
    ang = jnp.concatenate([jnp.zeros((N_META, 2, ROPE_PAIRS), jnp.float32), ang], axis=0)
    return jnp.cos(ang), jnp.sin(ang)


def _apply_rope(x, cos, sin):
    xs = x.reshape(*x.shape[:-1], 2, 2, ROPE_PAIRS)
    x1, x2 = xs[..., 0, :], xs[..., 1, :]
    c = cos.astype(x.dtype)[None, :, None]
    s = sin.astype(x.dtype)[None, :, None]
    out = jnp.stack([x1 * c - x2 * s, x2 * c + x1 * s], axis=-2)
    return out.reshape(x.shape)


def _attn_block(qb, k, v):
    s = jnp.einsum('bqkgd,bskd->bkgqs', qb, k).astype(jnp.float32)
    p = jax.nn.softmax(s, axis=-1).astype(v.dtype)
    return jnp.einsum('bkgqs,bskd->bqkgd', p, v)


def _attention_mixer(h, w_qkv, q_gain, k_gain, w_out, cos, sin):
    B, L, _ = h.shape
    qkv = h @ w_qkv
    q = qkv[..., :N_HEADS * HEAD_DIM].reshape(B, L, N_HEADS, HEAD_DIM)
    k = qkv[..., N_HEADS * HEAD_DIM:(N_HEADS + N_KV_HEADS) * HEAD_DIM].reshape(B, L, N_KV_HEADS, HEAD_DIM)
    v = qkv[..., (N_HEADS + N_KV_HEADS) * HEAD_DIM:].reshape(B, L, N_KV_HEADS, HEAD_DIM)
    q = _apply_rope(_rmsnorm(q, q_gain), cos, sin) * (HEAD_DIM ** -0.5)
    k = _apply_rope(_rmsnorm(k, k_gain), cos, sin)
    q = q.reshape(B, L, N_KV_HEADS, GQA_GROUP, HEAD_DIM)
    out_meta = _attn_block(q[:, :N_META], k, v)
    n_blk = (L - N_META) // Q_BLOCK
    q_real = q[:, N_META:].reshape(B, n_blk, Q_BLOCK, N_KV_HEADS, GQA_GROUP, HEAD_DIM)
    q_real = q_real.transpose(1, 0, 2, 3, 4, 5)
    out_real = lax.map(lambda qb: _attn_block(qb, k, v), q_real)
    out_real = out_real.transpose(1, 0, 2, 3, 4, 5).reshape(B, L - N_META, N_KV_HEADS, GQA_GROUP, HEAD_DIM)
    o = jnp.concatenate([out_meta, out_real], axis=1).reshape(B, L, N_HEADS * HEAD_DIM)
    return o @ w_out


def _swiglu(h, w_in, w_out):
    gu = h @ w_in
    return (jax.nn.silu(gu[..., :D_FF]) * gu[..., D_FF:]) @ w_out


def setup_inputs(seed: int = 0) -> dict:
    key = jax.random.key(seed)
    ks = jax.random.split(key, 18)
    f32 = jnp.float32
    nrm = lambda k, shape, fan_in: jax.random.normal(k, shape, f32) * (fan_in ** -0.5)
    x = jax.random.normal(ks[0], (BATCH, SEQ, D_MODEL), f32)
    meta_tokens = jax.random.normal(ks[1], (N_META, D_MODEL), f32)
    norm_gains = 1.0 + 0.02 * jax.random.normal(ks[2], (DEPTH, 4, D_MODEL), f32)
    lru_w_in = nrm(ks[3], (N_LRU_LAYERS, D_MODEL, 2 * D_RNN), D_MODEL)
    lru_conv_w = nrm(ks[4], (N_LRU_LAYERS, CONV_W, D_RNN), CONV_W)
    lru_conv_b = 0.01 * jax.random.normal(ks[5], (N_LRU_LAYERS, D_RNN), f32)
    lru_gate_w = nrm(ks[6], (N_LRU_LAYERS, 2, 2, LRU_BLOCKS, LRU_BLOCK_W, LRU_BLOCK_W), LRU_BLOCK_W)
    lru_gate_b = 0.01 * jax.random.normal(ks[7], (N_LRU_LAYERS, 2, 2, D_RNN), f32)
    a_c = jax.random.uniform(ks[8], (N_LRU_LAYERS, 2, D_RNN), f32, 0.9, 0.999)
    s = a_c ** (1.0 / LRU_C)
    lru_lambda = jnp.log(s) - jnp.log1p(-s)
    lru_w_out = nrm(ks[9], (N_LRU_LAYERS, D_RNN, D_MODEL), D_RNN)
    attn_w_qkv = nrm(ks[10], (N_ATTN_LAYERS, D_MODEL, QKV_DIM), D_MODEL)
    attn_q_gain = 1.0 + 0.02 * jax.random.normal(ks[11], (N_ATTN_LAYERS, HEAD_DIM), f32)
    attn_k_gain = 1.0 + 0.02 * jax.random.normal(ks[12], (N_ATTN_LAYERS, HEAD_DIM), f32)
    attn_w_out = nrm(ks[13], (N_ATTN_LAYERS, N_HEADS * HEAD_DIM, D_MODEL), N_HEADS * HEAD_DIM)
    ffn_w_in = nrm(ks[14], (DEPTH, D_MODEL, 2 * D_FF), D_MODEL)
    ffn_w_out = nrm(ks[15], (DEPTH, D_FF, D_MODEL), D_FF)
    return {"x": x, "meta_tokens": meta_tokens, "norm_gains": norm_gains,
            "lru_w_in": lru_w_in, "lru_conv_w": lru_conv_w, "lru_conv_b": lru_conv_b,
            "lru_gate_w": lru_gate_w, "lru_gate_b": lru_gate_b, "lru_lambda": lru_lambda,
            "lru_w_out": lru_w_out, "attn_w_qkv": attn_w_qkv, "attn_q_gain": attn_q_gain,
            "attn_k_gain": attn_k_gain, "attn_w_out": attn_w_out,
            "ffn_w_in": ffn_w_in, "ffn_w_out": ffn_w_out}


def reference(x, meta_tokens, norm_gains, lru_w_in, lru_conv_w, lru_conv_b, lru_gate_w,
              lru_gate_b, lru_lambda, lru_w_out, attn_w_qkv, attn_q_gain, attn_k_gain,
              attn_w_out, ffn_w_in, ffn_w_out):
    B, S, _ = x.shape
    meta = jnp.broadcast_to(meta_tokens.astype(x.dtype)[None], (B, N_META, D_MODEL))
    h = jnp.concatenate([meta, x], axis=1)
    cos, sin = _axial_rope_angles(S)
    for layer in range(DEPTH):
        g = norm_gains[layer]
        slot = layer // N_MIXERS
        u = _rmsnorm(h, g[0])
        if layer % N_MIXERS == 0:
            m = _rglru_mixer(u, lru_w_in[slot], lru_conv_w[slot], lru_conv_b[slot],
                             lru_gate_w[slot], lru_gate_b[slot], lru_lambda[slot], lru_w_out[slot])
        else:
            m = _attention_mixer(u, attn_w_qkv[slot], attn_q_gain[slot], attn_k_gain[slot],
                                 attn_w_out[slot], cos, sin)
        h = h + _rmsnorm(m, g[1])
        u = _rmsnorm(h, g[2])
        h = h + _rmsnorm(_swiglu(u, ffn_w_in[layer], ffn_w_out[layer]), g[3])
    return h[:, N_META:]
```

```cpp
#include <hip/hip_runtime.h>
#include <hip/hip_bf16.h>
#include <hip/hip_cooperative_groups.h>
#include <cstdio>
#include <cstdint>
#include <cmath>
namespace cg = cooperative_groups;

#define PG8_ROWS_VALID 65664
namespace pg8 {
#define PG8_LAS __attribute__((address_space(3)))
typedef unsigned short bf16_t;
typedef short bf16x8 __attribute__((ext_vector_type(8)));
typedef float f32x4 __attribute__((ext_vector_type(4)));
typedef unsigned u32x4 __attribute__((ext_vector_type(4)));
constexpr int BM = 256, BK = 64, HALF = 128, HTB = HALF * BK * 2  , STAGE_BYTES = 8 * HTB, NXCD = 8, WGM = 8;

__host__ __device__ __forceinline__ int lds_byte(int r, int c) { const int st = (r >> 4) * 2 + (c >> 5), rr = r & 15, cc = c & 31, ob = rr * 64 + cc * 2; return st * 1024 + (ob ^ (((ob >> 9) & 1) << 5)); }
__host__ __device__ __forceinline__ void stage_rc(int b, int& R, int& C) { const int st = b / 1024, sb = b % 1024, swz = sb ^ (((sb >> 9) & 1) << 5); R = (st >> 1) * 16 + swz / 64; C = (st & 1) * 32 + (swz % 64) / 2; }
__host__ __device__ __forceinline__ int perm32(int rho) { const int n = rho >> 4, i = rho & 15; return 8 * (i >> 2) + 4 * n + (i & 3); }

struct Unit { int pm, pn, k0, nt, part; };
struct Gemm { const bf16_t* A; const bf16_t* Bt; int M, N, K; };

struct StaticOrder {
    int nM, nN, nwg, G, c, ntail, ntK, S;
    __host__ __device__ void init(int M, int N, int K, int G_, int c_, bool with_tail = true, int S_ = 1) { nM = M / BM - 1; nN = N / BM; nwg = nM * nN; G = G_; c = c_; ntK = K / BK; S = S_; ntail = with_tail ? nN * S : 0; }
    __host__ __device__ bool next(int i, Unit& u) const {
        const long L = (long)i * G + c; if (L >= nwg + ntail) return false;
        u.k0 = 0; u.nt = ntK; u.part = 0;
        if (L >= nwg) { const int j = (int)(L - nwg); u.pm = nM; u.pn = j / S; const int p = j % S; u.part = p;
            if (S > 1) { const int pairs = ntK / 2, q = pairs / S, r = pairs % S; u.nt = 2 * (q + (p < r ? 1 : 0)); u.k0 = 2 * (p * q + (p < r ? p : r)); }
            return true; }
        int wgid = (int)L; { const int q = nwg / NXCD, r = nwg % NXCD, xcd = wgid % NXCD, off = wgid / NXCD; wgid = (xcd < r ? xcd * (q + 1) : r * (q + 1) + (xcd - r) * q) + off; }
        const int nig = WGM * nN, gid = wgid / nig, fm = gid * WGM, gsz = (nM - fm) < WGM ? (nM - fm) : WGM;
        u.pm = fm + ((wgid % nig) % gsz); u.pn = (wgid % nig) / gsz; return true;
    }
    __device__ __forceinline__ void a_ready(const Unit&) const {}
    __device__ __forceinline__ void done(const Unit&) const {}
};

__device__ __forceinline__ unsigned cvt_pk_bf16(float lo, float hi) { unsigned r; asm volatile("v_cvt_pk_bf16_f32 %0, %1, %2" : "=v"(r) : "v"(lo), "v"(hi)); return r; }
typedef float f32x2 __attribute__((ext_vector_type(2)));
__device__ __forceinline__ f32x2 gelu_pk(f32x2 v) {
    const f32x2 av = __builtin_elementwise_abs(v), d = av * 0.2316418882f + 1.0f;
    f32x2 t; t.x = __builtin_amdgcn_rcpf(d.x); t.y = __builtin_amdgcn_rcpf(d.y);
    f32x2 q = t * 0.5307027145f + (-0.7265760135f); q = q * t + 0.7107068705f; q = q * t + (-0.142248368f); q = q * t + 0.127414796f; q = q * t;
    const f32x2 s = (v * v) * (-0.72134752044f);
    f32x2 e; e.x = __builtin_amdgcn_exp2f(s.x); e.y = __builtin_amdgcn_exp2f(s.y);
    const f32x2 m = v * (q * e), r = v - m;
    f32x2 o; o.x = v.x < 0.f ? m.x : r.x; o.y = v.y < 0.f ? m.y : r.y; return o;
}

template <int ACT  > struct EpiBf16 {
    static constexpr bool PERM = true, AFTER_DRAIN = false; static_assert(ACT == 0 || ACT == 1, "EpiBf16: ACT is 0 (none) or 1 (gelu_pk)");
    bf16_t* O; int ldc; const float* bias; int split_cols; size_t split_stride; float scale0;
    __device__ __forceinline__ void operator()(const f32x4 (&acc)[2][2][4][2], const Unit& u, int wr, int wc, int fr, int fq) const {
        const int row0 = u.pm * BM + wr * 64 + fr; int colt = u.pn * BM; bf16_t* base = O;
        float sc = 1.f; if (split_cols) { const int t = colt / split_cols; base += (size_t)t * split_stride; colt -= t * split_cols; if (t == 0) sc = scale0; }
        const int col0 = colt + wc * 32 + 8 * fq, bcol0 = u.pn * BM + wc * 32 + 8 * fq;
        f32x4 bv[2][2];
#pragma unroll
        for (int bj = 0; bj < 2; ++bj)
#pragma unroll
            for (int n = 0; n < 2; ++n) bv[bj][n] = bias ? *(const f32x4*)(bias + bcol0 + bj * HALF + 4 * n) : (f32x4){0.f, 0.f, 0.f, 0.f};
#pragma unroll
        for (int ai = 0; ai < 2; ++ai)
#pragma unroll
            for (int m = 0; m < 4; ++m) { bf16_t* rowp = base + (size_t)(row0 + ai * HALF + m * 16) * ldc + col0;
#pragma unroll
                for (int bj = 0; bj < 2; ++bj) { f32x4 v0 = acc[ai][bj][m][0] + bv[bj][0], v1 = acc[ai][bj][m][1] + bv[bj][1];
                    if (ACT == 1) { f32x2 a = gelu_pk((f32x2){v0[0], v0[1]}), b = gelu_pk((f32x2){v0[2], v0[3]}), c = gelu_pk((f32x2){v1[0], v1[1]}), d = gelu_pk((f32x2){v1[2], v1[3]});
                        v0 = (f32x4){a.x, a.y, b.x, b.y}; v1 = (f32x4){c.x, c.y, d.x, d.y}; }
                    v0 = v0 * sc; v1 = v1 * sc; u32x4 w; w.x = cvt_pk_bf16(v0[0], v0[1]); w.y = cvt_pk_bf16(v0[2], v0[3]); w.z = cvt_pk_bf16(v1[0], v1[1]); w.w = cvt_pk_bf16(v1[2], v1[3]);
                    *(u32x4*)(rowp + bj * HALF) = w; } }
    }
};
template <class Epi, class Sched, bool ALIGN_EPI = false, bool SP2 = false>
__device__ __forceinline__ void gemm_phase(PG8_LAS unsigned char* lds, const Gemm g, const Sched& S, const Epi& E) {
    int tid_ = threadIdx.x; asm volatile("" : "+v"(tid_));
    const int tid = tid_, wid = __builtin_amdgcn_readfirstlane(tid >> 6), lane = tid & 63, wr = wid >> 2, wc = wid & 3, fr = lane & 15, fq = lane >> 4;
    const int K = g.K, nt = K / BK;
    unsigned voffA[2], voffB[2];
#pragma unroll
    for (int i = 0; i < 2; ++i) { int R, C; stage_rc(tid * 16 + i * 8192, R, C); const int Rb = Epi::PERM ? ((R & ~31) + perm32(R & 31)) : R;
        voffA[i] = (unsigned)(R * K + C) * 2u; voffB[i] = (unsigned)(Rb * K + C) * 2u; }
    const size_t kstep = (size_t)(BK * 2);
    const size_t hstep = (size_t)HALF * K * 2;
    const size_t tstep = 2 * hstep;
    const unsigned ldsw = (unsigned)wid * 1024u;
    const int aoff = lds_byte(wr * 64 + fr, fq * 8), boff = lds_byte(wc * 32 + fr, fq * 8);
#define PG8_SA(b, h) (((b) * 2 + (h)) * HTB)
#define PG8_SB(b, h) ((4 + (b) * 2 + (h)) * HTB)
#define PG8_STAGE(bufoff, gbase, voff) do { _Pragma("unroll") for (int _i = 0; _i < 2; ++_i) \
        __builtin_amdgcn_global_load_lds((const unsigned*)((const char*)(gbase) + (voff)[_i]), (PG8_LAS unsigned*)(lds + (bufoff) + ldsw + _i * 8192), 16, 0, 0); } while (0)
#define PG8_LDA(dst, b, h) do { _Pragma("unroll") for (int m = 0; m < 4; ++m) _Pragma("unroll") for (int k = 0; k < 2; ++k) dst[m][k] = *(const PG8_LAS bf16x8*)(lds + PG8_SA(b, h) + aoff + m * 2048 + k * 1024); } while (0)
#define PG8_LDB(dst, b, h) do { _Pragma("unroll") for (int n = 0; n < 2; ++n) _Pragma("unroll") for (int k = 0; k < 2; ++k) dst[n][k] = *(const PG8_LAS bf16x8*)(lds + PG8_SB(b, h) + boff + n * 2048 + k * 1024); } while (0)
#define PG8_MMA(ai, bj, At, Bt) do { __builtin_amdgcn_s_setprio(1); _Pragma("unroll") for (int m = 0; m < 4; ++m) _Pragma("unroll") for (int n = 0; n < 2; ++n) _Pragma("unroll") for (int k = 0; k < 2; ++k) \
        acc[ai][bj][m][n] = __builtin_amdgcn_mfma_f32_16x16x32_bf16(Bt[n][k], At[m][k], acc[ai][bj][m][n], 0, 0, 0); __builtin_amdgcn_s_setprio(0); } while (0)
#define PG8_WAIT_V(n) asm volatile("s_waitcnt vmcnt(" #n ")" ::: "memory")
#define PG8_WAIT_L(n) asm volatile("s_waitcnt lgkmcnt(" #n ")" ::: "memory")
#define PG8_BAR __builtin_amdgcn_s_barrier()
#define PG8_SCHED __builtin_amdgcn_sched_barrier(0)
    Unit cur, nxt; int ui = 0;
    if (!S.next(0, cur)) return;
    f32x4 acc[2][2][4][2];
#pragma unroll
    for (int a = 0; a < 2; ++a)
#pragma unroll
        for (int b = 0; b < 2; ++b)
#pragma unroll
            for (int m = 0; m < 4; ++m)
#pragma unroll
                for (int n = 0; n < 2; ++n) acc[a][b][m][n] = (f32x4){0.f, 0.f, 0.f, 0.f};
    bf16x8 At[4][2], B0[2][2], B1[2][2];
    const char* cA = (const char*)g.A + (size_t)cur.pm * tstep + (size_t)cur.k0 * kstep; const char* cB = (const char*)g.Bt + (size_t)cur.pn * tstep + (size_t)cur.k0 * kstep;
    S.a_ready(cur);
    if constexpr (SP2) {
        PG8_STAGE(PG8_SB(0, 0), cB, voffB); PG8_STAGE(PG8_SB(0, 1), cB + hstep, voffB); PG8_STAGE(PG8_SA(0, 0), cA, voffA); PG8_STAGE(PG8_SA(0, 1), cA + hstep, voffA);
        if (wr == 1) PG8_BAR;
        PG8_WAIT_V(2); PG8_BAR;
        PG8_STAGE(PG8_SB(1, 0), cB + kstep, voffB); PG8_STAGE(PG8_SA(1, 0), cA + kstep, voffA); PG8_STAGE(PG8_SB(1, 1), cB + hstep + kstep, voffB);
        PG8_WAIT_V(6); PG8_BAR;
    } else {
        PG8_STAGE(PG8_SB(0, 0), cB, voffB); PG8_STAGE(PG8_SA(0, 0), cA, voffA); PG8_STAGE(PG8_SB(0, 1), cB + hstep, voffB); PG8_STAGE(PG8_SA(0, 1), cA + hstep, voffA);
        if (wr == 1) PG8_BAR;
        PG8_WAIT_V(4); PG8_BAR;
        PG8_STAGE(PG8_SB(1, 0), cB + kstep, voffB); PG8_STAGE(PG8_SA(1, 0), cA + kstep, voffA); PG8_STAGE(PG8_SB(1, 1), cB + hstep + kstep, voffB);
        PG8_WAIT_V(6); PG8_BAR;
    }
    for (;;) {
        const bool has_next = S.next(ui + 1, nxt);
        const bool full = (cur.pm * BM + HALF) < PG8_ROWS_VALID;
        const char* nA = has_next ? (const char*)g.A + (size_t)nxt.pm * tstep + (size_t)nxt.k0 * kstep : cA; const char* nB = has_next ? (const char*)g.Bt + (size_t)nxt.pn * tstep + (size_t)nxt.k0 * kstep : cB;
        const int ntu = cur.nt;
        for (int t = 0; t < ntu; t += 2) {
            const bool last = (t == ntu - 2);
            const char* a1 = cA + (size_t)(t + 1) * kstep;
            const char* a2 = last ? nA : cA + (size_t)(t + 2) * kstep; const char* b2 = last ? nB : cB + (size_t)(t + 2) * kstep;
            const char* a3 = a2 + kstep; const char* b3 = b2 + kstep;
            if (last && has_next) S.a_ready(nxt);
            if constexpr (SP2) {
            PG8_LDB(B0, 0, 0); PG8_LDB(B1, 0, 1); PG8_SCHED; PG8_LDA(At, 0, 0); PG8_STAGE(PG8_SA(1, 1), a1 + hstep, voffA);
            PG8_WAIT_V(8); PG8_WAIT_L(0); PG8_BAR; PG8_MMA(0, 0, At, B0); PG8_MMA(0, 1, At, B1); PG8_BAR; PG8_SCHED;
            PG8_LDA(At, 0, 1); PG8_STAGE(PG8_SB(0, 0), b2, voffB); PG8_STAGE(PG8_SB(0, 1), b2 + hstep, voffB); PG8_STAGE(PG8_SA(0, 0), a2, voffA);
            PG8_WAIT_V(8); PG8_WAIT_L(0); PG8_BAR; if (full) { PG8_MMA(1, 0, At, B0); PG8_MMA(1, 1, At, B1); } PG8_BAR; PG8_SCHED;
            PG8_LDB(B0, 1, 0); PG8_LDB(B1, 1, 1); PG8_SCHED; PG8_LDA(At, 1, 0); PG8_STAGE(PG8_SA(0, 1), a2 + hstep, voffA);
            PG8_WAIT_V(8); PG8_WAIT_L(0); PG8_BAR; PG8_MMA(0, 0, At, B0); PG8_MMA(0, 1, At, B1); PG8_BAR; PG8_SCHED;
            PG8_LDA(At, 1, 1); PG8_STAGE(PG8_SB(1, 0), b3, voffB); PG8_STAGE(PG8_SB(1, 1), b3 + hstep, voffB); PG8_STAGE(PG8_SA(1, 0), a3, voffA);
            PG8_WAIT_V(8); PG8_WAIT_L(0); PG8_BAR; if (full) { PG8_MMA(1, 0, At, B0); PG8_MMA(1, 1, At, B1); } PG8_BAR; PG8_SCHED;
            } else {
            PG8_LDB(B0, 0, 0); PG8_SCHED; PG8_LDA(At, 0, 0); PG8_STAGE(PG8_SA(1, 1), a1 + hstep, voffA);
            PG8_WAIT_L(8); PG8_BAR; PG8_WAIT_L(0); PG8_MMA(0, 0, At, B0); PG8_BAR; PG8_SCHED;
            PG8_LDB(B1, 0, 1); PG8_STAGE(PG8_SB(0, 0), b2, voffB);
            PG8_BAR; PG8_WAIT_L(0); PG8_MMA(0, 1, At, B1); PG8_BAR;
            PG8_LDA(At, 0, 1); PG8_STAGE(PG8_SA(0, 0), a2, voffA);
            PG8_BAR; PG8_WAIT_L(0); PG8_MMA(1, 0, At, B0); PG8_BAR; PG8_SCHED;
            PG8_STAGE(PG8_SB(0, 1), b2 + hstep, voffB);
            PG8_WAIT_V(6); PG8_BAR; PG8_MMA(1, 1, At, B1); PG8_BAR;
            PG8_LDB(B0, 1, 0); PG8_SCHED; PG8_LDA(At, 1, 0); PG8_STAGE(PG8_SA(0, 1), a2 + hstep, voffA);
            PG8_WAIT_L(8); PG8_BAR; PG8_WAIT_L(0); PG8_MMA(0, 0, At, B0); PG8_BAR; PG8_SCHED;
            PG8_LDB(B1, 1, 1); PG8_STAGE(PG8_SB(1, 0), b3, voffB);
            PG8_BAR; PG8_WAIT_L(0); PG8_MMA(0, 1, At, B1); PG8_BAR;
            PG8_LDA(At, 1, 1); PG8_STAGE(PG8_SA(1, 0), a3, voffA);
            PG8_BAR; PG8_WAIT_L(0); PG8_MMA(1, 0, At, B0); PG8_BAR; PG8_SCHED;
            PG8_STAGE(PG8_SB(1, 1), b3 + hstep, voffB);
            PG8_WAIT_V(6); PG8_BAR; PG8_MMA(1, 1, At, B1); PG8_BAR;
            }
        }
        if constexpr (ALIGN_EPI) { if (wr == 0) PG8_BAR; }
        if constexpr (!Epi::AFTER_DRAIN) { E(acc, cur, wr, wc, fr, fq); S.done(cur); }
        if (!has_next) break;
#pragma unroll
        for (int a = 0; a < 2; ++a)
#pragma unroll
            for (int b = 0; b < 2; ++b)
#pragma unroll
                for (int m = 0; m < 4; ++m)
#pragma unroll
                    for (int n = 0; n < 2; ++n) acc[a][b][m][n] = (f32x4){0.f, 0.f, 0.f, 0.f};
        cur = nxt; cA = nA; cB = nB; ++ui;
        if constexpr (ALIGN_EPI) { if (wr == 1) PG8_BAR; }
    }
    PG8_WAIT_V(0);
    if constexpr (!ALIGN_EPI) { if (wr == 0) PG8_BAR; }
    PG8_BAR;
    if constexpr (Epi::AFTER_DRAIN) { E.fused(acc, cur, wr, wc, fr, fq, lds, wid, lane); S.done(cur); }
#undef PG8_SA
#undef PG8_SB
#undef PG8_STAGE
#undef PG8_LDA
#undef PG8_LDB
#undef PG8_MMA
#undef PG8_WAIT_V
#undef PG8_WAIT_L
#undef PG8_BAR
#undef PG8_SCHED
}
}

namespace att {
using bf16 = __hip_bfloat16;
constexpr int D = 128, NW = 8, QBLK = 32, KVBLK = 64;
constexpr float SCALE = 0.088388347648318440f;
constexpr float THR = 8.f;
constexpr int SDEPTH = 2;
constexpr int LDQ = 1536, LDK = 1536, LDO = 1024;
constexpr size_t SHM_V = KVBLK * D * 2, SHM_K = KVBLK * D * 2, SHM_ATTN = 2 * SHM_V + 2 * SHM_K + NW * 64 * 4;
using bf16x8 = __attribute__((ext_vector_type(8))) short;
using s16x4  = __attribute__((ext_vector_type(4))) short;
using f32x16 = __attribute__((ext_vector_type(16))) float;
using u32x4  = __attribute__((ext_vector_type(4))) unsigned;
#define KSWZ(row, colB) ((row) * 256 + ((colB) ^ (((row) & 7) << 4)))
#define SBAR() __builtin_amdgcn_sched_barrier(0)
__device__ __forceinline__ int crow(int r, int hi) { return (r & 3) + 8 * (r >> 2) + 4 * hi; }
__device__ __forceinline__ unsigned cvtpk(float lo, float hi) {
  unsigned r; asm volatile("v_cvt_pk_bf16_f32 %0, %1, %2" : "=v"(r) : "v"(lo), "v"(hi)); return r;
}
__device__ __forceinline__ bf16x8 ld8(const bf16* p) { return *reinterpret_cast<const bf16x8*>(p); }

__device__ __forceinline__ void partialSM(f32x16& p0, f32x16& p1, float& m_reg, float& mn, float& alpha) {
  constexpr float THRL = THR * 1.4426950408889634f;
  float pmax = p0[0]; for (int r = 1; r < 16; ++r) pmax = fmaxf(pmax, p0[r]); for (int r = 0; r < 16; ++r) pmax = fmaxf(pmax, p1[r]);
  { auto rr = __builtin_amdgcn_permlane32_swap(__float_as_uint(pmax), __float_as_uint(pmax), false, false);
    pmax = fmaxf(__uint_as_float(rr[0]), __uint_as_float(rr[1])); }
  if (__builtin_expect(__all(pmax - m_reg <= THRL), 1)) { mn = m_reg; alpha = 1.f; }
  else { mn = fmaxf(m_reg, pmax); alpha = __builtin_amdgcn_exp2f(m_reg - mn); m_reg = mn; }
  for (int r = 0; r < 16; ++r) p0[r] = p0[r] - mn; for (int r = 0; r < 16; ++r) p1[r] = p1[r] - mn;
  for (int r = 0; r < 16; ++r) p0[r] = __builtin_amdgcn_exp2f(p0[r]);
}
__device__ __forceinline__ void partialSM_fixed(f32x16& p0) {
  for (int r = 0; r < 16; ++r) p0[r] = __builtin_amdgcn_exp2f(p0[r]);
}
__device__ __forceinline__ void finishSM(f32x16& p0, f32x16& p1, float alpha, float& l_reg, bf16x8& pa0, bf16x8& pa1, bf16x8& pa2, bf16x8& pa3) {
  for (int r = 0; r < 16; ++r) p1[r] = __builtin_amdgcn_exp2f(p1[r]);
  float ps = 0; for (int r = 0; r < 16; ++r) ps += p0[r]; for (int r = 0; r < 16; ++r) ps += p1[r];
  { auto rr = __builtin_amdgcn_permlane32_swap(__float_as_uint(ps), __float_as_uint(ps), false, false);
    ps = __uint_as_float(rr[0]) + __uint_as_float(rr[1]); }
  l_reg = l_reg * alpha + ps;
#define PK4(P, BASE, OUT) do { unsigned a0 = cvtpk(P[BASE + 0], P[BASE + 1]), a1 = cvtpk(P[BASE + 2], P[BASE + 3]);   \
    unsigned b0 = cvtpk(P[BASE + 4], P[BASE + 5]), b1 = cvtpk(P[BASE + 6], P[BASE + 7]);                              \
    auto r0 = __builtin_amdgcn_permlane32_swap(a0, b0, false, false); auto r1 = __builtin_amdgcn_permlane32_swap(a1, b1, false, false); \
    u32x4 w = {r0[0], r1[0], r0[1], r1[1]}; OUT = *reinterpret_cast<bf16x8*>(&w); } while (0)
  PK4(p0, 0, pa0); PK4(p0, 8, pa1); PK4(p1, 0, pa2); PK4(p1, 8, pa3);
#undef PK4
}
__device__ __forceinline__ void qkt(f32x16& p0, f32x16& p1, const bf16* Ks, const bf16x8* qr, int r32, int hi) {
  p0 = f32x16{}; p1 = f32x16{};
  for (int d0 = 0; d0 < 8; ++d0) { int cb = (d0 * 16 + hi * 8) * 2;
    bf16x8 b0 = *reinterpret_cast<const bf16x8*>((const char*)Ks + KSWZ(r32, cb));
    bf16x8 b1 = *reinterpret_cast<const bf16x8*>((const char*)Ks + KSWZ(32 + r32, cb));
    p0 = __builtin_amdgcn_mfma_f32_32x32x16_bf16(b0, qr[d0], p0, 0, 0, 0);
    p1 = __builtin_amdgcn_mfma_f32_32x32x16_bf16(b1, qr[d0], p1, 0, 0, 0); }
}
__device__ __forceinline__ int v_st(int k, int c) { const int kk = (k & ~0xC) | ((k & 4) << 1) | ((k & 8) >> 1); return ((kk >> 3) * 4 + (c >> 5)) * 512 + ((kk & 7) * 32 + (c & 31)) * 2; }
__device__ __forceinline__ int v_rd_base(int lane) { return ((lane & 3) << 3) | (((lane >> 2) & 3) << 6) | (((lane >> 4) & 1) << 5) | (((lane >> 5) & 1) << 8); }
constexpr int v_rd_off(int d0, int ks, int half) { return d0 * 512 + ks * 4096 + half * 2048; }
template <int OFF> __device__ __forceinline__ s16x4 tr_read(int vb) {
  s16x4 r; asm volatile("ds_read_b64_tr_b16 %0, %1 offset:%2" : "=&v"(r) : "v"(vb), "i"(OFF) : "memory"); return r;
}
template <int D0> __device__ __forceinline__ void pv_one(f32x16& od, int vb, bf16x8 pa0, bf16x8 pa1, bf16x8 pa2, bf16x8 pa3) {
  const s16x4 l0 = tr_read<v_rd_off(D0, 0, 0)>(vb), h0 = tr_read<v_rd_off(D0, 0, 1)>(vb), l1 = tr_read<v_rd_off(D0, 1, 0)>(vb), h1 = tr_read<v_rd_off(D0, 1, 1)>(vb);
  const s16x4 l2 = tr_read<v_rd_off(D0, 2, 0)>(vb), h2 = tr_read<v_rd_off(D0, 2, 1)>(vb), l3 = tr_read<v_rd_off(D0, 3, 0)>(vb), h3 = tr_read<v_rd_off(D0, 3, 1)>(vb);
  asm volatile("s_waitcnt lgkmcnt(0)" ::: "memory"); SBAR();
#define PK(L, H) (bf16x8){L[0], L[1], L[2], L[3], H[0], H[1], H[2], H[3]}
  od = __builtin_amdgcn_mfma_f32_32x32x16_bf16(pa0, PK(l0, h0), od, 0, 0, 0);
  od = __builtin_amdgcn_mfma_f32_32x32x16_bf16(pa1, PK(l1, h1), od, 0, 0, 0);
  od = __builtin_amdgcn_mfma_f32_32x32x16_bf16(pa2, PK(l2, h2), od, 0, 0, 0);
  od = __builtin_amdgcn_mfma_f32_32x32x16_bf16(pa3, PK(l3, h3), od, 0, 0, 0);
#undef PK
}
__device__ __forceinline__ void pv_d0(f32x16* o, int vb, bf16x8 pa0, bf16x8 pa1, bf16x8 pa2, bf16x8 pa3) {
  pv_one<0>(o[0], vb, pa0, pa1, pa2, pa3); pv_one<1>(o[1], vb, pa0, pa1, pa2, pa3); pv_one<2>(o[2], vb, pa0, pa1, pa2, pa3); pv_one<3>(o[3], vb, pa0, pa1, pa2, pa3);
}

struct AttSlot { bf16x8 vs0, vs1, ks0, ks1; };
struct AttCarry { bf16x8 qr[8]; AttSlot s[2]; };
__device__ __forceinline__ void att_preload(AttCarry& cy, const bf16* Qrow, const bf16* Kh, const bf16* Vh) {
  const int tid = threadIdx.x, sr = tid >> 4, sc = (tid & 15) * 8;
#pragma unroll
  for (int d0 = 0; d0 < 8; ++d0) cy.qr[d0] = ld8(Qrow + d0 * 16);
#pragma unroll
  for (int i = 0; i < 2; ++i) { const int k0 = i * KVBLK;
    cy.s[i].vs0 = ld8(&Vh[(long)(k0 + sr) * LDK + sc]); cy.s[i].vs1 = ld8(&Vh[(long)(k0 + 32 + sr) * LDK + sc]);
    cy.s[i].ks0 = ld8(&Kh[(long)(k0 + sr) * LDK + sc]); cy.s[i].ks1 = ld8(&Kh[(long)(k0 + 32 + sr) * LDK + sc]); }
}
template <bool PARTIAL, bool FIXED>
__device__ __forceinline__ void attn_unit(const bf16* __restrict__ Qrow, const bf16* __restrict__ Kh, const bf16* __restrict__ Vh,
                                          bf16* __restrict__ Ob, int NT, bool mask_last, float* __restrict__ PO, char* lds,
                                          const bf16* Qb_n = nullptr, const bf16* Kh_n = nullptr, const bf16* Vh_n = nullptr) {
  AttCarry cy; unsigned warm0 = 0u, warm1 = 0u;
  int tid_ = threadIdx.x; asm volatile("" : "+v"(tid_));
  const int tid = tid_, wid = tid >> 6, lane = tid & 63, r32 = lane & 31, hi = lane >> 5;
  bf16* V_lds = (bf16*)lds; bf16* K_lds = (bf16*)(lds + 3 * SHM_V);
  float* ws = (float*)(lds + 3 * SHM_V + 3 * SHM_K) + wid * 64; float* li_l = ws; float* al_l = ws + 32;
  float m_reg = FIXED ? 0.f : -1e30f, l_reg = 0; f32x16 o[4] = {}; bf16x8 (&qr)[8] = cy.qr;
  const bf16* Qw = Qrow;
  const int sr = tid >> 4, sc = (tid & 15) * 8, vst0 = v_st(sr, sc), vst1 = v_st(32 + sr, sc);
  const int vb0 = (int)(uintptr_t)V_lds + v_rd_base(lane);
  AttSlot (&sr_)[2] = cy.s;
#define SLOAD(i, k0) do { sr_[i].vs0 = ld8(&Vh[(long)((k0) + sr) * LDK + sc]); sr_[i].vs1 = ld8(&Vh[(long)((k0) + 32 + sr) * LDK + sc]); \
    sr_[i].ks0 = ld8(&Kh[(long)((k0) + sr) * LDK + sc]); sr_[i].ks1 = ld8(&Kh[(long)((k0) + 32 + sr) * LDK + sc]); } while (0)
#define SLOADP(i, Kp, Vp, k0) do { sr_[i].vs0 = ld8(&(Vp)[(long)((k0) + sr) * LDK + sc]); sr_[i].vs1 = ld8(&(Vp)[(long)((k0) + 32 + sr) * LDK + sc]); \
    sr_[i].ks0 = ld8(&(Kp)[(long)((k0) + sr) * LDK + sc]); sr_[i].ks1 = ld8(&(Kp)[(long)((k0) + 32 + sr) * LDK + sc]); } while (0)
#define SWRITE(b, i) do { *(bf16x8*)((char*)V_lds + (b) * SHM_V + vst0) = sr_[i].vs0;          \
    *(bf16x8*)((char*)V_lds + (b) * SHM_V + vst1) = sr_[i].vs1; int kc = sc * 2;               \
    *(bf16x8*)((char*)K_lds + (b) * SHM_K + KSWZ(sr, kc)) = sr_[i].ks0;                       \
    *(bf16x8*)((char*)K_lds + (b) * SHM_K + KSWZ(32 + sr, kc)) = sr_[i].ks1; } while (0)
#define SWAIT() asm volatile("s_waitcnt vmcnt(4)" ::: "memory")
#define RESC(a) do { if (__any((a) < 1.f)) { if (hi == 0) al_l[r32] = (a); asm volatile("s_waitcnt lgkmcnt(0)" ::: "memory"); \
    for (int d = 0; d < 4; ++d) for (int r = 0; r < 16; ++r) o[d][r] *= al_l[crow(r, hi)]; } } while (0)
  f32x16 pA0, pA1, pB0, pB1; float mnA, mnB, alA, alB; bf16x8 pa0, pa1, pa2, pa3;
  int bp = 0, bc = 1, bn = 2;
#pragma unroll
  for (int d0 = 0; d0 < 8; ++d0) qr[d0] = ld8(Qw + d0 * 16);
  SLOAD(0, 0); SLOAD(1, KVBLK);
  SWRITE(0, 0); __syncthreads();
  qkt(pA0, pA1, K_lds, qr, r32, hi);
  SLOAD(0, 2 * KVBLK); SBAR();
  if constexpr (FIXED) { partialSM_fixed(pA0); alA = 1.f; } else partialSM(pA0, pA1, m_reg, mnA, alA);
  SWAIT(); SWRITE(1, 1);
#define ROT3() do { const int t_ = bp; bp = bc; bc = bn; bn = t_; } while (0)
  int j = 1;
  for (; j + 2 < NT; j += 2) {
    __syncthreads();
    SBAR(); qkt(pB0, pB1, (bf16*)((char*)K_lds + bc * SHM_K), qr, r32, hi);
    finishSM(pA0, pA1, alA, l_reg, pa0, pa1, pa2, pa3); SBAR();
    SLOAD(1, (j + 2) * KVBLK); SBAR();
    pv_d0(o, vb0 + bp * (int)SHM_V, pa0, pa1, pa2, pa3);
    if constexpr (FIXED) { partialSM_fixed(pB0); alB = 1.f; } else { partialSM(pB0, pB1, m_reg, mnB, alB); RESC(alB); }
    SWAIT(); SWRITE(bn, 0);
    ROT3();
    __syncthreads();
    SBAR(); qkt(pA0, pA1, (bf16*)((char*)K_lds + bc * SHM_K), qr, r32, hi);
    finishSM(pB0, pB1, alB, l_reg, pa0, pa1, pa2, pa3); SBAR();
    SLOAD(0, (j + 3) * KVBLK); SBAR();
    pv_d0(o, vb0 + bp * (int)SHM_V, pa0, pa1, pa2, pa3);
    if constexpr (FIXED) { partialSM_fixed(pA0); alA = 1.f; } else { partialSM(pA0, pA1, m_reg, mnA, alA); RESC(alA); }
    SWAIT(); SWRITE(bn, 1);
    ROT3();
  }
  {
    __syncthreads();
    SBAR(); qkt(pB0, pB1, (bf16*)((char*)K_lds + bc * SHM_K), qr, r32, hi);
    finishSM(pA0, pA1, alA, l_reg, pa0, pa1, pa2, pa3); SBAR();
    if constexpr (!PARTIAL) { const int i1 = tid & 255;
      warm0 = *(const unsigned*)(Qb_n + (long)(tid >> 1) * LDQ + (tid & 1) * 64);
      warm1 = *(const unsigned*)((tid < 256 ? Kh_n : Vh_n) + (long)(i1 >> 1) * LDK + (i1 & 1) * 64); }
    SBAR();
    pv_d0(o, vb0 + bp * (int)SHM_V, pa0, pa1, pa2, pa3);
    if constexpr (FIXED) { partialSM_fixed(pB0); alB = 1.f; } else { partialSM(pB0, pB1, m_reg, mnB, alB); RESC(alB); }
    SWRITE(bn, 0);
    ROT3();
    __syncthreads();
    SBAR(); qkt(pA0, pA1, (bf16*)((char*)K_lds + bc * SHM_K), qr, r32, hi);
    if (mask_last) {
      asm volatile("; masked tail tile" ::: "memory");
      const float NEG = -INFINITY;
#pragma unroll
      for (int r = 8; r < 16; ++r) pA0[r] = NEG;
#pragma unroll
      for (int r = 0; r < 16; ++r) pA1[r] = NEG;
    }
    finishSM(pB0, pB1, alB, l_reg, pa0, pa1, pa2, pa3); SBAR();
    pv_d0(o, vb0 + bp * (int)SHM_V, pa0, pa1, pa2, pa3);
    if constexpr (FIXED) { partialSM_fixed(pA0); alA = 1.f; } else { partialSM(pA0, pA1, m_reg, mnA, alA); RESC(alA); }
    ROT3();
  }
#undef ROT3
  SBAR(); finishSM(pA0, pA1, alA, l_reg, pa0, pa1, pa2, pa3); SBAR();
  pv_d0(o, vb0 + bp * (int)SHM_V, pa0, pa1, pa2, pa3);
  if (PARTIAL) {
    if (wid < 2) { float* po = PO + (wid * QBLK) * 128;
#pragma unroll
      for (int r = 0; r < 16; ++r) { const int orow = crow(r, hi);
#pragma unroll
        for (int d0 = 0; d0 < 4; ++d0) po[orow * 128 + d0 * 32 + r32] = o[d0][r]; }
      if (hi == 0) { PO[8192 + (wid * QBLK + r32) * 2] = m_reg; PO[8192 + (wid * QBLK + r32) * 2 + 1] = l_reg; } }
    __syncthreads();
    return;
  }
  if (hi == 0) li_l[r32] = l_reg; asm volatile("s_waitcnt lgkmcnt(0)" ::: "memory");
  float rli[16];
#pragma unroll
  for (int r = 0; r < 16; ++r) rli[r] = __builtin_amdgcn_rcpf(li_l[crow(r, hi)]);
  __syncthreads();
  unsigned short* stg = (unsigned short*)(lds + wid * 8192);
#pragma unroll
  for (int r = 0; r < 16; ++r) { const int orow = crow(r, hi);
#pragma unroll
    for (int d0 = 0; d0 < 4; ++d0) { const float v = o[d0][r] * rli[r]; stg[orow * 128 + d0 * 32 + r32] = (unsigned short)(cvtpk(v, v) & 0xffffu); } }
  asm volatile("s_waitcnt lgkmcnt(0)" ::: "memory");
#pragma unroll
  for (int it = 0; it < 8; ++it) { const int row = it * 4 + (lane >> 4), c16 = lane & 15;
    const bf16x8 v = *reinterpret_cast<const bf16x8*>((const char*)stg + row * 256 + c16 * 16);
    *reinterpret_cast<bf16x8*>(Ob + (long)(wid * QBLK + row) * LDO + c16 * 8) = v; }
  asm volatile("" :: "v"(warm0 ^ warm1));
  __syncthreads();
#undef SLOAD
#undef SLOADP
#undef SWRITE
#undef SWAIT
#undef RESC
}
#undef KSWZ
#undef SBAR
}

#define LAS __attribute__((address_space(3)))
typedef unsigned short bf16raw;
typedef short bf16x8 __attribute__((ext_vector_type(8)));
typedef float f32x4 __attribute__((ext_vector_type(4)));
typedef float f32x2 __attribute__((ext_vector_type(2)));
typedef unsigned u32x4 __attribute__((ext_vector_type(4)));
typedef unsigned u32x2 __attribute__((ext_vector_type(2)));

constexpr int DM = 1024, NB = 8, SEQ = 8192, NMETA = 16, LTOK = SEQ + NMETA, MTOK = NB * LTOK, MPAD = 65792;
constexpr int DFF = 2816, QKVD = 1536, NTHREADS = 512;
constexpr float RMS_EPS = 1e-6f;
constexpr int LDS_BYTES = 147456;
static_assert(MPAD % 256 == 0 && MPAD >= MTOK + 128, "row padding");
constexpr size_t WS_H = 0;
constexpr size_t WS_U = WS_H + (size_t)MPAD * DM * 4;
constexpr size_t WS_BIG = WS_U + (size_t)MPAD * DM * 2;
constexpr size_t WS_MB = WS_BIG + (size_t)MPAD * DFF * 2;
constexpr size_t WS_W = WS_MB + (size_t)MPAD * DM * 2;
constexpr size_t WO_LRU_IN = 0, WO_LRU_OUT = WO_LRU_IN + 2ul * 2048 * 1024, WO_GATE = WO_LRU_OUT + 2ul * 1024 * 1024, WO_QKV = WO_GATE + 64ul * 128 * 128,
                 WO_AO = WO_QKV + 2ul * 1536 * 1024, WO_F1 = WO_AO + 2ul * 1024 * 1024, WO_F2 = WO_F1 + 4ul * 5632 * 1024, WO_END = WO_F2 + 4ul * 1024 * 2816;
constexpr int LT = 48, NCHUNK = LTOK / LT;
static_assert(NCHUNK * LT == LTOK, "chunking");
constexpr size_t WS_SUM = WS_W + WO_END * 2;
constexpr size_t WS_CARRY = WS_SUM + (size_t)NB * NCHUNK * 2 * 1024 * 8;
constexpr size_t WS_ROPE = WS_CARRY + (size_t)NB * NCHUNK * 2 * 1024 * 4;
constexpr size_t WS_CTL = WS_ROPE + 128 * 32 * 8;
constexpr size_t WS_TAILP = WS_CTL + 16384;
constexpr size_t WS_END = WS_TAILP + 4ul * 128 * 1024 * 4;
constexpr int MREG = 65536, TAIL_S = 4;
constexpr int LDS_MISC = 147200;

__device__ __forceinline__ unsigned cvt_pk(float lo, float hi) { unsigned r; asm volatile("v_cvt_pk_bf16_f32 %0, %1, %2" : "=v"(r) : "v"(lo), "v"(hi)); return r; }
__device__ __forceinline__ float bf_lo(unsigned w) { return __uint_as_float(w << 16); }
__device__ __forceinline__ float bf_hi(unsigned w) { return __uint_as_float(w & 0xffff0000u); }
__device__ __forceinline__ float wave_sum(float v) {
#pragma unroll
    for (int o = 1; o < 64; o <<= 1) v += __shfl_xor(v, o);
    return v;
}
__device__ __forceinline__ float sigmoidf_fast(float x) { return __builtin_amdgcn_rcpf(1.0f + __builtin_amdgcn_exp2f(-1.4426950408889634f * x)); }
__device__ __forceinline__ float gelu_tanh(float x) {
    const float z = x * (1.0f + 0.044715f * x * x) * (2.0f * 0.7978845608028654f);
    return x * sigmoidf_fast(z);
}

struct EpiPlain {
    static constexpr bool PERM = true, AFTER_DRAIN = false, ALIGN = true;
    bf16raw* O; int ldc; const float* rs; float* tailp;
    __device__ __forceinline__ void operator()(const f32x4 (&acc)[2][2][4][2], const pg8::Unit& u, int wr, int wc, int fr, int fq) const {
        const int row0 = u.pm * 256 + wr * 64 + fr, col0 = u.pn * 256 + wc * 32 + 8 * fq;
        if (tailp && u.pm * 256 >= MREG) {
#pragma unroll
            for (int m = 0; m < 4; ++m) { float* rowp = tailp + ((size_t)u.part * 128 + wr * 64 + m * 16 + fr) * 1024 + col0;
#pragma unroll
                for (int bj = 0; bj < 2; ++bj) { *(f32x4*)(rowp + bj * 128) = acc[0][bj][m][0]; *(f32x4*)(rowp + bj * 128 + 4) = acc[0][bj][m][1]; } }
            return; }
#pragma unroll
        for (int ai = 0; ai < 2; ++ai)
#pragma unroll
            for (int m = 0; m < 4; ++m) { bf16raw* rowp = O + (size_t)(row0 + ai * 128 + m * 16) * ldc + col0; const float sc = rs ? rs[row0 + ai * 128 + m * 16] : 1.0f;
#pragma unroll
                for (int bj = 0; bj < 2; ++bj) { const f32x4 v0 = acc[ai][bj][m][0] * sc, v1 = acc[ai][bj][m][1] * sc;
                    u32x4 w; w.x = cvt_pk(v0[0], v0[1]); w.y = cvt_pk(v0[2], v0[3]); w.z = cvt_pk(v1[0], v1[1]); w.w = cvt_pk(v1[2], v1[3]);
                    *(u32x4*)(rowp + bj * 128) = w; } }
    }
};
struct EpiLruIn {
    static constexpr bool PERM = true, AFTER_DRAIN = false, ALIGN = true;
    bf16raw* Y; bf16raw* X; const float* rs;
    __device__ __forceinline__ void operator()(const f32x4 (&acc)[2][2][4][2], const pg8::Unit& u, int wr, int wc, int fr, int fq) const {
        const bool isy = u.pn < 4; bf16raw* base = isy ? Y : X;
        const int row0 = u.pm * 256 + wr * 64 + fr, col0 = (isy ? u.pn : u.pn - 4) * 256 + wc * 32 + 8 * fq;
#pragma unroll
        for (int ai = 0; ai < 2; ++ai)
#pragma unroll
            for (int m = 0; m < 4; ++m) { bf16raw* rowp = base + (size_t)(row0 + ai * 128 + m * 16) * DM + col0; const float sc = rs[row0 + ai * 128 + m * 16];
#pragma unroll
                for (int bj = 0; bj < 2; ++bj) { f32x4 v0 = acc[ai][bj][m][0] * sc, v1 = acc[ai][bj][m][1] * sc;
                    if (isy) {
#pragma unroll
                        for (int i = 0; i < 4; ++i) { v0[i] = gelu_tanh(v0[i]); v1[i] = gelu_tanh(v1[i]); } }
                    u32x4 w; w.x = cvt_pk(v0[0], v0[1]); w.y = cvt_pk(v0[2], v0[3]); w.z = cvt_pk(v1[0], v1[1]); w.w = cvt_pk(v1[2], v1[3]);
                    *(u32x4*)(rowp + bj * 128) = w; } }
    }
};
struct EpiSwiglu {
    static constexpr bool PERM = true, AFTER_DRAIN = false, ALIGN = true;
    bf16raw* O; const float* rs;
    __device__ __forceinline__ void operator()(const f32x4 (&acc)[2][2][4][2], const pg8::Unit& u, int wr, int wc, int fr, int fq) const {
        const int row0 = u.pm * 256 + wr * 64 + fr, col0 = u.pn * 128 + wc * 32 + 8 * fq;
#pragma unroll
        for (int ai = 0; ai < 2; ++ai)
#pragma unroll
            for (int m = 0; m < 4; ++m) { bf16raw* rowp = O + (size_t)(row0 + ai * 128 + m * 16) * DFF + col0; const float sc = rs[row0 + ai * 128 + m * 16];
                unsigned wv[4];
#pragma unroll
                for (int n = 0; n < 2; ++n)
#pragma unroll
                    for (int ip = 0; ip < 4; ip += 2) {
                        const f32x2 g = (f32x2){acc[ai][0][m][n][ip], acc[ai][0][m][n][ip + 1]} * sc, up = (f32x2){acc[ai][1][m][n][ip], acc[ai][1][m][n][ip + 1]} * sc;
                        const f32x2 t = g * (-1.4426950408889634f);
                        f32x2 ex; ex.x = __builtin_amdgcn_exp2f(t.x); ex.y = __builtin_amdgcn_exp2f(t.y);
                        ex = ex + 1.0f;
                        f32x2 rc; rc.x = __builtin_amdgcn_rcpf(ex.x); rc.y = __builtin_amdgcn_rcpf(ex.y);
                        const f32x2 r = g * rc * up;
                        wv[n * 2 + (ip >> 1)] = cvt_pk(r.x, r.y); }
                u32x4 w; w.x = wv[0]; w.y = wv[1]; w.z = wv[2]; w.w = wv[3];
                *(u32x4*)rowp = w; }
    }
};

struct EpiQkv {
    static constexpr bool PERM = true, AFTER_DRAIN = false, ALIGN = true;
    bf16raw* O; const float* rs; const float* qg; const float* kg; const f32x2* tab; LAS float* ss;
    __device__ __forceinline__ void operator()(const f32x4 (&acc)[2][2][4][2], const pg8::Unit& u, int wr, int wc, int fr, int fq) const {
        const int row0 = u.pm * 256 + wr * 64 + fr, col0 = u.pn * 256 + wc * 32 + 8 * fq;
        if (u.pn == 5) {
#pragma unroll
            for (int ai = 0; ai < 2; ++ai)
#pragma unroll
                for (int m = 0; m < 4; ++m) { bf16raw* rowp = O + (size_t)(row0 + ai * 128 + m * 16) * QKVD + col0; const float sc = rs[row0 + ai * 128 + m * 16];
#pragma unroll
                    for (int bj = 0; bj < 2; ++bj) { const f32x4 v0 = acc[ai][bj][m][0] * sc, v1 = acc[ai][bj][m][1] * sc;
                        u32x4 w; w.x = cvt_pk(v0[0], v0[1]); w.y = cvt_pk(v0[2], v0[3]); w.z = cvt_pk(v1[0], v1[1]); w.w = cvt_pk(v1[2], v1[3]);
                        *(u32x4*)(rowp + bj * 128) = w; } }
            return; }
#pragma unroll
        for (int ai = 0; ai < 2; ++ai)
#pragma unroll
            for (int m = 0; m < 4; ++m) { const float sc = rs[row0 + ai * 128 + m * 16];
#pragma unroll
                for (int bj = 0; bj < 2; ++bj) { const f32x4 v0 = acc[ai][bj][m][0] * sc, v1 = acc[ai][bj][m][1] * sc;
                    float s = (v0[0] * v0[0] + v0[1] * v0[1]) + (v0[2] * v0[2] + v0[3] * v0[3]) + (v1[0] * v1[0] + v1[1] * v1[1]) + (v1[2] * v1[2] + v1[3] * v1[3]);
                    s += __shfl_xor(s, 16); s += __shfl_xor(s, 32);
                    if (fq == 0) ss[(bj * 4 + wc) * 256 + ai * 128 + wr * 64 + m * 16 + fr] = s; } }
        asm volatile("s_waitcnt lgkmcnt(0)" ::: "memory"); __builtin_amdgcn_s_barrier(); asm volatile("" ::: "memory");
        const int axis = wc >> 1, p0 = (wc & 1) * 16 + 4 * fq, d1 = axis * 64 + p0;
        const float* gsrc = (u.pn == 4) ? kg : qg; const float qsc = (u.pn == 4) ? 1.0f : 0.088388347648318440f * 1.4426950408889634f;
        const f32x4 g1 = *(const f32x4*)(gsrc + d1), g2 = *(const f32x4*)(gsrc + d1 + 32);
#pragma unroll
        for (int ai = 0; ai < 2; ++ai)
#pragma unroll
            for (int m = 0; m < 4; ++m) { const int row = row0 + ai * 128 + m * 16, rl = ai * 128 + wr * 64 + m * 16 + fr; const float sc = rs[row];
                const int rr = row < MTOK ? row : 0, b = rr / LTOK, t = rr - b * LTOK;
                f32x4 cc = (f32x4){1.f, 1.f, 1.f, 1.f}, sn = (f32x4){0.f, 0.f, 0.f, 0.f};
                if (t >= NMETA) { const int s = t - NMETA, pos = axis ? (s & 63) : (s >> 6); const f32x4 t0 = *(const f32x4*)(tab + pos * 32 + p0), t1 = *(const f32x4*)(tab + pos * 32 + p0 + 2);
                    cc = (f32x4){t0[0], t0[2], t1[0], t1[2]}; sn = (f32x4){t0[1], t0[3], t1[1], t1[3]}; }
                bf16raw* rowp = O + (size_t)row * QKVD + col0;
#pragma unroll
                for (int bj = 0; bj < 2; ++bj) { const LAS float* sp = ss + bj * 1024 + rl;
                    const float tot = (sp[0] + sp[256]) + (sp[512] + sp[768]);
                    const float rn = (1.0f / sqrtf(tot * (1.0f / 128.0f) + RMS_EPS)) * sc * qsc;
                    const f32x4 n1 = acc[ai][bj][m][0] * rn * g1, n2 = acc[ai][bj][m][1] * rn * g2;
                    const f32x4 o1 = n1 * cc - n2 * sn, o2 = n2 * cc + n1 * sn;
                    u32x4 w; w.x = cvt_pk(o1[0], o1[1]); w.y = cvt_pk(o1[2], o1[3]); w.z = cvt_pk(o2[0], o2[1]); w.w = cvt_pk(o2[2], o2[3]);
                    *(u32x4*)(rowp + bj * 128) = w; } }
    }
};

__device__ __forceinline__ void transpose_item(const float* W, int K, int N, bf16raw* WT, int perm, const float* gk, LAS float* scr, int item, int lane) {
    const int nblk = N / 32, kb = item / nblk, nb = item % nblk, k0 = 64 * kb, n0 = 32 * nb;
    int d0 = n0;
    if (perm == 1) { const int j = n0 < DFF ? n0 : n0 - DFF; d0 = (j >> 7) * 256 + (j & 127) + (n0 < DFF ? 0 : 128); }
#pragma unroll 8
    for (int i = 0; i < 32; ++i) { const int kk = 2 * i + (lane >> 5); const float gsc = gk ? gk[k0 + kk] : 1.0f; scr[kk * 33 + (lane & 31)] = W[(size_t)(k0 + kk) * N + n0 + (lane & 31)] * gsc; }
    asm volatile("s_waitcnt lgkmcnt(0)" ::: "memory");
    const int c = lane & 7;
#pragma unroll
    for (int j = 0; j < 4; ++j) { const int n = (lane >> 3) + 8 * j; const LAS float* s = scr + (8 * c) * 33 + n;
        u32x4 o; o.x = cvt_pk(s[0 * 33], s[1 * 33]); o.y = cvt_pk(s[2 * 33], s[3 * 33]); o.z = cvt_pk(s[4 * 33], s[5 * 33]); o.w = cvt_pk(s[6 * 33], s[7 * 33]);
        int dr = d0 + n;
        if (perm == 2) { const int ns = n0 + n; if (ns < 1280) { const int hd = ns >> 7, d = ns & 127, ax = d >> 6, hf = (d >> 5) & 1, p = d & 31;
                dr = hd * 128 + 32 * (ax * 2 + (p >> 4)) + 8 * ((p >> 2) & 3) + 4 * hf + (p & 3); } }
        *(u32x4*)(WT + (size_t)dr * K + k0 + 8 * c) = o; }
    asm volatile("s_waitcnt lgkmcnt(0)" ::: "memory");
}
__device__ __forceinline__ void convert_group(const float* W, int K, int N, int nmat, bf16raw* WT, int perm, const float* gbase, int gstride, LAS float* scr, int gw, int NGW, int lane) {
    const int per = (K / 64) * (N / 32), total = per * nmat;
    for (int it = gw; it < total; it += NGW) { const int mt = it / per, r = it % per;
        transpose_item(W + (size_t)mt * K * N, K, N, WT + (size_t)mt * K * N, perm, gbase ? gbase + (size_t)mt * gstride : nullptr, scr, r, lane); }
}

struct Row16 { f32x4 v[4]; };
__device__ __forceinline__ void ld_row_f32(Row16& r, const float* p, int lane) {
    const f32x4* q = (const f32x4*)(p + 8 * lane); r.v[0] = q[0]; r.v[1] = q[1]; r.v[2] = q[128]; r.v[3] = q[129];
}
__device__ __forceinline__ void st_row_f32(const Row16& r, float* p, int lane) {
    f32x4* q = (f32x4*)(p + 8 * lane); q[0] = r.v[0]; q[1] = r.v[1]; q[128] = r.v[2]; q[129] = r.v[3];
}
__device__ __forceinline__ void ld_row_bf16(Row16& r, const bf16raw* p, int lane) {
    const u32x4 a = *(const u32x4*)(p + 8 * lane), b = *(const u32x4*)(p + 512 + 8 * lane);
    r.v[0] = (f32x4){bf_lo(a.x), bf_hi(a.x), bf_lo(a.y), bf_hi(a.y)}; r.v[1] = (f32x4){bf_lo(a.z), bf_hi(a.z), bf_lo(a.w), bf_hi(a.w)};
    r.v[2] = (f32x4){bf_lo(b.x), bf_hi(b.x), bf_lo(b.y), bf_hi(b.y)}; r.v[3] = (f32x4){bf_lo(b.z), bf_hi(b.z), bf_lo(b.w), bf_hi(b.w)};
}
__device__ __forceinline__ void st_row_bf16(const Row16& r, bf16raw* p, int lane) {
    u32x4 a, b; a.x = cvt_pk(r.v[0][0], r.v[0][1]); a.y = cvt_pk(r.v[0][2], r.v[0][3]); a.z = cvt_pk(r.v[1][0], r.v[1][1]); a.w = cvt_pk(r.v[1][2], r.v[1][3]);
    b.x = cvt_pk(r.v[2][0], r.v[2][1]); b.y = cvt_pk(r.v[2][2], r.v[2][3]); b.z = cvt_pk(r.v[3][0], r.v[3][1]); b.w = cvt_pk(r.v[3][2], r.v[3][3]);
    *(u32x4*)(p + 8 * lane) = a; *(u32x4*)(p + 512 + 8 * lane) = b;
}
__device__ __forceinline__ float row_rstd(const Row16& r) {
    float s = 0.f;
#pragma unroll
    for (int j = 0; j < 4; ++j) s += (r.v[j][0] * r.v[j][0] + r.v[j][1] * r.v[j][1]) + (r.v[j][2] * r.v[j][2] + r.v[j][3] * r.v[j][3]);
    return 1.0f / sqrtf(wave_sum(s) * (1.0f / DM) + RMS_EPS);
}
struct RawPair { u32x4 r[8]; };
__device__ __forceinline__ void rp_load(RawPair& p, const bf16raw* MB, const bf16raw* U, int m0, int NGW, int lane) {
    const int m1 = m0 + NGW, m1c = m1 < MREG ? m1 : m0;
    p.r[0] = *(const u32x4*)(MB + (size_t)m0 * DM + 8 * lane); p.r[1] = *(const u32x4*)(MB + (size_t)m0 * DM + 512 + 8 * lane);
    p.r[2] = *(const u32x4*)(U + (size_t)m0 * DM + 8 * lane);  p.r[3] = *(const u32x4*)(U + (size_t)m0 * DM + 512 + 8 * lane);
    p.r[4] = *(const u32x4*)(MB + (size_t)m1c * DM + 8 * lane); p.r[5] = *(const u32x4*)(MB + (size_t)m1c * DM + 512 + 8 * lane);
    p.r[6] = *(const u32x4*)(U + (size_t)m1c * DM + 8 * lane);  p.r[7] = *(const u32x4*)(U + (size_t)m1c * DM + 512 + 8 * lane);
}
__device__ __forceinline__ void rp_unpack(Row16& r, const u32x4 a, const u32x4 b) {
    r.v[0] = (f32x4){bf_lo(a.x), bf_hi(a.x), bf_lo(a.y), bf_hi(a.y)}; r.v[1] = (f32x4){bf_lo(a.z), bf_hi(a.z), bf_lo(a.w), bf_hi(a.w)};
    r.v[2] = (f32x4){bf_lo(b.x), bf_hi(b.x), bf_lo(b.y), bf_hi(b.y)}; r.v[3] = (f32x4){bf_lo(b.z), bf_hi(b.z), bf_lo(b.w), bf_hi(b.w)};
}
__device__ __forceinline__ void rp_process(const RawPair& p, int mode, int m0, int NGW, bf16raw* U, float* RS, const Row16& gp, float* out, int lane) {
    const int m1 = m0 + NGW; const bool has1 = m1 < MREG;
    Row16 mv0, h0, mv1, h1;
    rp_unpack(mv0, p.r[0], p.r[1]); rp_unpack(h0, p.r[2], p.r[3]); rp_unpack(mv1, p.r[4], p.r[5]); rp_unpack(h1, p.r[6], p.r[7]);
    const float ra = row_rstd(mv0), rb = row_rstd(mv1);
#pragma unroll
    for (int j = 0; j < 4; ++j) { h0.v[j] = h0.v[j] + mv0.v[j] * ra * gp.v[j]; h1.v[j] = h1.v[j] + mv1.v[j] * rb * gp.v[j]; }
    if (mode == 2) {
        { const int b = m0 / LTOK, t = m0 - b * LTOK; if (t >= NMETA) st_row_f32(h0, out + ((size_t)b * SEQ + (t - NMETA)) * DM, lane); }
        if (has1) { const int b = m1 / LTOK, t = m1 - b * LTOK; if (t >= NMETA) st_row_f32(h1, out + ((size_t)b * SEQ + (t - NMETA)) * DM, lane); }
        return; }
    st_row_bf16(h0, U + (size_t)m0 * DM, lane);
    if (has1) st_row_bf16(h1, U + (size_t)m1 * DM, lane);
    const float r0 = row_rstd(h0), r1 = row_rstd(h1);
    if (lane == 0) { RS[m0] = r0; if (has1) RS[m1] = r1; }
}
__device__ __forceinline__ void resid_pass(int mode, const float* x, const float* meta, const bf16raw* MB, bf16raw* U, float* RS, bf16raw* OB, const float* g_post, float* out,
                                           int gw, int NGW, int lane, const float* tailp = nullptr) {
    Row16 gp;
    if (mode != 0) ld_row_f32(gp, g_post, lane);
    if (mode == 0) {
        for (int m = gw; m < MPAD; m += NGW) {
            Row16 h;
            if (m >= MTOK) {
                const u32x4 z = (u32x4){0u, 0u, 0u, 0u};
                *(u32x4*)(U + (size_t)m * DM + 8 * lane) = z; *(u32x4*)(U + (size_t)m * DM + 512 + 8 * lane) = z;
                *(u32x4*)(OB + (size_t)m * DM + 8 * lane) = z; *(u32x4*)(OB + (size_t)m * DM + 512 + 8 * lane) = z;
                if (lane == 0) RS[m] = 0.f;
                continue; }
            const int b = m / LTOK, t = m - b * LTOK;
            const float* src = (t < NMETA) ? meta + (size_t)t * DM : x + ((size_t)b * SEQ + (t - NMETA)) * DM; ld_row_f32(h, src, lane);
            st_row_bf16(h, U + (size_t)m * DM, lane);
            const float rs2 = row_rstd(h);
            if (lane == 0) RS[m] = rs2;
        }
        return;
    }
    if (gw < MTOK - MREG) { const int m = MREG + gw; Row16 mv, t1, h;
        ld_row_f32(mv, tailp + (size_t)gw * DM, lane);
#pragma unroll
        for (int p = 1; p < TAIL_S; ++p) { ld_row_f32(t1, tailp + ((size_t)p * 128 + gw) * DM, lane);
#pragma unroll
            for (int j = 0; j < 4; ++j) mv.v[j] = mv.v[j] + t1.v[j]; }
        ld_row_bf16(h, U + (size_t)m * DM, lane);
        const float ra = row_rstd(mv);
#pragma unroll
        for (int j = 0; j < 4; ++j) h.v[j] = h.v[j] + mv.v[j] * ra * gp.v[j];
        if (mode == 2) { const int b = m / LTOK, t = m - b * LTOK; if (t >= NMETA) st_row_f32(h, out + ((size_t)b * SEQ + (t - NMETA)) * DM, lane); }
        else { st_row_bf16(h, U + (size_t)m * DM, lane); const float r2 = row_rstd(h); if (lane == 0) RS[m] = r2; }
    }
    RawPair A, B; const int S = 2 * NGW; int m0 = gw;
    if (m0 < MREG) rp_load(A, MB, U, m0, NGW, lane);
    while (m0 < MREG) {
        if (m0 + S < MREG) rp_load(B, MB, U, m0 + S, NGW, lane);
        rp_process(A, mode, m0, NGW, U, RS, gp, out, lane);
        m0 += S; if (m0 >= MREG) break;
        if (m0 + S < MREG) rp_load(A, MB, U, m0 + S, NGW, lane);
        rp_process(B, mode, m0, NGW, U, RS, gp, out, lane);
        m0 += S;
    }
}

__device__ __forceinline__ void rope_pass(bf16raw* QKV, const float* qg, const float* kg, const f32x2* tab, int gw, int NGW, int lane) {
    const int hsel = lane >> 5, within = lane & 31, axis = within >> 4, s16 = within & 15, d1 = axis * 64 + 2 * s16, d2 = d1 + 32;
    const f32x2 gq1 = *(const f32x2*)(qg + d1), gq2 = *(const f32x2*)(qg + d2), gk1 = *(const f32x2*)(kg + d1), gk2 = *(const f32x2*)(kg + d2);
    for (int m = gw; m < MTOK; m += NGW) {
        const int b = m / LTOK, t = m - b * LTOK;
        f32x2 cs0 = (f32x2){1.f, 0.f}, cs1 = (f32x2){1.f, 0.f};
        if (t >= NMETA) { const int s = t - NMETA, pos = axis ? (s & 63) : (s >> 6); cs0 = tab[pos * 32 + 2 * s16]; cs1 = tab[pos * 32 + 2 * s16 + 1]; }
        bf16raw* rowp = QKV + (size_t)m * QKVD;
        unsigned w1[5], w2[5];
#pragma unroll
        for (int st = 0; st < 5; ++st) { const int hd = 2 * st + hsel; w1[st] = *(const unsigned*)(rowp + hd * 128 + d1); w2[st] = *(const unsigned*)(rowp + hd * 128 + d2); }
#pragma unroll
        for (int st = 0; st < 5; ++st) { const int hd = 2 * st + hsel;
            const float x1a = bf_lo(w1[st]), x1b = bf_hi(w1[st]), x2a = bf_lo(w2[st]), x2b = bf_hi(w2[st]);
            float ss = (x1a * x1a + x1b * x1b) + (x2a * x2a + x2b * x2b);
            ss += __shfl_xor(ss, 1); ss += __shfl_xor(ss, 2); ss += __shfl_xor(ss, 4); ss += __shfl_xor(ss, 8); ss += __shfl_xor(ss, 16);
            const float rs = 1.0f / sqrtf(ss * (1.0f / 128.0f) + RMS_EPS);
            const bool isq = (st < 4);
            const f32x2 g1 = isq ? gq1 : gk1, g2 = isq ? gq2 : gk2;
            const float n1a = x1a * rs * g1.x, n1b = x1b * rs * g1.y, n2a = x2a * rs * g2.x, n2b = x2b * rs * g2.y;
            const float o1a = n1a * cs0.x - n2a * cs0.y, o2a = n2a * cs0.x + n1a * cs0.y;
            const float o1b = n1b * cs1.x - n2b * cs1.y, o2b = n2b * cs1.x + n1b * cs1.y;
            *(unsigned*)(rowp + hd * 128 + d1) = cvt_pk(o1a, o1b); *(unsigned*)(rowp + hd * 128 + d2) = cvt_pk(o2a, o2b); }
    }
}

constexpr int L_XCF = 0, L_XCB = 24576, L_CC = 37632, L_AB = 40960, AB_RS = 132, AB_PL = LT * AB_RS;
static_assert(L_AB + 2 * AB_PL * 4 <= LDS_MISC && L_CC + 5 * 128 * 4 <= L_AB, "LRU LDS");
struct LruW { bf16x8 f[2][2][4]; };
struct LruC { float br[2], bi[2], k8[2]; };
__device__ __forceinline__ void lru_load_w(LruW& w, LruC& cc, const bf16raw* Wg, const float* gate_b, const float* lam, int slot, int n, int wid, int lane) {
    const int dir = wid >> 2, cq = wid & 3, fr = lane & 15, fq = lane >> 4;
#pragma unroll
    for (int g = 0; g < 2; ++g)
#pragma unroll
        for (int nt = 0; nt < 2; ++nt)
#pragma unroll
            for (int ks = 0; ks < 4; ++ks)
                w.f[g][nt][ks] = *(const bf16x8*)(Wg + ((size_t)((((slot * 2 + dir) * 2 + g) * 8 + n) * 128 + cq * 32 + nt * 16 + fr)) * 128 + ks * 32 + fq * 8);
#pragma unroll
    for (int nt = 0; nt < 2; ++nt) { const int gch = n * 128 + cq * 32 + nt * 16 + fr;
        cc.br[nt] = gate_b[((size_t)(slot * 2 + dir) * 2 + 0) * DM + gch]; cc.bi[nt] = gate_b[((size_t)(slot * 2 + dir) * 2 + 1) * DM + gch];
        const float lm = lam[(size_t)(slot * 2 + dir) * DM + gch];
        const float sp = (lm > 15.f) ? __expf(-lm) : log1pf(__expf(-lm));
        cc.k8[nt] = -8.0f * sp * 1.4426950408889634f; }
}
struct LruX { u32x4 r[5]; };
__device__ __forceinline__ void lru_fetch_x(LruX& xr, const bf16raw* X, int b, int c, int n, int tid) {
    const int cgp = tid & 15, pr = tid >> 4;
    if (pr < 24) {
#pragma unroll
        for (int k = 0; k < 5; ++k) { const int tt = c * LT + 2 * pr - 2 + k;
            xr.r[k] = (tt >= 0 && tt < LTOK) ? *(const u32x4*)(X + ((size_t)b * LTOK + tt) * DM + n * 128 + cgp * 8) : (u32x4){0u, 0u, 0u, 0u}; } }
}
template <bool FINAL, bool REV>
__device__ __forceinline__ void lru_scan(const f32x4 (&acc)[3][2][2], LAS float* HF, f32x2* SUMS, size_t sbase, float hin0, float hin1, int cq, int fr, int fq, int lane) {
    const int rank = REV ? 3 - fq : fq;
    const int src1 = (REV ? lane + 16 : lane - 16) & 63, src2 = (REV ? lane + 32 : lane - 32) & 63, srcT = REV ? fr : fr + 48;
#pragma unroll
    for (int nt = 0; nt < 2; ++nt) {
        float Pe[3], Qe[3], Pt[3], Qt[3];
#pragma unroll
        for (int mt = 0; mt < 3; ++mt) { float p = 1.f, q = 0.f;
#pragma unroll
            for (int ii = 0; ii < 4; ++ii) { const int i = REV ? 3 - ii : ii; const float a = acc[mt][0][nt][i]; q = a * q + acc[mt][1][nt][i]; p *= a; }
            { const float pp = __shfl(p, src1), qp = __shfl(q, src1); if (rank >= 1) { q = qp * p + q; p = pp * p; } }
            { const float pp = __shfl(p, src2), qp = __shfl(q, src2); if (rank >= 2) { q = qp * p + q; p = pp * p; } }
            Pt[mt] = __shfl(p, srcT); Qt[mt] = __shfl(q, srcT);
            if (FINAL) { const float pe = __shfl(p, src1), qe = __shfl(q, src1); Pe[mt] = rank >= 1 ? pe : 1.f; Qe[mt] = rank >= 1 ? qe : 0.f; } }
        if (!FINAL) { float A = 1.f, Bv = 0.f;
#pragma unroll
            for (int mm = 0; mm < 3; ++mm) { const int mt = REV ? 2 - mm : mm; Bv = Bv * Pt[mt] + Qt[mt]; A *= Pt[mt]; }
            if (fq == 0) SUMS[sbase + 16 * nt] = (f32x2){A, Bv};
        } else { float hseg = nt ? hin1 : hin0; const int ch = cq * 32 + nt * 16 + fr;
#pragma unroll
            for (int mm = 0; mm < 3; ++mm) { const int mt = REV ? 2 - mm : mm;
                float h = Pe[mt] * hseg + Qe[mt];
#pragma unroll
                for (int ii = 0; ii < 4; ++ii) { const int i = REV ? 3 - ii : ii; h = acc[mt][0][nt][i] * h + acc[mt][1][nt][i];
                    HF[(REV ? AB_PL : 0) + (mt * 16 + fq * 4 + i) * AB_RS + ch] = h; }
                hseg = Pt[mt] * hseg + Qt[mt]; } }
    }
}
#define LDS_BAR() do { asm volatile("s_waitcnt lgkmcnt(0)" ::: "memory"); __builtin_amdgcn_s_barrier(); asm volatile("" ::: "memory"); } while (0)
template <bool FINAL>
__device__ __forceinline__ void lru_pass(LAS unsigned char* lds, int slot, const bf16raw* Wg, const bf16raw* X, bf16raw* Y, const float* conv_w, const float* conv_b,
                                         const float* gate_b, const float* lam, f32x2* SUMS, const float* CARRY, int G, int bid, int tid0, int wid, int lane0) {
    constexpr int NTILES = 8 * NB * NCHUNK, PERN = NB * NCHUNK;
    const int lo = (int)(((long)bid * NTILES) / G), hi = (int)(((long)(bid + 1) * NTILES) / G);
    LAS float* XCF = (LAS float*)(lds + L_XCF); LAS unsigned char* XCB = lds + L_XCB; LAS float* CC = (LAS float*)(lds + L_CC); LAS float* HF = (LAS float*)(lds + L_AB);
    const int dir = wid >> 2, cq = wid & 3;
    LruW w; LruC cc; LruX xr; int curn = -1;
    if (lo < hi) { const int n = lo / PERN, rem = lo - n * PERN, b = rem / NCHUNK, c = rem - b * NCHUNK; lru_fetch_x(xr, X, b, c, n, tid0); }
    for (int tau = lo; tau < hi; ++tau) { const int n = tau / PERN, rem = tau - n * PERN, b = rem / NCHUNK, c = rem - b * NCHUNK;
        const size_t row0 = (size_t)b * LTOK + c * LT;
        int tid = tid0; asm volatile("" : "+v"(tid));
        const int lane = tid & 63, fr = lane & 15, fq = lane >> 4, cgp = tid & 15, pr = tid >> 4;
        if (n != curn) { lru_load_w(w, cc, Wg, gate_b, lam, slot, n, wid, lane); curn = n;
            for (int i = tid; i < 5 * 128; i += NTHREADS) CC[i] = (i < 512) ? conv_w[(size_t)slot * 4 * DM + (i >> 7) * DM + n * 128 + (i & 127)] : conv_b[(size_t)slot * DM + n * 128 + (i & 127)];
            __syncthreads(); }
        const size_t sbase = ((size_t)(b * NCHUNK + c) * 2 + dir) * DM + n * 128 + cq * 32 + fr;
        float hin0 = 0.f, hin1 = 0.f;
        if (FINAL) { hin0 = CARRY[sbase]; hin1 = CARRY[sbase + 16]; }
        if (pr < 24) {
            f32x4 xa[5], xb[5];
#pragma unroll
            for (int k = 0; k < 5; ++k) { const u32x4 v = xr.r[k]; xa[k] = (f32x4){bf_lo(v.x), bf_hi(v.x), bf_lo(v.y), bf_hi(v.y)}; xb[k] = (f32x4){bf_lo(v.z), bf_hi(v.z), bf_lo(v.w), bf_hi(v.w)}; }
#pragma unroll
            for (int j = 0; j < 2; ++j) { f32x4 a0 = *(const LAS f32x4*)(CC + 512 + cgp * 8), a1 = *(const LAS f32x4*)(CC + 512 + cgp * 8 + 4);
#pragma unroll
                for (int k = 0; k < 4; ++k) { a0 += *(const LAS f32x4*)(CC + k * 128 + cgp * 8) * xa[j + k]; a1 += *(const LAS f32x4*)(CC + k * 128 + cgp * 8 + 4) * xb[j + k]; }
                const int t = 2 * pr + j;
                *(LAS f32x4*)(XCF + t * 128 + cgp * 8) = a0; *(LAS f32x4*)(XCF + t * 128 + cgp * 8 + 4) = a1;
                u32x4 pk; pk.x = cvt_pk(a0[0], a0[1]); pk.y = cvt_pk(a0[2], a0[3]); pk.z = cvt_pk(a1[0], a1[1]); pk.w = cvt_pk(a1[2], a1[3]);
                *(LAS u32x4*)(XCB + t * 272 + cgp * 16) = pk; }
        }
        if (tau + 1 < hi) { const int t2 = tau + 1, n2 = t2 / PERN, rem2 = t2 - n2 * PERN, b2 = rem2 / NCHUNK, c2 = rem2 - b2 * NCHUNK; lru_fetch_x(xr, X, b2, c2, n2, tid); }
        LDS_BAR();
        f32x4 acc[3][2][2];
#pragma unroll
        for (int mt = 0; mt < 3; ++mt)
#pragma unroll
            for (int g = 0; g < 2; ++g)
#pragma unroll
                for (int nt = 0; nt < 2; ++nt) acc[mt][g][nt] = (f32x4){0.f, 0.f, 0.f, 0.f};
#pragma unroll
        for (int ks = 0; ks < 4; ++ks) {
#pragma unroll
            for (int mt = 0; mt < 3; ++mt) { const bf16x8 af = *(const LAS bf16x8*)(XCB + (mt * 16 + fr) * 272 + (ks * 32 + fq * 8) * 2);
#pragma unroll
                for (int g = 0; g < 2; ++g)
#pragma unroll
                    for (int nt = 0; nt < 2; ++nt) acc[mt][g][nt] = __builtin_amdgcn_mfma_f32_16x16x32_bf16(af, w.f[g][nt][ks], acc[mt][g][nt], 0, 0, 0); } }
#pragma unroll
        for (int nt = 0; nt < 2; ++nt) { const int ch = cq * 32 + nt * 16 + fr;
            const float nbr = -1.4426950408889634f * cc.br[nt], nbi = -1.4426950408889634f * cc.bi[nt], k8 = cc.k8[nt];
#pragma unroll
            for (int mt = 0; mt < 3; ++mt)
#pragma unroll
                for (int ip = 0; ip < 4; ip += 2) { const int tk = mt * 16 + fq * 4 + ip;
                    const f32x2 xr2 = (f32x2){acc[mt][0][nt][ip], acc[mt][0][nt][ip + 1]}, xi2 = (f32x2){acc[mt][1][nt][ip], acc[mt][1][nt][ip + 1]};
                    const f32x2 tr = xr2 * (-1.4426950408889634f) + nbr, ti = xi2 * (-1.4426950408889634f) + nbi;
                    f32x2 er, ei; er.x = __builtin_amdgcn_exp2f(tr.x); er.y = __builtin_amdgcn_exp2f(tr.y); ei.x = __builtin_amdgcn_exp2f(ti.x); ei.y = __builtin_amdgcn_exp2f(ti.y);
                    er = er + 1.0f; ei = ei + 1.0f;
                    f32x2 r, ig; r.x = __builtin_amdgcn_rcpf(er.x); r.y = __builtin_amdgcn_rcpf(er.y); ig.x = __builtin_amdgcn_rcpf(ei.x); ig.y = __builtin_amdgcn_rcpf(ei.y);
                    const f32x2 la = r * k8;
                    f32x2 a; a.x = __builtin_amdgcn_exp2f(la.x); a.y = __builtin_amdgcn_exp2f(la.y);
                    const f32x2 y = 1.0f - a * a;
                    f32x2 sq; sq.x = __builtin_amdgcn_sqrtf(y.x); sq.y = __builtin_amdgcn_sqrtf(y.y);
                    const f32x2 xc2 = (f32x2){XCF[tk * 128 + ch], XCF[(tk + 1) * 128 + ch]};
                    const f32x2 bb = sq * ig * xc2;
                    acc[mt][0][nt][ip] = a.x; acc[mt][0][nt][ip + 1] = a.y; acc[mt][1][nt][ip] = bb.x; acc[mt][1][nt][ip + 1] = bb.y; } }
        if (dir) lru_scan<FINAL, true>(acc, HF, SUMS, sbase, hin0, hin1, cq, fr, fq, lane);
        else     lru_scan<FINAL, false>(acc, HF, SUMS, sbase, hin0, hin1, cq, fr, fq, lane);
        if (FINAL) {
            const u32x4 yv0 = (pr < 24) ? *(const u32x4*)(Y + (row0 + 2 * pr) * DM + n * 128 + cgp * 8) : (u32x4){0u, 0u, 0u, 0u};
            const u32x4 yv1 = (pr < 24) ? *(const u32x4*)(Y + (row0 + 2 * pr + 1) * DM + n * 128 + cgp * 8) : (u32x4){0u, 0u, 0u, 0u};
            LDS_BAR();
            if (pr < 24) {
#pragma unroll
                for (int j = 0; j < 2; ++j) { const int t = 2 * pr + j; const u32x4 yv = j ? yv1 : yv0;
                    const LAS float* hf = HF + t * AB_RS + cgp * 8; const LAS float* hb = HF + AB_PL + t * AB_RS + cgp * 8;
                    const f32x4 f0 = *(const LAS f32x4*)hf, f1 = *(const LAS f32x4*)(hf + 4), b0 = *(const LAS f32x4*)hb, b1 = *(const LAS f32x4*)(hb + 4);
                    const f32x4 z0 = (f0 + b0) * (f32x4){bf_lo(yv.x), bf_hi(yv.x), bf_lo(yv.y), bf_hi(yv.y)}, z1 = (f1 + b1) * (f32x4){bf_lo(yv.z), bf_hi(yv.z), bf_lo(yv.w), bf_hi(yv.w)};
                    u32x4 o; o.x = cvt_pk(z0[0], z0[1]); o.y = cvt_pk(z0[2], z0[3]); o.z = cvt_pk(z1[0], z1[1]); o.w = cvt_pk(z1[2], z1[3]);
                    *(u32x4*)(Y + (row0 + t) * DM + n * 128 + cgp * 8) = o; } }
        }
        LDS_BAR();
    }
}
__device__ __forceinline__ void lru_carry(const f32x2* SUMS, float* CARRY, int G, int bid, int wid, int lane) {
    if (wid != 0) return;
    for (int gt = bid * 64 + lane; gt < NB * 2 * DM; gt += G * 64) { const int b = gt >> 11, sd = (gt >> 10) & 1, gch = gt & 1023;
        float h = 0.f;
        if (sd == 0) {
#pragma unroll 19
            for (int c = 0; c < NCHUNK; ++c) { const size_t i = ((size_t)(b * NCHUNK + c) * 2 + sd) * DM + gch; CARRY[i] = h; const f32x2 s = SUMS[i]; h = s.x * h + s.y; } }
        else {
#pragma unroll 19
            for (int c = NCHUNK - 1; c >= 0; --c) { const size_t i = ((size_t)(b * NCHUNK + c) * 2 + sd) * DM + gch; CARRY[i] = h; const f32x2 s = SUMS[i]; h = s.x * h + s.y; } }
    }
}

typedef unsigned v4u __attribute__((ext_vector_type(4)));
#define XB_TMO      128
#define XB_XCNT(j)  (256  + 64 * (j))
#define XB_XSUB(j)  (1280 + 64 * (j))
#define XB_XGEN(j)  (2304 + 64 * (j))
#define XB_TOP      3328
#define XB_TOPGEN   3392
#define XCD_BAR_WORDS 3456
#define XB_SPIN_CAP (1u << 18)

__device__ __forceinline__ unsigned xb_ld(unsigned* p)              { return __hip_atomic_load(p, __ATOMIC_RELAXED, __HIP_MEMORY_SCOPE_AGENT); }
__device__ __forceinline__ unsigned xb_add(unsigned* p, unsigned v) { return __hip_atomic_fetch_add(p, v, __ATOMIC_RELAXED, __HIP_MEMORY_SCOPE_AGENT); }
__device__ __forceinline__ unsigned xb_xcc_id() { return (unsigned)__builtin_amdgcn_s_getreg((3 << 11) | 20) & 0xFu; }
#define XB_SPIN(cond, bar) do { unsigned _sp = 0; while (cond) { __builtin_amdgcn_s_sleep(1); \
    if ((++_sp & 255u) == 0u) { if (xb_ld(&(bar)[XB_TMO])) break; if (_sp > XB_SPIN_CAP) { atomicAdd(&(bar)[XB_TMO], 1u); break; } } } } while (0)

struct XcdBarrier {
    unsigned* bar; unsigned x;
    volatile LAS unsigned* st;
};

__device__ __forceinline__ XcdBarrier xcd_barrier_post(unsigned* bar, volatile LAS unsigned* st) {
    XcdBarrier b; b.bar = bar; b.x = xb_xcc_id(); b.st = st;
    if (threadIdx.x == 0) (void)xb_add(&bar[XB_XCNT(b.x)], 1u);
    return b;
}
__device__ __forceinline__ void xcd_barrier_complete(unsigned* bar, unsigned x, unsigned& nloc, unsigned& nx) {
    const unsigned G = gridDim.x * gridDim.y * gridDim.z;
    unsigned sum, cnt, mine, sp = 0u;
    for (;;) {
        sum = 0u; cnt = 0u; mine = 0u;
#pragma unroll
        for (unsigned j = 0; j < 16; ++j) { const unsigned c = xb_ld(&bar[XB_XCNT(j)]); sum += c; cnt += (c > 0u) ? 1u : 0u; mine = (j == x) ? c : mine; }
        if (sum == G) break;
        __builtin_amdgcn_s_sleep(1);
        if ((++sp & 255u) == 0u) { if (xb_ld(&bar[XB_TMO])) break; if (sp > XB_SPIN_CAP) { atomicAdd(&bar[XB_TMO], 1u); break; } }
    }
    nloc = mine > 0u ? mine : 1u; nx = cnt > 0u ? cnt : 1u;
}

__device__ __forceinline__ void xcd_barrier(const XcdBarrier& b) {
    asm volatile("s_waitcnt vmcnt(0)" ::: "memory");
    __syncthreads();
    if (threadIdx.x == 0) {
        unsigned* bar = b.bar;
        __builtin_amdgcn_s_waitcnt(0);
        unsigned nloc = b.st[0], nx = b.st[1];
        if (nloc == 0u) { xcd_barrier_complete(bar, b.x, nloc, nx); b.st[0] = nloc; b.st[1] = nx; }
        const unsigned old = xb_add(&bar[XB_XSUB(b.x)], 1u);
        const unsigned gen = old / nloc;
        if (old + 1u == (gen + 1u) * nloc) {
            __builtin_amdgcn_fence(__ATOMIC_RELEASE, "agent");
            asm volatile("s_waitcnt vmcnt(0)" ::: "memory");
            const unsigned og = xb_add(&bar[XB_TOP], 1u);
            const unsigned tg = og / nx;
            if (og + 1u == (tg + 1u) * nx) xb_add(&bar[XB_TOPGEN], 1u);
            else XB_SPIN(xb_ld(&bar[XB_TOPGEN]) == tg, bar);
            __builtin_amdgcn_fence(__ATOMIC_ACQUIRE, "agent");
            xb_add(&bar[XB_XGEN(b.x)], 1u);
            asm volatile("s_waitcnt vmcnt(0)" ::: "memory");
        } else {
            XB_SPIN(xb_ld(&bar[XB_XGEN(b.x)]) == gen, bar);
            __builtin_amdgcn_fence(__ATOMIC_ACQUIRE, "agent");
            asm volatile("s_waitcnt vmcnt(0)" ::: "memory");
        }
    }
    __syncthreads();
}

#define LAUNDER(p) asm volatile("" : "+s"(p))
struct Args { const float* in[16]; float* out; unsigned char* ws; };
#ifdef NO_GEMM
#define GEMM_RUN(EPI, Aptr, Bptr, Nn, Kk, Eobj) do { } while (0)
#define GEMM_RUN_T(EPI, Aptr, Bptr, Nn, Kk, Eobj, TAIL) do { } while (0)
#define GEMM_RUN_S(EPI, Aptr, Bptr, Nn, Kk, Eobj, TAIL, SPL) do { } while (0)
#else
#define GEMM_RUN(EPI, Aptr, Bptr, Nn, Kk, Eobj) GEMM_RUN_S(EPI, Aptr, Bptr, Nn, Kk, Eobj, true, 1)
#define GEMM_RUN_T(EPI, Aptr, Bptr, Nn, Kk, Eobj, TAIL) GEMM_RUN_S(EPI, Aptr, Bptr, Nn, Kk, Eobj, TAIL, 1)
#define GEMM_RUN_S(EPI, Aptr, Bptr, Nn, Kk, Eobj, TAIL, SPL) do { pg8::Gemm g_{(const pg8::bf16_t*)(Aptr), (const pg8::bf16_t*)(Bptr), MPAD, (Nn), (Kk)}; int bid_ = blockIdx.x; asm volatile("" : "+s"(bid_)); int G_ = gridDim.x; asm volatile("" : "+s"(G_)); pg8::StaticOrder S_; S_.init(MPAD, (Nn), (Kk), G_, bid_, (TAIL), (SPL)); \
    pg8::gemm_phase<EPI, pg8::StaticOrder, EPI::ALIGN, true>((PG8_LAS unsigned char*)lds, g_, S_, (Eobj)); } while (0)
#endif

__global__ void __launch_bounds__(NTHREADS, 2) mega_fwd(Args args) {
    extern __shared__ __attribute__((aligned(16))) unsigned char lds[];
    cg::grid_group grid = cg::this_grid();
#define FRESH() int tid = threadIdx.x; asm volatile("" : "+v"(tid)); int bid = blockIdx.x; asm volatile("" : "+s"(bid)); int G = gridDim.x; asm volatile("" : "+s"(G)); const int NGW = G * 8; \
    const int lane = tid & 63, wid = __builtin_amdgcn_readfirstlane(tid >> 6), gw = bid * 8 + wid; (void)lane; (void)gw; (void)NGW
    unsigned char* ws = args.ws;
    const float* x = args.in[0]; const float* meta = args.in[1]; const float* gains = args.in[2];
    bf16raw* OB0 = (bf16raw*)(ws + WS_H); float* RS0 = (float*)(ws + WS_H + (size_t)MPAD * DM * 2); bf16raw* U0 = (bf16raw*)(ws + WS_U);
    bf16raw* BIG0 = (bf16raw*)(ws + WS_BIG); bf16raw* MB0 = (bf16raw*)(ws + WS_MB);
    bf16raw* Wb0 = (bf16raw*)(ws + WS_W); f32x2* SUMS = (f32x2*)(ws + WS_SUM); float* CARRY = (float*)(ws + WS_CARRY); f32x2* ROPE = (f32x2*)(ws + WS_ROPE);

    {
        FRESH();
        LAS float* scr = (LAS float*)((LAS unsigned char*)lds + wid * 16384);
        bf16raw* OB = OB0; float* RS = RS0; bf16raw* U = U0; bf16raw* Wb = Wb0;
        convert_group(args.in[3], 1024, 2048, 2, Wb + WO_LRU_IN, 0, gains, 8 * DM, scr, gw, NGW, lane);
        convert_group(args.in[9], 1024, 1024, 2, Wb + WO_LRU_OUT, 0, nullptr, 0, scr, gw, NGW, lane);
        convert_group(args.in[6], 128, 128, 64, Wb + WO_GATE, 0, nullptr, 0, scr, gw, NGW, lane);
        convert_group(args.in[10], 1024, 1536, 2, Wb + WO_QKV, 2, gains + 4 * DM, 8 * DM, scr, gw, NGW, lane);
        convert_group(args.in[13], 1024, 1024, 2, Wb + WO_AO, 0, nullptr, 0, scr, gw, NGW, lane);
        convert_group(args.in[14], 1024, 5632, 4, Wb + WO_F1, 1, gains + 2 * DM, 4 * DM, scr, gw, NGW, lane);
        convert_group(args.in[15], 2816, 1024, 4, Wb + WO_F2, 0, nullptr, 0, scr, gw, NGW, lane);
        for (int i = bid * NTHREADS + tid; i < 128 * 32; i += G * NTHREADS) { const int pos = i >> 5, p = i & 31;
            const float inv_freq = (float)exp(-(double)p * (9.210340371976184 / 32.0));
            const float ang = (float)pos * inv_freq;
            double rev = (double)ang * 0.15915494309189535; rev -= floor(rev);
            ROPE[i] = (f32x2){__builtin_amdgcn_cosf((float)rev), __builtin_amdgcn_sinf((float)rev)}; }
        resid_pass(0, x, meta, nullptr, U, RS, OB, nullptr, nullptr, gw, NGW, lane);
        if (bid == 0) for (int i = tid; i < 4096; i += NTHREADS) ((unsigned*)(ws + WS_CTL))[i] = 0u;
        if (tid < 2) ((volatile LAS unsigned*)((LAS unsigned char*)lds + LDS_MISC))[tid] = 0u;
    }
    grid.sync();
    const XcdBarrier xbar = xcd_barrier_post((unsigned*)(ws + WS_CTL), (volatile LAS unsigned*)((LAS unsigned char*)lds + LDS_MISC));
#define GSYNC() xcd_barrier(xbar)

    for (int layer = 0; layer < 4; ++layer) {
        const int slot = layer >> 1; const float* gl = gains + (size_t)layer * 4 * DM;
        size_t zl = 0; asm volatile("" : "+s"(zl));
        float* TAILP = (float*)(ws + WS_TAILP) + zl;
        bf16raw* OB = OB0 + zl; float* RS = RS0 + zl; bf16raw* U = U0 + zl; bf16raw* BIG = BIG0 + zl; bf16raw* MB = MB0 + zl; bf16raw* Wb = Wb0 + zl; bf16raw* Yb = BIG; bf16raw* Xb = BIG + (size_t)MPAD * DM;
        if ((layer & 1) == 0) {
            { EpiLruIn E{Yb, Xb, RS}; GEMM_RUN(EpiLruIn, U, Wb + WO_LRU_IN + (size_t)slot * 2048 * 1024, 2048, 1024, E); }
            GSYNC();
#ifndef NO_LRU
            { FRESH(); lru_pass<false>((LAS unsigned char*)lds, slot, Wb + WO_GATE, Xb, Yb, args.in[4], args.in[5], args.in[7], args.in[8], SUMS, CARRY, G, bid, tid, wid, lane); }
            GSYNC();
            { FRESH(); lru_carry(SUMS, CARRY, G, bid, wid, lane); }
            GSYNC();
            { FRESH(); lru_pass<true>((LAS unsigned char*)lds, slot, Wb + WO_GATE, Xb, Yb, args.in[4], args.in[5], args.in[7], args.in[8], SUMS, CARRY, G, bid, tid, wid, lane); }
#endif
            GSYNC();
        } else {
            { EpiQkv E{BIG, RS, args.in[11] + slot * 128, args.in[12] + slot * 128, ROPE, (LAS float*)((LAS unsigned char*)lds + 131072)}; GEMM_RUN(EpiQkv, U, Wb + WO_QKV + (size_t)slot * 1536 * 1024, 1536, 1024, E); }
            GSYNC();
#ifndef NO_ATT
            { int bid = blockIdx.x; asm volatile("" : "+s"(bid)); int G = gridDim.x; asm volatile("" : "+s"(G));
              int tq = threadIdx.x; asm volatile("" : "+v"(tq));
#define ATT_IDS() int tq_ = threadIdx.x; asm volatile("" : "+v"(tq_)); const int qw = tq_ >> 6, qr32 = tq_ & 31, qhi = (tq_ >> 5) & 1
              bool fixed_ok;
              { const float* qg_ = args.in[11] + slot * 128; const float* kg_ = args.in[12] + slot * 128; const int l_ = tq & 63;
                float bq = fmaxf(fabsf(qg_[l_]), fabsf(qg_[l_ + 64])), bk = fmaxf(fabsf(kg_[l_]), fabsf(kg_[l_ + 64]));
#pragma unroll
                for (int o_ = 1; o_ < 64; o_ <<= 1) { bq = fmaxf(bq, __shfl_xor(bq, o_)); bk = fmaxf(bk, __shfl_xor(bk, o_)); }
                const float bound = 0.088388347648318440f * 1.4426950408889634f * 128.0f * bq * bk * 1.02f;
                fixed_ok = __builtin_amdgcn_readfirstlane((int)(bound <= 60.0f)) != 0; }
              float* PART = (float*)(ws + WS_SUM) + zl;
              if (layer < 3)   for (int it = bid; it < 16 * 43; it += G) { const int bk = it / 43, s = it - bk * 43, b = bk >> 1, kvh = bk & 1; const size_t rb = (size_t)b * LTOK;
                  ATT_IDS(); const int Rm = (qw * 32 + qr32) & 63, g4 = Rm >> 4, jm = Rm & 15;
                  if (fixed_ok) att::attn_unit<true, true>((const att::bf16*)(BIG + (rb + jm) * QKVD + (kvh * 4 + g4) * 128 + qhi * 8), (const att::bf16*)(BIG + (rb + 192 * s) * QKVD + 1024 + kvh * 128),
                                       (const att::bf16*)(BIG + (rb + 192 * s) * QKVD + 1280 + kvh * 128), nullptr, 3, s == 42, PART + (size_t)it * 8320, (char*)lds);
                  else att::attn_unit<true, false>((const att::bf16*)(BIG + (rb + jm) * QKVD + (kvh * 4 + g4) * 128 + qhi * 8), (const att::bf16*)(BIG + (rb + 192 * s) * QKVD + 1024 + kvh * 128),
                                       (const att::bf16*)(BIG + (rb + 192 * s) * QKVD + 1280 + kvh * 128), nullptr, 3, s == 42, PART + (size_t)it * 8320, (char*)lds); }
              for (int u = bid; u < NB * 8 * 32; u += G) { const int h = u & 7, kvh = h >> 2, qb = (u >> 3) & 31, b = u >> 8;
                  ATT_IDS(); const size_t rb = (size_t)b * LTOK, q0 = rb + NMETA + 256 * qb;
                  const int u2 = (u + G < NB * 8 * 32) ? u + G : u, h2 = u2 & 7, kvh2 = h2 >> 2; const size_t rb2 = (size_t)(u2 >> 8) * LTOK, q02 = rb2 + NMETA + 256 * ((u2 >> 3) & 31);
                  if (fixed_ok) att::attn_unit<false, true>((const att::bf16*)(BIG + (q0 + qw * 32 + qr32) * QKVD + h * 128 + qhi * 8), (const att::bf16*)(BIG + rb * QKVD + 1024 + kvh * 128),
                                        (const att::bf16*)(BIG + rb * QKVD + 1280 + kvh * 128), (att::bf16*)(OB + q0 * DM + h * 128), 129, true, nullptr, (char*)lds,
                                        (const att::bf16*)(BIG + q02 * QKVD + h2 * 128), (const att::bf16*)(BIG + rb2 * QKVD + 1024 + kvh2 * 128), (const att::bf16*)(BIG + rb2 * QKVD + 1280 + kvh2 * 128));
                  else att::attn_unit<false, false>((const att::bf16*)(BIG + (q0 + qw * 32 + qr32) * QKVD + h * 128 + qhi * 8), (const att::bf16*)(BIG + rb * QKVD + 1024 + kvh * 128),
                                        (const att::bf16*)(BIG + rb * QKVD + 1280 + kvh * 128), (att::bf16*)(OB + q0 * DM + h * 128), 129, true, nullptr, (char*)lds,
                                        (const att::bf16*)(BIG + q02 * QKVD + h2 * 128), (const att::bf16*)(BIG + rb2 * QKVD + 1024 + kvh2 * 128), (const att::bf16*)(BIG + rb2 * QKVD + 1280 + kvh2 * 128)); } }
            if (layer < 3) { GSYNC();
            { FRESH(); const float* PART = (const float*)(ws + WS_SUM) + zl; constexpr float C = 1.0f;
              for (int gt = bid * NTHREADS + tid; gt < 16 * 64 * 128; gt += G * NTHREADS) { const int bk = gt >> 13, R = (gt >> 7) & 63, d = gt & 127, b = bk >> 1, kvh = bk & 1;
                  const float* pb = PART + (size_t)bk * 43 * 8320;
                  float M = -3.0e38f;
                  for (int s = 0; s < 43; ++s) M = fmaxf(M, pb[(size_t)s * 8320 + 8192 + R * 2]);
                  float L = 0.f, O = 0.f;
                  for (int s = 0; s < 43; ++s) { const float w = __builtin_amdgcn_exp2f((pb[(size_t)s * 8320 + 8192 + R * 2] - M) * C);
                      L += w * pb[(size_t)s * 8320 + 8192 + R * 2 + 1]; O += w * pb[(size_t)s * 8320 + R * 128 + d]; }
                  const float v = O / L;
                  OB[((size_t)b * LTOK + (R & 15)) * DM + (kvh * 4 + (R >> 4)) * 128 + d] = (bf16raw)(cvt_pk(v, v) & 0xffffu); } } }
#endif
            GSYNC();
        }
        { const bf16raw* Ap = (layer & 1) ? OB : Yb; const bf16raw* Bp = (layer & 1) ? Wb + WO_AO + (size_t)slot * 1024 * 1024 : Wb + WO_LRU_OUT + (size_t)slot * 1024 * 1024;
          EpiPlain E{MB, DM, nullptr, TAILP}; GEMM_RUN_S(EpiPlain, Ap, Bp, 1024, 1024, E, true, TAIL_S); }
        GSYNC();
        { FRESH(); resid_pass(1, nullptr, nullptr, MB, U, RS, nullptr, gl + DM, nullptr, gw, NGW, lane, TAILP); }
        GSYNC();
        { EpiSwiglu E{BIG, RS}; GEMM_RUN_T(EpiSwiglu, U, Wb + WO_F1 + (size_t)layer * 5632 * 1024, 5632, 1024, E, true); }
        GSYNC();
        { EpiPlain E{MB, DM, nullptr, TAILP}; GEMM_RUN_S(EpiPlain, BIG, Wb + WO_F2 + (size_t)layer * 1024 * 2816, 1024, 2816, E, true, TAIL_S); }
        GSYNC();
        if (layer < 3) { { FRESH(); resid_pass(1, nullptr, nullptr, MB, U, RS, nullptr, gl + 3 * DM, nullptr, gw, NGW, lane, TAILP); } GSYNC(); }
        else { FRESH(); resid_pass(2, nullptr, nullptr, MB, U, RS, nullptr, gl + 3 * DM, args.out, gw, NGW, lane, TAILP); }
    }
}

extern "C" void kernel_launch(void* const* d_in, const int* in_sizes, int n_in, void* d_out, int out_size, void* d_ws, size_t ws_size, hipStream_t stream) {
    static int grid = 0;
    if (grid == 0) {
        if (n_in != 16 || ws_size < WS_END) { fprintf(stderr, "kernel_launch: n_in %d ws %zu (need %zu)\n", n_in, ws_size, (size_t)WS_END); grid = -1; return; }
        int dev = 0, cus = 0, per_cu = 0;
        hipGetDevice(&dev); hipDeviceGetAttribute(&cus, hipDeviceAttributeMultiprocessorCount, dev);
        if (hipFuncSetAttribute((const void*)mega_fwd, hipFuncAttributeMaxDynamicSharedMemorySize, LDS_BYTES) != hipSuccess) { fprintf(stderr, "kernel_launch: hipFuncSetAttribute failed\n"); grid = -1; return; }
        if (hipOccupancyMaxActiveBlocksPerMultiprocessor(&per_cu, (const void*)mega_fwd, NTHREADS, LDS_BYTES) != hipSuccess || per_cu < 1) { fprintf(stderr, "kernel_launch: occupancy query gave %d\n", per_cu); per_cu = 1; }
        (void)hipGetLastError();
        grid = cus * per_cu;
    }
    if (grid < 0) return;
    Args a{};
    for (int i = 0; i < 16; ++i) a.in[i] = (const float*)d_in[i];
    a.out = (float*)d_out; a.ws = (unsigned char*)d_ws;
    void* kargs[] = {&a};
    hipError_t e = hipLaunchCooperativeKernel((const void*)mega_fwd, dim3(grid), dim3(NTHREADS), kargs, LDS_BYTES, stream);
    if (e != hipSuccess) fprintf(stderr, "kernel_launch: cooperative launch failed: %s (grid %d)\n", hipGetErrorString(e), grid);
}
```

```cpp
#include <hip/hip_runtime.h>
#include <hip/hip_bf16.h>
#include <hip/hip_cooperative_groups.h>
#include <cstdio>
#include <cstdint>
#include <cmath>
namespace cg = cooperative_groups;

#define PG8_ROWS_VALID 65664
namespace pg8 {
#define PG8_LAS __attribute__((address_space(3)))
typedef unsigned short bf16_t;
typedef short bf16x8 __attribute__((ext_vector_type(8)));
typedef float f32x4 __attribute__((ext_vector_type(4)));
typedef unsigned u32x4 __attribute__((ext_vector_type(4)));
constexpr int BM = 256, BK = 64, HALF = 128, HTB = HALF * BK * 2  , STAGE_BYTES = 8 * HTB, NXCD = 8, WGM = 8;

__host__ __device__ __forceinline__ int lds_byte(int r, int c) { const int st = (r >> 4) * 2 + (c >> 5), rr = r & 15, cc = c & 31, ob = rr * 64 + cc * 2; return st * 1024 + (ob ^ (((ob >> 9) & 1) << 5)); }
__host__ __device__ __forceinline__ void stage_rc(int b, int& R, int& C) { const int st = b / 1024, sb = b % 1024, swz = sb ^ (((sb >> 9) & 1) << 5); R = (st >> 1) * 16 + swz / 64; C = (st & 1) * 32 + (swz % 64) / 2; }
__host__ __device__ __forceinline__ int perm32(int rho) { const int n = rho >> 4, i = rho & 15; return 8 * (i >> 2) + 4 * n + (i & 3); }

struct Unit { int pm, pn, k0, nt, part; };
struct Gemm { const bf16_t* A; const bf16_t* Bt; int M, N, K; };

struct StaticOrder {
    int nM, nN, nwg, G, c, ntail, ntK, S;
    __host__ __device__ void init(int M, int N, int K, int G_, int c_, bool with_tail = true, int S_ = 1) { nM = M / BM - 1; nN = N / BM; nwg = nM * nN; G = G_; c = c_; ntK = K / BK; S = S_; ntail = with_tail ? nN * S : 0; }
    __host__ __device__ bool next(int i, Unit& u) const {
        const long L = (long)i * G + c; if (L >= nwg + ntail) return false;
        u.k0 = 0; u.nt = ntK; u.part = 0;
        if (L >= nwg) { const int j = (int)(L - nwg); u.pm = nM; u.pn = j / S; const int p = j % S; u.part = p;
            if (S > 1) { const int pairs = ntK / 2, q = pairs / S, r = pairs % S; u.nt = 2 * (q + (p < r ? 1 : 0)); u.k0 = 2 * (p * q + (p < r ? p : r)); }
            return true; }
        int wgid = (int)L; { const int q = nwg / NXCD, r = nwg % NXCD, xcd = wgid % NXCD, off = wgid / NXCD; wgid = (xcd < r ? xcd * (q + 1) : r * (q + 1) + (xcd - r) * q) + off; }
        const int nig = WGM * nN, gid = wgid / nig, fm = gid * WGM, gsz = (nM - fm) < WGM ? (nM - fm) : WGM;
        u.pm = fm + ((wgid % nig) % gsz); u.pn = (wgid % nig) / gsz; return true;
    }
    __device__ __forceinline__ void a_ready(const Unit&) const {}
    __device__ __forceinline__ void done(const Unit&) const {}
};

__device__ __forceinline__ unsigned cvt_pk_bf16(float lo, float hi) { unsigned r; asm volatile("v_cvt_pk_bf16_f32 %0, %1, %2" : "=v"(r) : "v"(lo), "v"(hi)); return r; }
typedef float f32x2 __attribute__((ext_vector_type(2)));
__device__ __forceinline__ f32x2 gelu_pk(f32x2 v) {
    const f32x2 av = __builtin_elementwise_abs(v), d = av * 0.2316418882f + 1.0f;
    f32x2 t; t.x = __builtin_amdgcn_rcpf(d.x); t.y = __builtin_amdgcn_rcpf(d.y);
    f32x2 q = t * 0.5307027145f + (-0.7265760135f); q = q * t + 0.7107068705f; q = q * t + (-0.142248368f); q = q * t + 0.127414796f; q = q * t;
    const f32x2 s = (v * v) * (-0.72134752044f);
    f32x2 e; e.x = __builtin_amdgcn_exp2f(s.x); e.y = __builtin_amdgcn_exp2f(s.y);
    const f32x2 m = v * (q * e), r = v - m;
    f32x2 o; o.x = v.x < 0.f ? m.x : r.x; o.y = v.y < 0.f ? m.y : r.y; return o;
}

template <int ACT  > struct EpiBf16 {
    static constexpr bool PERM = true, AFTER_DRAIN = false; static_assert(ACT == 0 || ACT == 1, "EpiBf16: ACT is 0 (none) or 1 (gelu_pk)");
    bf16_t* O; int ldc; const float* bias; int split_cols; size_t split_stride; float scale0;
    __device__ __forceinline__ void operator()(const f32x4 (&acc)[2][2][4][2], const Unit& u, int wr, int wc, int fr, int fq) const {
        const int row0 = u.pm * BM + wr * 64 + fr; int colt = u.pn * BM; bf16_t* base = O;
        float sc = 1.f; if (split_cols) { const int t = colt / split_cols; base += (size_t)t * split_stride; colt -= t * split_cols; if (t == 0) sc = scale0; }
        const int col0 = colt + wc * 32 + 8 * fq, bcol0 = u.pn * BM + wc * 32 + 8 * fq;
        f32x4 bv[2][2];
#pragma unroll
        for (int bj = 0; bj < 2; ++bj)
#pragma unroll
            for (int n = 0; n < 2; ++n) bv[bj][n] = bias ? *(const f32x4*)(bias + bcol0 + bj * HALF + 4 * n) : (f32x4){0.f, 0.f, 0.f, 0.f};
#pragma unroll
        for (int ai = 0; ai < 2; ++ai)
#pragma unroll
            for (int m = 0; m < 4; ++m) { bf16_t* rowp = base + (size_t)(row0 + ai * HALF + m * 16) * ldc + col0;
#pragma unroll
                for (int bj = 0; bj < 2; ++bj) { f32x4 v0 = acc[ai][bj][m][0] + bv[bj][0], v1 = acc[ai][bj][m][1] + bv[bj][1];
                    if (ACT == 1) { f32x2 a = gelu_pk((f32x2){v0[0], v0[1]}), b = gelu_pk((f32x2){v0[2], v0[3]}), c = gelu_pk((f32x2){v1[0], v1[1]}), d = gelu_pk((f32x2){v1[2], v1[3]});
                        v0 = (f32x4){a.x, a.y, b.x, b.y}; v1 = (f32x4){c.x, c.y, d.x, d.y}; }
                    v0 = v0 * sc; v1 = v1 * sc; u32x4 w; w.x = cvt_pk_bf16(v0[0], v0[1]); w.y = cvt_pk_bf16(v0[2], v0[3]); w.z = cvt_pk_bf16(v1[0], v1[1]); w.w = cvt_pk_bf16(v1[2], v1[3]);
                    *(u32x4*)(rowp + bj * HALF) = w; } }
    }
};
template <class Epi, class Sched, bool ALIGN_EPI = false, bool SP2 = false>
__device__ __forceinline__ void gemm_phase(PG8_LAS unsigned char* lds, const Gemm g, const Sched& S, const Epi& E) {
    int tid_ = threadIdx.x; asm volatile("" : "+v"(tid_));
    const int tid = tid_, wid = __builtin_amdgcn_readfirstlane(tid >> 6), lane = tid & 63, wr = wid >> 2, wc = wid & 3, fr = lane & 15, fq = lane >> 4;
    const int K = g.K, nt = K / BK;
    unsigned voffA[2], voffB[2];
#pragma unroll
    for (int i = 0; i < 2; ++i) { int R, C; stage_rc(tid * 16 + i * 8192, R, C); const int Rb = Epi::PERM ? ((R & ~31) + perm32(R & 31)) : R;
        voffA[i] = (unsigned)(R * K + C) * 2u; voffB[i] = (unsigned)(Rb * K + C) * 2u; }
    const size_t kstep = (size_t)(BK * 2);
    const size_t hstep = (size_t)HALF * K * 2;
    const size_t tstep = 2 * hstep;
    const unsigned ldsw = (unsigned)wid * 1024u;
    const int aoff = lds_byte(wr * 64 + fr, fq * 8), boff = lds_byte(wc * 32 + fr, fq * 8);
#define PG8_SA(b, h) (((b) * 2 + (h)) * HTB)
#define PG8_SB(b, h) ((4 + (b) * 2 + (h)) * HTB)
#define PG8_STAGE(bufoff, gbase, voff) do { _Pragma("unroll") for (int _i = 0; _i < 2; ++_i) \
        __builtin_amdgcn_global_load_lds((const unsigned*)((const char*)(gbase) + (voff)[_i]), (PG8_LAS unsigned*)(lds + (bufoff) + ldsw + _i * 8192), 16, 0, 0); } while (0)
#define PG8_LDA(dst, b, h) do { _Pragma("unroll") for (int m = 0; m < 4; ++m) _Pragma("unroll") for (int k = 0; k < 2; ++k) dst[m][k] = *(const PG8_LAS bf16x8*)(lds + PG8_SA(b, h) + aoff + m * 2048 + k * 1024); } while (0)
#define PG8_LDB(dst, b, h) do { _Pragma("unroll") for (int n = 0; n < 2; ++n) _Pragma("unroll") for (int k = 0; k < 2; ++k) dst[n][k] = *(const PG8_LAS bf16x8*)(lds + PG8_SB(b, h) + boff + n * 2048 + k * 1024); } while (0)
#define PG8_MMA(ai, bj, At, Bt) do { __builtin_amdgcn_s_setprio(1); _Pragma("unroll") for (int m = 0; m < 4; ++m) _Pragma("unroll") for (int n = 0; n < 2; ++n) _Pragma("unroll") for (int k = 0; k < 2; ++k) \
        acc[ai][bj][m][n] = __builtin_amdgcn_mfma_f32_16x16x32_bf16(Bt[n][k], At[m][k], acc[ai][bj][m][n], 0, 0, 0); __builtin_amdgcn_s_setprio(0); } while (0)
#define PG8_WAIT_V(n) asm volatile("s_waitcnt vmcnt(" #n ")" ::: "memory")
#define PG8_WAIT_L(n) asm volatile("s_waitcnt lgkmcnt(" #n ")" ::: "memory")
#define PG8_BAR __builtin_amdgcn_s_barrier()
#define PG8_SCHED __builtin_amdgcn_sched_barrier(0)
    Unit cur, nxt; int ui = 0;
    if (!S.next(0, cur)) return;
    f32x4 acc[2][2][4][2];
#pragma unroll
    for (int a = 0; a < 2; ++a)
#pragma unroll
        for (int b = 0; b < 2; ++b)
#pragma unroll
            for (int m = 0; m < 4; ++m)
#pragma unroll
                for (int n = 0; n < 2; ++n) acc[a][b][m][n] = (f32x4){0.f, 0.f, 0.f, 0.f};
    bf16x8 At[4][2], B0[2][2], B1[2][2];
    const char* cA = (const char*)g.A + (size_t)cur.pm * tstep + (size_t)cur.k0 * kstep; const char* cB = (const char*)g.Bt + (size_t)cur.pn * tstep + (size_t)cur.k0 * kstep;
    S.a_ready(cur);
    if constexpr (SP2) {
        PG8_STAGE(PG8_SB(0, 0), cB, voffB); PG8_STAGE(PG8_SB(0, 1), cB + hstep, voffB); PG8_STAGE(PG8_SA(0, 0), cA, voffA); PG8_STAGE(PG8_SA(0, 1), cA + hstep, voffA);
        if (wr == 1) PG8_BAR;
        PG8_WAIT_V(2); PG8_BAR;
        PG8_STAGE(PG8_SB(1, 0), cB + kstep, voffB); PG8_STAGE(PG8_SA(1, 0), cA + kstep, voffA); PG8_STAGE(PG8_SB(1, 1), cB + hstep + kstep, voffB);
        PG8_WAIT_V(6); PG8_BAR;
    } else {
        PG8_STAGE(PG8_SB(0, 0), cB, voffB); PG8_STAGE(PG8_SA(0, 0), cA, voffA); PG8_STAGE(PG8_SB(0, 1), cB + hstep, voffB); PG8_STAGE(PG8_SA(0, 1), cA + hstep, voffA);
        if (wr == 1) PG8_BAR;
        PG8_WAIT_V(4); PG8_BAR;
        PG8_STAGE(PG8_SB(1, 0), cB + kstep, voffB); PG8_STAGE(PG8_SA(1, 0), cA + kstep, voffA); PG8_STAGE(PG8_SB(1, 1), cB + hstep + kstep, voffB);
        PG8_WAIT_V(6); PG8_BAR;
    }
    for (;;) {
        const bool has_next = S.next(ui + 1, nxt);
        const bool full = (cur.pm * BM + HALF) < PG8_ROWS_VALID;
        const char* nA = has_next ? (const char*)g.A + (size_t)nxt.pm * tstep + (size_t)nxt.k0 * kstep : cA; const char* nB = has_next ? (const char*)g.Bt + (size_t)nxt.pn * tstep + (size_t)nxt.k0 * kstep : cB;
        const int ntu = cur.nt;
        for (int t = 0; t < ntu; t += 2) {
            const bool last = (t == ntu - 2);
            const char* a1 = cA + (size_t)(t + 1) * kstep;
            const char* a2 = last ? nA : cA + (size_t)(t + 2) * kstep; const char* b2 = last ? nB : cB + (size_t)(t + 2) * kstep;
            const char* a3 = a2 + kstep; const char* b3 = b2 + kstep;
            if (last && has_next) S.a_ready(nxt);
            if constexpr (SP2) {
            PG8_LDB(B0, 0, 0); PG8_LDB(B1, 0, 1); PG8_SCHED; PG8_LDA(At, 0, 0); PG8_STAGE(PG8_SA(1, 1), a1 + hstep, voffA);
            PG8_WAIT_V(8); PG8_WAIT_L(0); PG8_BAR; PG8_MMA(0, 0, At, B0); PG8_MMA(0, 1, At, B1); PG8_BAR; PG8_SCHED;
            PG8_LDA(At, 0, 1); PG8_STAGE(PG8_SB(0, 0), b2, voffB); PG8_STAGE(PG8_SB(0, 1), b2 + hstep, voffB); PG8_STAGE(PG8_SA(0, 0), a2, voffA);
            PG8_WAIT_V(8); PG8_WAIT_L(0); PG8_BAR; if (full) { PG8_MMA(1, 0, At, B0); PG8_MMA(1, 1, At, B1); } PG8_BAR; PG8_SCHED;
            PG8_LDB(B0, 1, 0); PG8_LDB(B1, 1, 1); PG8_SCHED; PG8_LDA(At, 1, 0); PG8_STAGE(PG8_SA(0, 1), a2 + hstep, voffA);
            PG8_WAIT_V(8); PG8_WAIT_L(0); PG8_BAR; PG8_MMA(0, 0, At, B0); PG8_MMA(0, 1, At, B1); PG8_BAR; PG8_SCHED;
            PG8_LDA(At, 1, 1); PG8_STAGE(PG8_SB(1, 0), b3, voffB); PG8_STAGE(PG8_SB(1, 1), b3 + hstep, voffB); PG8_STAGE(PG8_SA(1, 0), a3, voffA);
            PG8_WAIT_V(8); PG8_WAIT_L(0); PG8_BAR; if (full) { PG8_MMA(1, 0, At, B0); PG8_MMA(1, 1, At, B1); } PG8_BAR; PG8_SCHED;
            } else {
            PG8_LDB(B0, 0, 0); PG8_SCHED; PG8_LDA(At, 0, 0); PG8_STAGE(PG8_SA(1, 1), a1 + hstep, voffA);
            PG8_WAIT_L(8); PG8_BAR; PG8_WAIT_L(0); PG8_MMA(0, 0, At, B0); PG8_BAR; PG8_SCHED;
            PG8_LDB(B1, 0, 1); PG8_STAGE(PG8_SB(0, 0), b2, voffB);
            PG8_BAR; PG8_WAIT_L(0); PG8_MMA(0, 1, At, B1); PG8_BAR;
            PG8_LDA(At, 0, 1); PG8_STAGE(PG8_SA(0, 0), a2, voffA);
            PG8_BAR; PG8_WAIT_L(0); PG8_MMA(1, 0, At, B0); PG8_BAR; PG8_SCHED;
            PG8_STAGE(PG8_SB(0, 1), b2 + hstep, voffB);
            PG8_WAIT_V(6); PG8_BAR; PG8_MMA(1, 1, At, B1); PG8_BAR;
            PG8_LDB(B0, 1, 0); PG8_SCHED; PG8_LDA(At, 1, 0); PG8_STAGE(PG8_SA(0, 1), a2 + hstep, voffA);
            PG8_WAIT_L(8); PG8_BAR; PG8_WAIT_L(0); PG8_MMA(0, 0, At, B0); PG8_BAR; PG8_SCHED;
            PG8_LDB(B1, 1, 1); PG8_STAGE(PG8_SB(1, 0), b3, voffB);
            PG8_BAR; PG8_WAIT_L(0); PG8_MMA(0, 1, At, B1); PG8_BAR;
            PG8_LDA(At, 1, 1); PG8_STAGE(PG8_SA(1, 0), a3, voffA);
            PG8_BAR; PG8_WAIT_L(0); PG8_MMA(1, 0, At, B0); PG8_BAR; PG8_SCHED;
            PG8_STAGE(PG8_SB(1, 1), b3 + hstep, voffB);
            PG8_WAIT_V(6); PG8_BAR; PG8_MMA(1, 1, At, B1); PG8_BAR;
            }
        }
        if constexpr (ALIGN_EPI) { if (wr == 0) PG8_BAR; }
        if constexpr (!Epi::AFTER_DRAIN) { E(acc, cur, wr, wc, fr, fq); S.done(cur); }
        if (!has_next) break;
#pragma unroll
        for (int a = 0; a < 2; ++a)
#pragma unroll
            for (int b = 0; b < 2; ++b)
#pragma unroll
                for (int m = 0; m < 4; ++m)
#pragma unroll
                    for (int n = 0; n < 2; ++n) acc[a][b][m][n] = (f32x4){0.f, 0.f, 0.f, 0.f};
        cur = nxt; cA = nA; cB = nB; ++ui;
        if constexpr (ALIGN_EPI) { if (wr == 1) PG8_BAR; }
    }
    PG8_WAIT_V(0);
    if constexpr (!ALIGN_EPI) { if (wr == 0) PG8_BAR; }
    PG8_BAR;
    if constexpr (Epi::AFTER_DRAIN) { E.fused(acc, cur, wr, wc, fr, fq, lds, wid, lane); S.done(cur); }
#undef PG8_SA
#undef PG8_SB
#undef PG8_STAGE
#undef PG8_LDA
#undef PG8_LDB
#undef PG8_MMA
#undef PG8_WAIT_V
#undef PG8_WAIT_L
#undef PG8_BAR
#undef PG8_SCHED
}
}

namespace att {
using bf16 = __hip_bfloat16;
constexpr int D = 128, NW = 8, QBLK = 32, KVBLK = 64;
constexpr float SCALE = 0.088388347648318440f;
constexpr float THR = 8.f;
constexpr int SDEPTH = 2;
constexpr int LDQ = 1536, LDK = 1536, LDO = 1024;
constexpr size_t SHM_V = KVBLK * D * 2, SHM_K = KVBLK * D * 2, SHM_ATTN = 2 * SHM_V + 2 * SHM_K + NW * 64 * 4;
using bf16x8 = __attribute__((ext_vector_type(8))) short;
using s16x4  = __attribute__((ext_vector_type(4))) short;
using f32x16 = __attribute__((ext_vector_type(16))) float;
using u32x4  = __attribute__((ext_vector_type(4))) unsigned;
#define KSWZ(row, colB) ((row) * 256 + ((colB) ^ (((row) & 7) << 4)))
#define SBAR() __builtin_amdgcn_sched_barrier(0)
__device__ __forceinline__ int crow(int r, int hi) { return (r & 3) + 8 * (r >> 2) + 4 * hi; }
__device__ __forceinline__ unsigned cvtpk(float lo, float hi) {
  unsigned r; asm volatile("v_cvt_pk_bf16_f32 %0, %1, %2" : "=v"(r) : "v"(lo), "v"(hi)); return r;
}
__device__ __forceinline__ bf16x8 ld8(const bf16* p) { return *reinterpret_cast<const bf16x8*>(p); }

__device__ __forceinline__ void partialSM(f32x16& p0, f32x16& p1, float& m_reg, float& mn, float& alpha) {
  constexpr float THRL = THR * 1.4426950408889634f;
  float pmax = p0[0]; for (int r = 1; r < 16; ++r) pmax = fmaxf(pmax, p0[r]); for (int r = 0; r < 16; ++r) pmax = fmaxf(pmax, p1[r]);
  { auto rr = __builtin_amdgcn_permlane32_swap(__float_as_uint(pmax), __float_as_uint(pmax), false, false);
    pmax = fmaxf(__uint_as_float(rr[0]), __uint_as_float(rr[1])); }
  if (__builtin_expect(__all(pmax - m_reg <= THRL), 1)) { mn = m_reg; alpha = 1.f; }
  else { mn = fmaxf(m_reg, pmax); alpha = __builtin_amdgcn_exp2f(m_reg - mn); m_reg = mn; }
  for (int r = 0; r < 16; ++r) p0[r] = p0[r] - mn; for (int r = 0; r < 16; ++r) p1[r] = p1[r] - mn;
  for (int r = 0; r < 16; ++r) p0[r] = __builtin_amdgcn_exp2f(p0[r]);
}
__device__ __forceinline__ void partialSM_fixed(f32x16& p0) {
  for (int r = 0; r < 16; ++r) p0[r] = __builtin_amdgcn_exp2f(p0[r]);
}
__device__ __forceinline__ void finishSM(f32x16& p0, f32x16& p1, float alpha, float& l_reg, bf16x8& pa0, bf16x8& pa1, bf16x8& pa2, bf16x8& pa3) {
  for (int r = 0; r < 16; ++r) p1[r] = __builtin_amdgcn_exp2f(p1[r]);
  float ps = 0; for (int r = 0; r < 16; ++r) ps += p0[r]; for (int r = 0; r < 16; ++r) ps += p1[r];
  { auto rr = __builtin_amdgcn_permlane32_swap(__float_as_uint(ps), __float_as_uint(ps), false, false);
    ps = __uint_as_float(rr[0]) + __uint_as_float(rr[1]); }
  l_reg = l_reg * alpha + ps;
#define PK4(P, BASE, OUT) do { unsigned a0 = cvtpk(P[BASE + 0], P[BASE + 1]), a1 = cvtpk(P[BASE + 2], P[BASE + 3]);   \
    unsigned b0 = cvtpk(P[BASE + 4], P[BASE + 5]), b1 = cvtpk(P[BASE + 6], P[BASE + 7]);                              \
    auto r0 = __builtin_amdgcn_permlane32_swap(a0, b0, false, false); auto r1 = __builtin_amdgcn_permlane32_swap(a1, b1, false, false); \
    u32x4 w = {r0[0], r1[0], r0[1], r1[1]}; OUT = *reinterpret_cast<bf16x8*>(&w); } while (0)
  PK4(p0, 0, pa0); PK4(p0, 8, pa1); PK4(p1, 0, pa2); PK4(p1, 8, pa3);
#undef PK4
}
__device__ __forceinline__ void qkt(f32x16& p0, f32x16& p1, const bf16* Ks, const bf16x8* qr, int r32, int hi) {
  p0 = f32x16{}; p1 = f32x16{};
  for (int d0 = 0; d0 < 8; ++d0) { int cb = (d0 * 16 + hi * 8) * 2;
    bf16x8 b0 = *reinterpret_cast<const bf16x8*>((const char*)Ks + KSWZ(r32, cb));
    bf16x8 b1 = *reinterpret_cast<const bf16x8*>((const char*)Ks + KSWZ(32 + r32, cb));
    p0 = __builtin_amdgcn_mfma_f32_32x32x16_bf16(b0, qr[d0], p0, 0, 0, 0);
    p1 = __builtin_amdgcn_mfma_f32_32x32x16_bf16(b1, qr[d0], p1, 0, 0, 0); }
}
__device__ __forceinline__ int v_st(int k, int c) { const int kk = (k & ~0xC) | ((k & 4) << 1) | ((k & 8) >> 1); return ((kk >> 3) * 4 + (c >> 5)) * 512 + ((kk & 7) * 32 + (c & 31)) * 2; }
__device__ __forceinline__ int v_rd_base(int lane) { return ((lane & 3) << 3) | (((lane >> 2) & 3) << 6) | (((lane >> 4) & 1) << 5) | (((lane >> 5) & 1) << 8); }
constexpr int v_rd_off(int d0, int ks, int half) { return d0 * 512 + ks * 4096 + half * 2048; }
template <int OFF> __device__ __forceinline__ s16x4 tr_read(int vb) {
  s16x4 r; asm volatile("ds_read_b64_tr_b16 %0, %1 offset:%2" : "=&v"(r) : "v"(vb), "i"(OFF) : "memory"); return r;
}
template <int D0> __device__ __forceinline__ void pv_one(f32x16& od, int vb, bf16x8 pa0, bf16x8 pa1, bf16x8 pa2, bf16x8 pa3) {
  const s16x4 l0 = tr_read<v_rd_off(D0, 0, 0)>(vb), h0 = tr_read<v_rd_off(D0, 0, 1)>(vb), l1 = tr_read<v_rd_off(D0, 1, 0)>(vb), h1 = tr_read<v_rd_off(D0, 1, 1)>(vb);
  const s16x4 l2 = tr_read<v_rd_off(D0, 2, 0)>(vb), h2 = tr_read<v_rd_off(D0, 2, 1)>(vb), l3 = tr_read<v_rd_off(D0, 3, 0)>(vb), h3 = tr_read<v_rd_off(D0, 3, 1)>(vb);
  asm volatile("s_waitcnt lgkmcnt(0)" ::: "memory"); SBAR();
#define PK(L, H) (bf16x8){L[0], L[1], L[2], L[3], H[0], H[1], H[2], H[3]}
  od = __builtin_amdgcn_mfma_f32_32x32x16_bf16(pa0, PK(l0, h0), od, 0, 0, 0);
  od = __builtin_amdgcn_mfma_f32_32x32x16_bf16(pa1, PK(l1, h1), od, 0, 0, 0);
  od = __builtin_amdgcn_mfma_f32_32x32x16_bf16(pa2, PK(l2, h2), od, 0, 0, 0);
  od = __builtin_amdgcn_mfma_f32_32x32x16_bf16(pa3, PK(l3, h3), od, 0, 0, 0);
#undef PK
}
__device__ __forceinline__ void pv_d0(f32x16* o, int vb, bf16x8 pa0, bf16x8 pa1, bf16x8 pa2, bf16x8 pa3) {
  pv_one<0>(o[0], vb, pa0, pa1, pa2, pa3); pv_one<1>(o[1], vb, pa0, pa1, pa2, pa3); pv_one<2>(o[2], vb, pa0, pa1, pa2, pa3); pv_one<3>(o[3], vb, pa0, pa1, pa2, pa3);
}

struct AttSlot { bf16x8 vs0, vs1, ks0, ks1; };
struct AttCarry { bf16x8 qr[8]; AttSlot s[2]; };
__device__ __forceinline__ void att_preload(AttCarry& cy, const bf16* Qrow, const bf16* Kh, const bf16* Vh) {
  const int tid = threadIdx.x, sr = tid >> 4, sc = (tid & 15) * 8;
#pragma unroll
  for (int d0 = 0; d0 < 8; ++d0) cy.qr[d0] = ld8(Qrow + d0 * 16);
#pragma unroll
  for (int i = 0; i < 2; ++i) { const int k0 = i * KVBLK;
    cy.s[i].vs0 = ld8(&Vh[(long)(k0 + sr) * LDK + sc]); cy.s[i].vs1 = ld8(&Vh[(long)(k0 + 32 + sr) * LDK + sc]);
    cy.s[i].ks0 = ld8(&Kh[(long)(k0 + sr) * LDK + sc]); cy.s[i].ks1 = ld8(&Kh[(long)(k0 + 32 + sr) * LDK + sc]); }
}
template <bool PARTIAL, bool FIXED>
__device__ __forceinline__ void attn_unit(const bf16* __restrict__ Qrow, const bf16* __restrict__ Kh, const bf16* __restrict__ Vh,
                                          bf16* __restrict__ Ob, int NT, bool mask_last, float* __restrict__ PO, char* lds) {
  AttCarry cy;
  int tid_ = threadIdx.x; asm volatile("" : "+v"(tid_));
  const int tid = tid_, wid = tid >> 6, lane = tid & 63, r32 = lane & 31, hi = lane >> 5;
  bf16* V_lds = (bf16*)lds; bf16* K_lds = (bf16*)(lds + 3 * SHM_V);
  float* ws = (float*)(lds + 3 * SHM_V + 3 * SHM_K) + wid * 64; float* li_l = ws; float* al_l = ws + 32;
  float m_reg = FIXED ? 0.f : -1e30f, l_reg = 0; f32x16 o[4] = {}; bf16x8 (&qr)[8] = cy.qr;
  const bf16* Qw = Qrow;
  const int sr = tid >> 4, sc = (tid & 15) * 8, vst0 = v_st(sr, sc), vst1 = v_st(32 + sr, sc);
  const int vb0 = (int)(uintptr_t)V_lds + v_rd_base(lane);
  AttSlot (&sr_)[2] = cy.s;
#define SLOAD(i, k0) do { sr_[i].vs0 = ld8(&Vh[(long)((k0) + sr) * LDK + sc]); sr_[i].vs1 = ld8(&Vh[(long)((k0) + 32 + sr) * LDK + sc]); \
    sr_[i].ks0 = ld8(&Kh[(long)((k0) + sr) * LDK + sc]); sr_[i].ks1 = ld8(&Kh[(long)((k0) + 32 + sr) * LDK + sc]); } while (0)
#define SLOADP(i, Kp, Vp, k0) do { sr_[i].vs0 = ld8(&(Vp)[(long)((k0) + sr) * LDK + sc]); sr_[i].vs1 = ld8(&(Vp)[(long)((k0) + 32 + sr) * LDK + sc]); \
    sr_[i].ks0 = ld8(&(Kp)[(long)((k0) + sr) * LDK + sc]); sr_[i].ks1 = ld8(&(Kp)[(long)((k0) + 32 + sr) * LDK + sc]); } while (0)
#define SWRITE(b, i) do { *(bf16x8*)((char*)V_lds + (b) * SHM_V + vst0) = sr_[i].vs0;          \
    *(bf16x8*)((char*)V_lds + (b) * SHM_V + vst1) = sr_[i].vs1; int kc = sc * 2;               \
    *(bf16x8*)((char*)K_lds + (b) * SHM_K + KSWZ(sr, kc)) = sr_[i].ks0;                       \
    *(bf16x8*)((char*)K_lds + (b) * SHM_K + KSWZ(32 + sr, kc)) = sr_[i].ks1; } while (0)
#define SWAIT() asm volatile("s_waitcnt vmcnt(4)" ::: "memory")
#define RESC(a) do { if (__any((a) < 1.f)) { if (hi == 0) al_l[r32] = (a); asm volatile("s_waitcnt lgkmcnt(0)" ::: "memory"); \
    for (int d = 0; d < 4; ++d) for (int r = 0; r < 16; ++r) o[d][r] *= al_l[crow(r, hi)]; } } while (0)
  f32x16 pA0, pA1, pB0, pB1; float mnA, mnB, alA, alB; bf16x8 pa0, pa1, pa2, pa3;
  int bp = 0, bc = 1, bn = 2;
#pragma unroll
  for (int d0 = 0; d0 < 8; ++d0) qr[d0] = ld8(Qw + d0 * 16);
  SLOAD(0, 0); SLOAD(1, KVBLK);
  SWRITE(0, 0); __syncthreads();
  qkt(pA0, pA1, K_lds, qr, r32, hi);
  SLOAD(0, 2 * KVBLK); SBAR();
  if constexpr (FIXED) { partialSM_fixed(pA0); alA = 1.f; } else partialSM(pA0, pA1, m_reg, mnA, alA);
  SWAIT(); SWRITE(1, 1);
#define ROT3() do { const int t_ = bp; bp = bc; bc = bn; bn = t_; } while (0)
  int j = 1;
  for (; j + 2 < NT; j += 2) {
    __syncthreads();
    SBAR(); qkt(pB0, pB1, (bf16*)((char*)K_lds + bc * SHM_K), qr, r32, hi);
    finishSM(pA0, pA1, alA, l_reg, pa0, pa1, pa2, pa3); SBAR();
    SLOAD(1, (j + 2) * KVBLK); SBAR();
    pv_d0(o, vb0 + bp * (int)SHM_V, pa0, pa1, pa2, pa3);
    if constexpr (FIXED) { partialSM_fixed(pB0); alB = 1.f; } else { partialSM(pB0, pB1, m_reg, mnB, alB); RESC(alB); }
    SWAIT(); SWRITE(bn, 0);
    ROT3();
    __syncthreads();
    SBAR(); qkt(pA0, pA1, (bf16*)((char*)K_lds + bc * SHM_K), qr, r32, hi);
    finishSM(pB0, pB1, alB, l_reg, pa0, pa1, pa2, pa3); SBAR();
    SLOAD(0, (j + 3) * KVBLK); SBAR();
    pv_d0(o, vb0 + bp * (int)SHM_V, pa0, pa1, pa2, pa3);
    if constexpr (FIXED) { partialSM_fixed(pA0); alA = 1.f; } else { partialSM(pA0, pA1, m_reg, mnA, alA); RESC(alA); }
    SWAIT(); SWRITE(bn, 1);
    ROT3();
  }
  {
    __syncthreads();
    SBAR(); qkt(pB0, pB1, (bf16*)((char*)K_lds + bc * SHM_K), qr, r32, hi);
    finishSM(pA0, pA1, alA, l_reg, pa0, pa1, pa2, pa3); SBAR();
    pv_d0(o, vb0 + bp * (int)SHM_V, pa0, pa1, pa2, pa3);
    if constexpr (FIXED) { partialSM_fixed(pB0); alB = 1.f; } else { partialSM(pB0, pB1, m_reg, mnB, alB); RESC(alB); }
    SWRITE(bn, 0);
    ROT3();
    __syncthreads();
    SBAR(); qkt(pA0, pA1, (bf16*)((char*)K_lds + bc * SHM_K), qr, r32, hi);
    if (mask_last) {
      asm volatile("; masked tail tile" ::: "memory");
      const float NEG = -INFINITY;
#pragma unroll
      for (int r = 8; r < 16; ++r) pA0[r] = NEG;
#pragma unroll
      for (int r = 0; r < 16; ++r) pA1[r] = NEG;
    }
    finishSM(pB0, pB1, alB, l_reg, pa0, pa1, pa2, pa3); SBAR();
    pv_d0(o, vb0 + bp * (int)SHM_V, pa0, pa1, pa2, pa3);
    if constexpr (FIXED) { partialSM_fixed(pA0); alA = 1.f; } else { partialSM(pA0, pA1, m_reg, mnA, alA); RESC(alA); }
    ROT3();
  }
#undef ROT3
  SBAR(); finishSM(pA0, pA1, alA, l_reg, pa0, pa1, pa2, pa3); SBAR();
  pv_d0(o, vb0 + bp * (int)SHM_V, pa0, pa1, pa2, pa3);
  if (PARTIAL) {
    if (wid < 2) { float* po = PO + (wid * QBLK) * 128;
#pragma unroll
      for (int r = 0; r < 16; ++r) { const int orow = crow(r, hi);
#pragma unroll
        for (int d0 = 0; d0 < 4; ++d0) po[orow * 128 + d0 * 32 + r32] = o[d0][r]; }
      if (hi == 0) { PO[8192 + (wid * QBLK + r32) * 2] = m_reg; PO[8192 + (wid * QBLK + r32) * 2 + 1] = l_reg; } }
    __syncthreads();
    return;
  }
  if (hi == 0) li_l[r32] = l_reg; asm volatile("s_waitcnt lgkmcnt(0)" ::: "memory");
  float rli[16];
#pragma unroll
  for (int r = 0; r < 16; ++r) rli[r] = __builtin_amdgcn_rcpf(li_l[crow(r, hi)]);
  __syncthreads();
  unsigned short* stg = (unsigned short*)(lds + wid * 8192);
#pragma unroll
  for (int r = 0; r < 16; ++r) { const int orow = crow(r, hi);
#pragma unroll
    for (int d0 = 0; d0 < 4; ++d0) { const float v = o[d0][r] * rli[r]; stg[orow * 128 + d0 * 32 + r32] = (unsigned short)(cvtpk(v, v) & 0xffffu); } }
  asm volatile("s_waitcnt lgkmcnt(0)" ::: "memory");
#pragma unroll
  for (int it = 0; it < 8; ++it) { const int row = it * 4 + (lane >> 4), c16 = lane & 15;
    const bf16x8 v = *reinterpret_cast<const bf16x8*>((const char*)stg + row * 256 + c16 * 16);
    *reinterpret_cast<bf16x8*>(Ob + (long)(wid * QBLK + row) * LDO + c16 * 8) = v; }
  __syncthreads();
#undef SLOAD
#undef SLOADP
#undef SWRITE
#undef SWAIT
#undef RESC
}
#undef KSWZ
#undef SBAR
}

#define LAS __attribute__((address_space(3)))
typedef unsigned short bf16raw;
typedef short bf16x8 __attribute__((ext_vector_type(8)));
typedef float f32x4 __attribute__((ext_vector_type(4)));
typedef float f32x2 __attribute__((ext_vector_type(2)));
typedef unsigned u32x4 __attribute__((ext_vector_type(4)));
typedef unsigned u32x2 __attribute__((ext_vector_type(2)));

constexpr int DM = 1024, NB = 8, SEQ = 8192, NMETA = 16, LTOK = SEQ + NMETA, MTOK = NB * LTOK, MPAD = 65792;
constexpr int DFF = 2816, QKVD = 1536, NTHREADS = 512;
constexpr float RMS_EPS = 1e-6f;
constexpr int LDS_BYTES = 147456;
static_assert(MPAD % 256 == 0 && MPAD >= MTOK + 128, "row padding");
constexpr size_t WS_H = 0;
constexpr size_t WS_U = WS_H + (size_t)MPAD * DM * 4;
constexpr size_t WS_BIG = WS_U + (size_t)MPAD * DM * 2;
constexpr size_t WS_MB = WS_BIG + (size_t)MPAD * DFF * 2;
constexpr size_t WS_W = WS_MB + (size_t)MPAD * DM * 2;
constexpr size_t WO_LRU_IN = 0, WO_LRU_OUT = WO_LRU_IN + 2ul * 2048 * 1024, WO_GATE = WO_LRU_OUT + 2ul * 1024 * 1024, WO_QKV = WO_GATE + 64ul * 128 * 128,
                 WO_AO = WO_QKV + 2ul * 1536 * 1024, WO_F1 = WO_AO + 2ul * 1024 * 1024, WO_F2 = WO_F1 + 4ul * 5632 * 1024, WO_END = WO_F2 + 4ul * 1024 * 2816;
constexpr int LT = 48, NCHUNK = LTOK / LT;
static_assert(NCHUNK * LT == LTOK, "chunking");
constexpr size_t WS_SUM = WS_W + WO_END * 2;
constexpr size_t WS_CARRY = WS_SUM + (size_t)NB * NCHUNK * 2 * 1024 * 8;
constexpr size_t WS_ROPE = WS_CARRY + (size_t)NB * NCHUNK * 2 * 1024 * 4;
constexpr size_t WS_CTL = WS_ROPE + 128 * 32 * 8;
constexpr size_t WS_TAILP = WS_CTL + 16384;
constexpr size_t WS_END = WS_TAILP + 4ul * 128 * 1024 * 4;
constexpr int MREG = 65536, TAIL_S = 4;
constexpr int LDS_MISC = 147200;

__device__ __forceinline__ unsigned cvt_pk(float lo, float hi) { unsigned r; asm volatile("v_cvt_pk_bf16_f32 %0, %1, %2" : "=v"(r) : "v"(lo), "v"(hi)); return r; }
__device__ __forceinline__ float bf_lo(unsigned w) { return __uint_as_float(w << 16); }
__device__ __forceinline__ float bf_hi(unsigned w) { return __uint_as_float(w & 0xffff0000u); }
__device__ __forceinline__ float wave_sum(float v) {
#pragma unroll
    for (int o = 1; o < 64; o <<= 1) v += __shfl_xor(v, o);
    return v;
}
__device__ __forceinline__ float sigmoidf_fast(float x) { return __builtin_amdgcn_rcpf(1.0f + __builtin_amdgcn_exp2f(-1.4426950408889634f * x)); }
__device__ __forceinline__ float gelu_tanh(float x) {
    const float z = x * (1.0f + 0.044715f * x * x) * (2.0f * 0.7978845608028654f);
    return x * sigmoidf_fast(z);
}

struct EpiPlain {
    static constexpr bool PERM = true, AFTER_DRAIN = false, ALIGN = true;
    bf16raw* O; int ldc; const float* rs; float* tailp;
    __device__ __forceinline__ void operator()(const f32x4 (&acc)[2][2][4][2], const pg8::Unit& u, int wr, int wc, int fr, int fq) const {
        const int row0 = u.pm * 256 + wr * 64 + fr, col0 = u.pn * 256 + wc * 32 + 8 * fq;
        if (tailp && u.pm * 256 >= MREG) {
#pragma unroll
            for (int m = 0; m < 4; ++m) { float* rowp = tailp + ((size_t)u.part * 128 + wr * 64 + m * 16 + fr) * 1024 + col0;
#pragma unroll
                for (int bj = 0; bj < 2; ++bj) { *(f32x4*)(rowp + bj * 128) = acc[0][bj][m][0]; *(f32x4*)(rowp + bj * 128 + 4) = acc[0][bj][m][1]; } }
            return; }
#pragma unroll
        for (int ai = 0; ai < 2; ++ai)
#pragma unroll
            for (int m = 0; m < 4; ++m) { bf16raw* rowp = O + (size_t)(row0 + ai * 128 + m * 16) * ldc + col0; const float sc = rs ? rs[row0 + ai * 128 + m * 16] : 1.0f;
#pragma unroll
                for (int bj = 0; bj < 2; ++bj) { const f32x4 v0 = acc[ai][bj][m][0] * sc, v1 = acc[ai][bj][m][1] * sc;
                    u32x4 w; w.x = cvt_pk(v0[0], v0[1]); w.y = cvt_pk(v0[2], v0[3]); w.z = cvt_pk(v1[0], v1[1]); w.w = cvt_pk(v1[2], v1[3]);
                    *(u32x4*)(rowp + bj * 128) = w; } }
    }
};
struct EpiLruIn {
    static constexpr bool PERM = true, AFTER_DRAIN = false, ALIGN = true;
    bf16raw* Y; bf16raw* X; const float* rs;
    __device__ __forceinline__ void operator()(const f32x4 (&acc)[2][2][4][2], const pg8::Unit& u, int wr, int wc, int fr, int fq) const {
        const bool isy = u.pn < 4; bf16raw* base = isy ? Y : X;
        const int row0 = u.pm * 256 + wr * 64 + fr, col0 = (isy ? u.pn : u.pn - 4) * 256 + wc * 32 + 8 * fq;
#pragma unroll
        for (int ai = 0; ai < 2; ++ai)
#pragma unroll
            for (int m = 0; m < 4; ++m) { bf16raw* rowp = base + (size_t)(row0 + ai * 128 + m * 16) * DM + col0; const float sc = rs[row0 + ai * 128 + m * 16];
#pragma unroll
                for (int bj = 0; bj < 2; ++bj) { f32x4 v0 = acc[ai][bj][m][0] * sc, v1 = acc[ai][bj][m][1] * sc;
                    if (isy) {
#pragma unroll
                        for (int i = 0; i < 4; ++i) { v0[i] = gelu_tanh(v0[i]); v1[i] = gelu_tanh(v1[i]); } }
                    u32x4 w; w.x = cvt_pk(v0[0], v0[1]); w.y = cvt_pk(v0[2], v0[3]); w.z = cvt_pk(v1[0], v1[1]); w.w = cvt_pk(v1[2], v1[3]);
                    *(u32x4*)(rowp + bj * 128) = w; } }
    }
};
struct EpiSwiglu {
    static constexpr bool PERM = true, AFTER_DRAIN = false, ALIGN = true;
    bf16raw* O; const float* rs;
    __device__ __forceinline__ void operator()(const f32x4 (&acc)[2][2][4][2], const pg8::Unit& u, int wr, int wc, int fr, int fq) const {
        const int row0 = u.pm * 256 + wr * 64 + fr, col0 = u.pn * 128 + wc * 32 + 8 * fq;
#pragma unroll
        for (int ai = 0; ai < 2; ++ai)
#pragma unroll
            for (int m = 0; m < 4; ++m) { bf16raw* rowp = O + (size_t)(row0 + ai * 128 + m * 16) * DFF + col0; const float sc = rs[row0 + ai * 128 + m * 16];
                unsigned wv[4];
#pragma unroll
                for (int n = 0; n < 2; ++n)
#pragma unroll
                    for (int ip = 0; ip < 4; ip += 2) {
                        const f32x2 g = (f32x2){acc[ai][0][m][n][ip], acc[ai][0][m][n][ip + 1]} * sc, up = (f32x2){acc[ai][1][m][n][ip], acc[ai][1][m][n][ip + 1]} * sc;
                        const f32x2 t = g * (-1.4426950408889634f);
                        f32x2 ex; ex.x = __builtin_amdgcn_exp2f(t.x); ex.y = __builtin_amdgcn_exp2f(t.y);
                        ex = ex + 1.0f;
                        f32x2 rc; rc.x = __builtin_amdgcn_rcpf(ex.x); rc.y = __builtin_amdgcn_rcpf(ex.y);
                        const f32x2 r = g * rc * up;
                        wv[n * 2 + (ip >> 1)] = cvt_pk(r.x, r.y); }
                u32x4 w; w.x = wv[0]; w.y = wv[1]; w.z = wv[2]; w.w = wv[3];
                *(u32x4*)rowp = w; }
    }
};

struct EpiQkv {
    static constexpr bool PERM = true, AFTER_DRAIN = false, ALIGN = true;
    bf16raw* O; const float* rs; const float* qg; const float* kg; const f32x2* tab; LAS float* ss;
    __device__ __forceinline__ void operator()(const f32x4 (&acc)[2][2][4][2], const pg8::Unit& u, int wr, int wc, int fr, int fq) const {
        const int row0 = u.pm * 256 + wr * 64 + fr, col0 = u.pn * 256 + wc * 32 + 8 * fq;
        if (u.pn == 5) {
#pragma unroll
            for (int ai = 0; ai < 2; ++ai)
#pragma unroll
                for (int m = 0; m < 4; ++m) { bf16raw* rowp = O + (size_t)(row0 + ai * 128 + m * 16) * QKVD + col0; const float sc = rs[row0 + ai * 128 + m * 16];
#pragma unroll
                    for (int bj = 0; bj < 2; ++bj) { const f32x4 v0 = acc[ai][bj][m][0] * sc, v1 = acc[ai][bj][m][1] * sc;
                        u32x4 w; w.x = cvt_pk(v0[0], v0[1]); w.y = cvt_pk(v0[2], v0[3]); w.z = cvt_pk(v1[0], v1[1]); w.w = cvt_pk(v1[2], v1[3]);
                        *(u32x4*)(rowp + bj * 128) = w; } }
            return; }
#pragma unroll
        for (int ai = 0; ai < 2; ++ai)
#pragma unroll
            for (int m = 0; m < 4; ++m) { const float sc = rs[row0 + ai * 128 + m * 16];
#pragma unroll
                for (int bj = 0; bj < 2; ++bj) { const f32x4 v0 = acc[ai][bj][m][0] * sc, v1 = acc[ai][bj][m][1] * sc;
                    float s = (v0[0] * v0[0] + v0[1] * v0[1]) + (v0[2] * v0[2] + v0[3] * v0[3]) + (v1[0] * v1[0] + v1[1] * v1[1]) + (v1[2] * v1[2] + v1[3] * v1[3]);
                    s += __shfl_xor(s, 16); s += __shfl_xor(s, 32);
                    if (fq == 0) ss[(bj * 4 + wc) * 256 + ai * 128 + wr * 64 + m * 16 + fr] = s; } }
        asm volatile("s_waitcnt lgkmcnt(0)" ::: "memory"); __builtin_amdgcn_s_barrier(); asm volatile("" ::: "memory");
        const int axis = wc >> 1, p0 = (wc & 1) * 16 + 4 * fq, d1 = axis * 64 + p0;
        const float* gsrc = (u.pn == 4) ? kg : qg; const float qsc = (u.pn == 4) ? 1.0f : 0.088388347648318440f * 1.4426950408889634f;
        const f32x4 g1 = *(const f32x4*)(gsrc + d1), g2 = *(const f32x4*)(gsrc + d1 + 32);
#pragma unroll
        for (int ai = 0; ai < 2; ++ai)
#pragma unroll
            for (int m = 0; m < 4; ++m) { const int row = row0 + ai * 128 + m * 16, rl = ai * 128 + wr * 64 + m * 16 + fr; const float sc = rs[row];
                const int rr = row < MTOK ? row : 0, b = rr / LTOK, t = rr - b * LTOK;
                f32x4 cc = (f32x4){1.f, 1.f, 1.f, 1.f}, sn = (f32x4){0.f, 0.f, 0.f, 0.f};
                if (t >= NMETA) { const int s = t - NMETA, pos = axis ? (s & 63) : (s >> 6); const f32x4 t0 = *(const f32x4*)(tab + pos * 32 + p0), t1 = *(const f32x4*)(tab + pos * 32 + p0 + 2);
                    cc = (f32x4){t0[0], t0[2], t1[0], t1[2]}; sn = (f32x4){t0[1], t0[3], t1[1], t1[3]}; }
                bf16raw* rowp = O + (size_t)row * QKVD + col0;
#pragma unroll
                for (int bj = 0; bj < 2; ++bj) { const LAS float* sp = ss + bj * 1024 + rl;
                    const float tot = (sp[0] + sp[256]) + (sp[512] + sp[768]);
                    const float rn = (1.0f / sqrtf(tot * (1.0f / 128.0f) + RMS_EPS)) * sc * qsc;
                    const f32x4 n1 = acc[ai][bj][m][0] * rn * g1, n2 = acc[ai][bj][m][1] * rn * g2;
                    const f32x4 o1 = n1 * cc - n2 * sn, o2 = n2 * cc + n1 * sn;
                    u32x4 w; w.x = cvt_pk(o1[0], o1[1]); w.y = cvt_pk(o1[2], o1[3]); w.z = cvt_pk(o2[0], o2[1]); w.w = cvt_pk(o2[2], o2[3]);
                    *(u32x4*)(rowp + bj * 128) = w; } }
    }
};

__device__ __forceinline__ void transpose_item(const float* W, int K, int N, bf16raw* WT, int perm, const float* gk, LAS float* scr, int item, int lane) {
    const int nblk = N / 32, kb = item / nblk, nb = item % nblk, k0 = 64 * kb, n0 = 32 * nb;
    int d0 = n0;
    if (perm == 1) { const int j = n0 < DFF ? n0 : n0 - DFF; d0 = (j >> 7) * 256 + (j & 127) + (n0 < DFF ? 0 : 128); }
#pragma unroll 8
    for (int i = 0; i < 32; ++i) { const int kk = 2 * i + (lane >> 5); const float gsc = gk ? gk[k0 + kk] : 1.0f; scr[kk * 33 + (lane & 31)] = W[(size_t)(k0 + kk) * N + n0 + (lane & 31)] * gsc; }
    asm volatile("s_waitcnt lgkmcnt(0)" ::: "memory");
    const int c = lane & 7;
#pragma unroll
    for (int j = 0; j < 4; ++j) { const int n = (lane >> 3) + 8 * j; const LAS float* s = scr + (8 * c) * 33 + n;
        u32x4 o; o.x = cvt_pk(s[0 * 33], s[1 * 33]); o.y = cvt_pk(s[2 * 33], s[3 * 33]); o.z = cvt_pk(s[4 * 33], s[5 * 33]); o.w = cvt_pk(s[6 * 33], s[7 * 33]);
        int dr = d0 + n;
        if (perm == 2) { const int ns = n0 + n; if (ns < 1280) { const int hd = ns >> 7, d = ns & 127, ax = d >> 6, hf = (d >> 5) & 1, p = d & 31;
                dr = hd * 128 + 32 * (ax * 2 + (p >> 4)) + 8 * ((p >> 2) & 3) + 4 * hf + (p & 3); } }
        *(u32x4*)(WT + (size_t)dr * K + k0 + 8 * c) = o; }
    asm volatile("s_waitcnt lgkmcnt(0)" ::: "memory");
}
__device__ __forceinline__ void convert_group(const float* W, int K, int N, int nmat, bf16raw* WT, int perm, const float* gbase, int gstride, LAS float* scr, int gw, int NGW, int lane) {
    const int per = (K / 64) * (N / 32), total = per * nmat;
    for (int it = gw; it < total; it += NGW) { const int mt = it / per, r = it % per;
        transpose_item(W + (size_t)mt * K * N, K, N, WT + (size_t)mt * K * N, perm, gbase ? gbase + (size_t)mt * gstride : nullptr, scr, r, lane); }
}

struct Row16 { f32x4 v[4]; };
__device__ __forceinline__ void ld_row_f32(Row16& r, const float* p, int lane) {
    const f32x4* q = (const f32x4*)(p + 8 * lane); r.v[0] = q[0]; r.v[1] = q[1]; r.v[2] = q[128]; r.v[3] = q[129];
}
__device__ __forceinline__ void st_row_f32(const Row16& r, float* p, int lane) {
    f32x4* q = (f32x4*)(p + 8 * lane); q[0] = r.v[0]; q[1] = r.v[1]; q[128] = r.v[2]; q[129] = r.v[3];
}
__device__ __forceinline__ void ld_row_bf16(Row16& r, const bf16raw* p, int lane) {
    const u32x4 a = *(const u32x4*)(p + 8 * lane), b = *(const u32x4*)(p + 512 + 8 * lane);
    r.v[0] = (f32x4){bf_lo(a.x), bf_hi(a.x), bf_lo(a.y), bf_hi(a.y)}; r.v[1] = (f32x4){bf_lo(a.z), bf_hi(a.z), bf_lo(a.w), bf_hi(a.w)};
    r.v[2] = (f32x4){bf_lo(b.x), bf_hi(b.x), bf_lo(b.y), bf_hi(b.y)}; r.v[3] = (f32x4){bf_lo(b.z), bf_hi(b.z), bf_lo(b.w), bf_hi(b.w)};
}
__device__ __forceinline__ void st_row_bf16(const Row16& r, bf16raw* p, int lane) {
    u32x4 a, b; a.x = cvt_pk(r.v[0][0], r.v[0][1]); a.y = cvt_pk(r.v[0][2], r.v[0][3]); a.z = cvt_pk(r.v[1][0], r.v[1][1]); a.w = cvt_pk(r.v[1][2], r.v[1][3]);
    b.x = cvt_pk(r.v[2][0], r.v[2][1]); b.y = cvt_pk(r.v[2][2], r.v[2][3]); b.z = cvt_pk(r.v[3][0], r.v[3][1]); b.w = cvt_pk(r.v[3][2], r.v[3][3]);
    *(u32x4*)(p + 8 * lane) = a; *(u32x4*)(p + 512 + 8 * lane) = b;
}
__device__ __forceinline__ float row_rstd(const Row16& r) {
    float s = 0.f;
#pragma unroll
    for (int j = 0; j < 4; ++j) s += (r.v[j][0] * r.v[j][0] + r.v[j][1] * r.v[j][1]) + (r.v[j][2] * r.v[j][2] + r.v[j][3] * r.v[j][3]);
    return 1.0f / sqrtf(wave_sum(s) * (1.0f / DM) + RMS_EPS);
}
struct RawPair { u32x4 r[8]; };
__device__ __forceinline__ void rp_load(RawPair& p, const bf16raw* MB, const bf16raw* U, int m0, int NGW, int lane) {
    const int m1 = m0 + NGW, m1c = m1 < MREG ? m1 : m0;
    p.r[0] = *(const u32x4*)(MB + (size_t)m0 * DM + 8 * lane); p.r[1] = *(const u32x4*)(MB + (size_t)m0 * DM + 512 + 8 * lane);
    p.r[2] = *(const u32x4*)(U + (size_t)m0 * DM + 8 * lane);  p.r[3] = *(const u32x4*)(U + (size_t)m0 * DM + 512 + 8 * lane);
    p.r[4] = *(const u32x4*)(MB + (size_t)m1c * DM + 8 * lane); p.r[5] = *(const u32x4*)(MB + (size_t)m1c * DM + 512 + 8 * lane);
    p.r[6] = *(const u32x4*)(U + (size_t)m1c * DM + 8 * lane);  p.r[7] = *(const u32x4*)(U + (size_t)m1c * DM + 512 + 8 * lane);
}
__device__ __forceinline__ void rp_unpack(Row16& r, const u32x4 a, const u32x4 b) {
    r.v[0] = (f32x4){bf_lo(a.x), bf_hi(a.x), bf_lo(a.y), bf_hi(a.y)}; r.v[1] = (f32x4){bf_lo(a.z), bf_hi(a.z), bf_lo(a.w), bf_hi(a.w)};
    r.v[2] = (f32x4){bf_lo(b.x), bf_hi(b.x), bf_lo(b.y), bf_hi(b.y)}; r.v[3] = (f32x4){bf_lo(b.z), bf_hi(b.z), bf_lo(b.w), bf_hi(b.w)};
}
__device__ __forceinline__ void rp_process(const RawPair& p, int mode, int m0, int NGW, bf16raw* U, float* RS, const Row16& gp, float* out, int lane) {
    const int m1 = m0 + NGW; const bool has1 = m1 < MREG;
    Row16 mv0, h0, mv1, h1;
    rp_unpack(mv0, p.r[0], p.r[1]); rp_unpack(h0, p.r[2], p.r[3]); rp_unpack(mv1, p.r[4], p.r[5]); rp_unpack(h1, p.r[6], p.r[7]);
    const float ra = row_rstd(mv0), rb = row_rstd(mv1);
#pragma unroll
    for (int j = 0; j < 4; ++j) { h0.v[j] = h0.v[j] + mv0.v[j] * ra * gp.v[j]; h1.v[j] = h1.v[j] + mv1.v[j] * rb * gp.v[j]; }
    if (mode == 2) {
        { const int b = m0 / LTOK, t = m0 - b * LTOK; if (t >= NMETA) st_row_f32(h0, out + ((size_t)b * SEQ + (t - NMETA)) * DM, lane); }
        if (has1) { const int b = m1 / LTOK, t = m1 - b * LTOK; if (t >= NMETA) st_row_f32(h1, out + ((size_t)b * SEQ + (t - NMETA)) * DM, lane); }
        return; }
    st_row_bf16(h0, U + (size_t)m0 * DM, lane);
    if (has1) st_row_bf16(h1, U + (size_t)m1 * DM, lane);
    const float r0 = row_rstd(h0), r1 = row_rstd(h1);
    if (lane == 0) { RS[m0] = r0; if (has1) RS[m1] = r1; }
}
__device__ __forceinline__ void resid_pass(int mode, const float* x, const float* meta, const bf16raw* MB, bf16raw* U, float* RS, bf16raw* OB, const float* g_post, float* out,
                                           int gw, int NGW, int lane, const float* tailp = nullptr) {
    Row16 gp;
    if (mode != 0) ld_row_f32(gp, g_post, lane);
    if (mode == 0) {
        for (int m0 = gw; m0 < MPAD; m0 += 2 * NGW) {
            const int m1 = m0 + NGW; const bool has1 = m1 < MPAD; const int m1c = has1 ? m1 : m0;
            const bool pad0 = m0 >= MTOK, pad1 = m1c >= MTOK;
            const int mm0 = pad0 ? 0 : m0, mm1 = pad1 ? 0 : m1c;
            const int b0 = mm0 / LTOK, t0 = mm0 - b0 * LTOK, b1 = mm1 / LTOK, t1 = mm1 - b1 * LTOK;
            Row16 h0, h1;
            ld_row_f32(h0, (t0 < NMETA) ? meta + (size_t)t0 * DM : x + ((size_t)b0 * SEQ + (t0 - NMETA)) * DM, lane);
            ld_row_f32(h1, (t1 < NMETA) ? meta + (size_t)t1 * DM : x + ((size_t)b1 * SEQ + (t1 - NMETA)) * DM, lane);
#pragma unroll
            for (int k = 0; k < 2; ++k) { const int m = k ? m1 : m0; const bool pad = k ? pad1 : pad0; if (k && !has1) break;
                const Row16& h = k ? h1 : h0;
                if (pad) {
                    const u32x4 z = (u32x4){0u, 0u, 0u, 0u};
                    *(u32x4*)(U + (size_t)m * DM + 8 * lane) = z; *(u32x4*)(U + (size_t)m * DM + 512 + 8 * lane) = z;
                    *(u32x4*)(OB + (size_t)m * DM + 8 * lane) = z; *(u32x4*)(OB + (size_t)m * DM + 512 + 8 * lane) = z;
                    if (lane == 0) RS[m] = 0.f;
                } else {
                    st_row_bf16(h, U + (size_t)m * DM, lane);
                    const float rs2 = row_rstd(h);
                    if (lane == 0) RS[m] = rs2; } }
        }
        return;
    }
    if (gw < MTOK - MREG) { const int m = MREG + gw; Row16 mv, t1, h;
        ld_row_f32(mv, tailp + (size_t)gw * DM, lane);
#pragma unroll
        for (int p = 1; p < TAIL_S; ++p) { ld_row_f32(t1, tailp + ((size_t)p * 128 + gw) * DM, lane);
#pragma unroll
            for (int j = 0; j < 4; ++j) mv.v[j] = mv.v[j] + t1.v[j]; }
        ld_row_bf16(h, U + (size_t)m * DM, lane);
        const float ra = row_rstd(mv);
#pragma unroll
        for (int j = 0; j < 4; ++j) h.v[j] = h.v[j] + mv.v[j] * ra * gp.v[j];
        if (mode == 2) { const int b = m / LTOK, t = m - b * LTOK; if (t >= NMETA) st_row_f32(h, out + ((size_t)b * SEQ + (t - NMETA)) * DM, lane); }
        else { st_row_bf16(h, U + (size_t)m * DM, lane); const float r2 = row_rstd(h); if (lane == 0) RS[m] = r2; }
    }
    RawPair A, B; const int S = 2 * NGW; int m0 = gw;
    if (m0 < MREG) rp_load(A, MB, U, m0, NGW, lane);
    while (m0 < MREG) {
        if (m0 + S < MREG) rp_load(B, MB, U, m0 + S, NGW, lane);
        rp_process(A, mode, m0, NGW, U, RS, gp, out, lane);
        m0 += S; if (m0 >= MREG) break;
        if (m0 + S < MREG) rp_load(A, MB, U, m0 + S, NGW, lane);
        rp_process(B, mode, m0, NGW, U, RS, gp, out, lane);
        m0 += S;
    }
}

__device__ __forceinline__ void rope_pass(bf16raw* QKV, const float* qg, const float* kg, const f32x2* tab, int gw, int NGW, int lane) {
    const int hsel = lane >> 5, within = lane & 31, axis = within >> 4, s16 = within & 15, d1 = axis * 64 + 2 * s16, d2 = d1 + 32;
    const f32x2 gq1 = *(const f32x2*)(qg + d1), gq2 = *(const f32x2*)(qg + d2), gk1 = *(const f32x2*)(kg + d1), gk2 = *(const f32x2*)(kg + d2);
    for (int m = gw; m < MTOK; m += NGW) {
        const int b = m / LTOK, t = m - b * LTOK;
        f32x2 cs0 = (f32x2){1.f, 0.f}, cs1 = (f32x2){1.f, 0.f};
        if (t >= NMETA) { const int s = t - NMETA, pos = axis ? (s & 63) : (s >> 6); cs0 = tab[pos * 32 + 2 * s16]; cs1 = tab[pos * 32 + 2 * s16 + 1]; }
        bf16raw* rowp = QKV + (size_t)m * QKVD;
        unsigned w1[5], w2[5];
#pragma unroll
        for (int st = 0; st < 5; ++st) { const int hd = 2 * st + hsel; w1[st] = *(const unsigned*)(rowp + hd * 128 + d1); w2[st] = *(const unsigned*)(rowp + hd * 128 + d2); }
#pragma unroll
        for (int st = 0; st < 5; ++st) { const int hd = 2 * st + hsel;
            const float x1a = bf_lo(w1[st]), x1b = bf_hi(w1[st]), x2a = bf_lo(w2[st]), x2b = bf_hi(w2[st]);
            float ss = (x1a * x1a + x1b * x1b) + (x2a * x2a + x2b * x2b);
            ss += __shfl_xor(ss, 1); ss += __shfl_xor(ss, 2); ss += __shfl_xor(ss, 4); ss += __shfl_xor(ss, 8); ss += __shfl_xor(ss, 16);
            const float rs = 1.0f / sqrtf(ss * (1.0f / 128.0f) + RMS_EPS);
            const bool isq = (st < 4);
            const f32x2 g1 = isq ? gq1 : gk1, g2 = isq ? gq2 : gk2;
            const float n1a = x1a * rs * g1.x, n1b = x1b * rs * g1.y, n2a = x2a * rs * g2.x, n2b = x2b * rs * g2.y;
            const float o1a = n1a * cs0.x - n2a * cs0.y, o2a = n2a * cs0.x + n1a * cs0.y;
            const float o1b = n1b * cs1.x - n2b * cs1.y, o2b = n2b * cs1.x + n1b * cs1.y;
            *(unsigned*)(rowp + hd * 128 + d1) = cvt_pk(o1a, o1b); *(unsigned*)(rowp + hd * 128 + d2) = cvt_pk(o2a, o2b); }
    }
}

constexpr int L_XCF = 0, L_XCB = 24576, L_CC = 37632, L_AB = 40960, AB_RS = 132, AB_PL = LT * AB_RS;
static_assert(L_AB + 2 * AB_PL * 4 <= LDS_MISC && L_CC + 5 * 128 * 4 <= L_AB, "LRU LDS");
struct LruW { bf16x8 f[2][2][4]; };
struct LruC { float br[2], bi[2], k8[2]; };
__device__ __forceinline__ void lru_load_w(LruW& w, LruC& cc, const bf16raw* Wg, const float* gate_b, const float* lam, int slot, int n, int wid, int lane) {
    const int dir = wid >> 2, cq = wid & 3, fr = lane & 15, fq = lane >> 4;
#pragma unroll
    for (int g = 0; g < 2; ++g)
#pragma unroll
        for (int nt = 0; nt < 2; ++nt)
#pragma unroll
            for (int ks = 0; ks < 4; ++ks)
                w.f[g][nt][ks] = *(const bf16x8*)(Wg + ((size_t)((((slot * 2 + dir) * 2 + g) * 8 + n) * 128 + cq * 32 + nt * 16 + fr)) * 128 + ks * 32 + fq * 8);
#pragma unroll
    for (int nt = 0; nt < 2; ++nt) { const int gch = n * 128 + cq * 32 + nt * 16 + fr;
        cc.br[nt] = gate_b[((size_t)(slot * 2 + dir) * 2 + 0) * DM + gch]; cc.bi[nt] = gate_b[((size_t)(slot * 2 + dir) * 2 + 1) * DM + gch];
        const float lm = lam[(size_t)(slot * 2 + dir) * DM + gch];
        const float sp = (lm > 15.f) ? __expf(-lm) : log1pf(__expf(-lm));
        cc.k8[nt] = -8.0f * sp * 1.4426950408889634f; }
}
struct LruX { u32x4 r[5]; };
__device__ __forceinline__ void lru_fetch_x(LruX& xr, const bf16raw* X, int b, int c, int n, int tid) {
    const int cgp = tid & 15, pr = tid >> 4;
    if (pr < 24) {
#pragma unroll
        for (int k = 0; k < 5; ++k) { const int tt = c * LT + 2 * pr - 2 + k;
            xr.r[k] = (tt >= 0 && tt < LTOK) ? *(const u32x4*)(X + ((size_t)b * LTOK + tt) * DM + n * 128 + cgp * 8) : (u32x4){0u, 0u, 0u, 0u}; } }
}
template <bool FINAL, bool REV>
__device__ __forceinline__ void lru_scan(const f32x4 (&acc)[3][2][2], LAS float* HF, f32x2* SUMS, size_t sbase, float hin0, float hin1, int cq, int fr, int fq, int lane) {
    const int rank = REV ? 3 - fq : fq;
    const int src1 = (REV ? lane + 16 : lane - 16) & 63, src2 = (REV ? lane + 32 : lane - 32) & 63, srcT = REV ? fr : fr + 48;
#pragma unroll
    for (int nt = 0; nt < 2; ++nt) {
        float Pe[3], Qe[3], Pt[3], Qt[3];
#pragma unroll
        for (int mt = 0; mt < 3; ++mt) { float p = 1.f, q = 0.f;
#pragma unroll
            for (int ii = 0; ii < 4; ++ii) { const int i = REV ? 3 - ii : ii; const float a = acc[mt][0][nt][i]; q = a * q + acc[mt][1][nt][i]; p *= a; }
            { const float pp = __shfl(p, src1), qp = __shfl(q, src1); if (rank >= 1) { q = qp * p + q; p = pp * p; } }
            { const float pp = __shfl(p, src2), qp = __shfl(q, src2); if (rank >= 2) { q = qp * p + q; p = pp * p; } }
            Pt[mt] = __shfl(p, srcT); Qt[mt] = __shfl(q, srcT);
            if (FINAL) { const float pe = __shfl(p, src1), qe = __shfl(q, src1); Pe[mt] = rank >= 1 ? pe : 1.f; Qe[mt] = rank >= 1 ? qe : 0.f; } }
        if (!FINAL) { float A = 1.f, Bv = 0.f;
#pragma unroll
            for (int mm = 0; mm < 3; ++mm) { const int mt = REV ? 2 - mm : mm; Bv = Bv * Pt[mt] + Qt[mt]; A *= Pt[mt]; }
            if (fq == 0) SUMS[sbase + 16 * nt] = (f32x2){A, Bv};
        } else { float hseg = nt ? hin1 : hin0; const int ch = cq * 32 + nt * 16 + fr;
#pragma unroll
            for (int mm = 0; mm < 3; ++mm) { const int mt = REV ? 2 - mm : mm;
                float h = Pe[mt] * hseg + Qe[mt];
#pragma unroll
                for (int ii = 0; ii < 4; ++ii) { const int i = REV ? 3 - ii : ii; h = acc[mt][0][nt][i] * h + acc[mt][1][nt][i];
                    HF[(REV ? AB_PL : 0) + (mt * 16 + fq * 4 + i) * AB_RS + ch] = h; }
                hseg = Pt[mt] * hseg + Qt[mt]; } }
    }
}
#define LDS_BAR() do { asm volatile("s_waitcnt lgkmcnt(0)" ::: "memory"); __builtin_amdgcn_s_barrier(); asm volatile("" ::: "memory"); } while (0)
template <bool FINAL>
__device__ __forceinline__ void lru_pass(LAS unsigned char* lds, int slot, const bf16raw* Wg, const bf16raw* X, bf16raw* Y, const float* conv_w, const float* conv_b,
                                         const float* gate_b, const float* lam, f32x2* SUMS, const float* CARRY, int G, int bid, int tid0, int wid, int lane0) {
    constexpr int NTILES = 8 * NB * NCHUNK, PERN = NB * NCHUNK;
    const int lo = (int)(((long)bid * NTILES) / G), hi = (int)(((long)(bid + 1) * NTILES) / G);
    LAS float* XCF = (LAS float*)(lds + L_XCF); LAS unsigned char* XCB = lds + L_XCB; LAS float* CC = (LAS float*)(lds + L_CC); LAS float* HF = (LAS float*)(lds + L_AB);
    const int dir = wid >> 2, cq = wid & 3;
    LruW w; LruC cc; LruX xr; int curn = -1;
    if (lo < hi) { const int n = lo / PERN, rem = lo - n * PERN, b = rem / NCHUNK, c = rem - b * NCHUNK; lru_fetch_x(xr, X, b, c, n, tid0); }
    for (int tau = lo; tau < hi; ++tau) { const int n = tau / PERN, rem = tau - n * PERN, b = rem / NCHUNK, c = rem - b * NCHUNK;
        const size_t row0 = (size_t)b * LTOK + c * LT;
        int tid = tid0; asm volatile("" : "+v"(tid));
        const int lane = tid & 63, fr = lane & 15, fq = lane >> 4, cgp = tid & 15, pr = tid >> 4;
        if (n != curn) { lru_load_w(w, cc, Wg, gate_b, lam, slot, n, wid, lane); curn = n;
            for (int i = tid; i < 5 * 128; i += NTHREADS) CC[i] = (i < 512) ? conv_w[(size_t)slot * 4 * DM + (i >> 7) * DM + n * 128 + (i & 127)] : conv_b[(size_t)slot * DM + n * 128 + (i & 127)];
            __syncthreads(); }
        const size_t sbase = ((size_t)(b * NCHUNK + c) * 2 + dir) * DM + n * 128 + cq * 32 + fr;
        float hin0 = 0.f, hin1 = 0.f;
        if (FINAL) { hin0 = CARRY[sbase]; hin1 = CARRY[sbase + 16]; }
        if (pr < 24) {
            f32x4 xa[5], xb[5];
#pragma unroll
            for (int k = 0; k < 5; ++k) { const u32x4 v = xr.r[k]; xa[k] = (f32x4){bf_lo(v.x), bf_hi(v.x), bf_lo(v.y), bf_hi(v.y)}; xb[k] = (f32x4){bf_lo(v.z), bf_hi(v.z), bf_lo(v.w), bf_hi(v.w)}; }
#pragma unroll
            for (int j = 0; j < 2; ++j) { f32x4 a0 = *(const LAS f32x4*)(CC + 512 + cgp * 8), a1 = *(const LAS f32x4*)(CC + 512 + cgp * 8 + 4);
#pragma unroll
                for (int k = 0; k < 4; ++k) { a0 += *(const LAS f32x4*)(CC + k * 128 + cgp * 8) * xa[j + k]; a1 += *(const LAS f32x4*)(CC + k * 128 + cgp * 8 + 4) * xb[j + k]; }
                const int t = 2 * pr + j;
                *(LAS f32x4*)(XCF + t * 128 + cgp * 8) = a0; *(LAS f32x4*)(XCF + t * 128 + cgp * 8 + 4) = a1;
                u32x4 pk; pk.x = cvt_pk(a0[0], a0[1]); pk.y = cvt_pk(a0[2], a0[3]); pk.z = cvt_pk(a1[0], a1[1]); pk.w = cvt_pk(a1[2], a1[3]);
                *(LAS u32x4*)(XCB + t * 272 + cgp * 16) = pk; }
        }
        if (tau + 1 < hi) { const int t2 = tau + 1, n2 = t2 / PERN, rem2 = t2 - n2 * PERN, b2 = rem2 / NCHUNK, c2 = rem2 - b2 * NCHUNK; lru_fetch_x(xr, X, b2, c2, n2, tid); }
        LDS_BAR();
        f32x4 acc[3][2][2];
#pragma unroll
        for (int mt = 0; mt < 3; ++mt)
#pragma unroll
            for (int g = 0; g < 2; ++g)
#pragma unroll
                for (int nt = 0; nt < 2; ++nt) acc[mt][g][nt] = (f32x4){0.f, 0.f, 0.f, 0.f};
#pragma unroll
        for (int ks = 0; ks < 4; ++ks) {
#pragma unroll
            for (int mt = 0; mt < 3; ++mt) { const bf16x8 af = *(const LAS bf16x8*)(XCB + (mt * 16 + fr) * 272 + (ks * 32 + fq * 8) * 2);
#pragma unroll
                for (int g = 0; g < 2; ++g)
#pragma unroll
                    for (int nt = 0; nt < 2; ++nt) acc[mt][g][nt] = __builtin_amdgcn_mfma_f32_16x16x32_bf16(af, w.f[g][nt][ks], acc[mt][g][nt], 0, 0, 0); } }
#pragma unroll
        for (int nt = 0; nt < 2; ++nt) { const int ch = cq * 32 + nt * 16 + fr;
            const float nbr = -1.4426950408889634f * cc.br[nt], nbi = -1.4426950408889634f * cc.bi[nt], k8 = cc.k8[nt];
#pragma unroll
            for (int mt = 0; mt < 3; ++mt)
#pragma unroll
                for (int ip = 0; ip < 4; ip += 2) { const int tk = mt * 16 + fq * 4 + ip;
                    const f32x2 xr2 = (f32x2){acc[mt][0][nt][ip], acc[mt][0][nt][ip + 1]}, xi2 = (f32x2){acc[mt][1][nt][ip], acc[mt][1][nt][ip + 1]};
                    const f32x2 tr = xr2 * (-1.4426950408889634f) + nbr, ti = xi2 * (-1.4426950408889634f) + nbi;
                    f32x2 er, ei; er.x = __builtin_amdgcn_exp2f(tr.x); er.y = __builtin_amdgcn_exp2f(tr.y); ei.x = __builtin_amdgcn_exp2f(ti.x); ei.y = __builtin_amdgcn_exp2f(ti.y);
                    er = er + 1.0f; ei = ei + 1.0f;
                    f32x2 r, ig; r.x = __builtin_amdgcn_rcpf(er.x); r.y = __builtin_amdgcn_rcpf(er.y); ig.x = __builtin_amdgcn_rcpf(ei.x); ig.y = __builtin_amdgcn_rcpf(ei.y);
                    const f32x2 la = r * k8;
                    f32x2 a; a.x = __builtin_amdgcn_exp2f(la.x); a.y = __builtin_amdgcn_exp2f(la.y);
                    const f32x2 y = 1.0f - a * a;
                    f32x2 sq; sq.x = __builtin_amdgcn_sqrtf(y.x); sq.y = __builtin_amdgcn_sqrtf(y.y);
                    const f32x2 xc2 = (f32x2){XCF[tk * 128 + ch], XCF[(tk + 1) * 128 + ch]};
                    const f32x2 bb = sq * ig * xc2;
                    acc[mt][0][nt][ip] = a.x; acc[mt][0][nt][ip + 1] = a.y; acc[mt][1][nt][ip] = bb.x; acc[mt][1][nt][ip + 1] = bb.y; } }
        if (dir) lru_scan<FINAL, true>(acc, HF, SUMS, sbase, hin0, hin1, cq, fr, fq, lane);
        else     lru_scan<FINAL, false>(acc, HF, SUMS, sbase, hin0, hin1, cq, fr, fq, lane);
        if (FINAL) {
            const u32x4 yv0 = (pr < 24) ? *(const u32x4*)(Y + (row0 + 2 * pr) * DM + n * 128 + cgp * 8) : (u32x4){0u, 0u, 0u, 0u};
            const u32x4 yv1 = (pr < 24) ? *(const u32x4*)(Y + (row0 + 2 * pr + 1) * DM + n * 128 + cgp * 8) : (u32x4){0u, 0u, 0u, 0u};
            LDS_BAR();
            if (pr < 24) {
#pragma unroll
                for (int j = 0; j < 2; ++j) { const int t = 2 * pr + j; const u32x4 yv = j ? yv1 : yv0;
                    const LAS float* hf = HF + t * AB_RS + cgp * 8; const LAS float* hb = HF + AB_PL + t * AB_RS + cgp * 8;
                    const f32x4 f0 = *(const LAS f32x4*)hf, f1 = *(const LAS f32x4*)(hf + 4), b0 = *(const LAS f32x4*)hb, b1 = *(const LAS f32x4*)(hb + 4);
                    const f32x4 z0 = (f0 + b0) * (f32x4){bf_lo(yv.x), bf_hi(yv.x), bf_lo(yv.y), bf_hi(yv.y)}, z1 = (f1 + b1) * (f32x4){bf_lo(yv.z), bf_hi(yv.z), bf_lo(yv.w), bf_hi(yv.w)};
                    u32x4 o; o.x = cvt_pk(z0[0], z0[1]); o.y = cvt_pk(z0[2], z0[3]); o.z = cvt_pk(z1[0], z1[1]); o.w = cvt_pk(z1[2], z1[3]);
                    *(u32x4*)(Y + (row0 + t) * DM + n * 128 + cgp * 8) = o; } }
        }
        LDS_BAR();
    }
}
__device__ __forceinline__ void lru_carry(const f32x2* SUMS, float* CARRY, int G, int bid, int wid, int lane) {
    if (wid != 0) return;
    for (int gt = bid * 64 + lane; gt < NB * 2 * DM; gt += G * 64) { const int b = gt >> 11, sd = (gt >> 10) & 1, gch = gt & 1023;
        float h = 0.f;
        if (sd == 0) {
#pragma unroll 19
            for (int c = 0; c < NCHUNK; ++c) { const size_t i = ((size_t)(b * NCHUNK + c) * 2 + sd) * DM + gch; CARRY[i] = h; const f32x2 s = SUMS[i]; h = s.x * h + s.y; } }
        else {
#pragma unroll 19
            for (int c = NCHUNK - 1; c >= 0; --c) { const size_t i = ((size_t)(b * NCHUNK + c) * 2 + sd) * DM + gch; CARRY[i] = h; const f32x2 s = SUMS[i]; h = s.x * h + s.y; } }
    }
}

typedef unsigned v4u __attribute__((ext_vector_type(4)));
#define XB_TMO      128
#define XB_XCNT(j)  (256  + 64 * (j))
#define XB_XSUB(j)  (1280 + 64 * (j))
#define XB_XGEN(j)  (2304 + 64 * (j))
#define XB_TOP      3328
#define XB_TOPGEN   3392
#define XCD_BAR_WORDS 3456
#define XB_SPIN_CAP (1u << 18)

__device__ __forceinline__ unsigned xb_ld(unsigned* p)              { return __hip_atomic_load(p, __ATOMIC_RELAXED, __HIP_MEMORY_SCOPE_AGENT); }
__device__ __forceinline__ unsigned xb_add(unsigned* p, unsigned v) { return __hip_atomic_fetch_add(p, v, __ATOMIC_RELAXED, __HIP_MEMORY_SCOPE_AGENT); }
__device__ __forceinline__ unsigned xb_xcc_id() { return (unsigned)__builtin_amdgcn_s_getreg((3 << 11) | 20) & 0xFu; }
#define XB_SPIN(cond, bar) do { unsigned _sp = 0; while (cond) { __builtin_amdgcn_s_sleep(1); \
    if ((++_sp & 255u) == 0u) { if (xb_ld(&(bar)[XB_TMO])) break; if (_sp > XB_SPIN_CAP) { atomicAdd(&(bar)[XB_TMO], 1u); break; } } } } while (0)

struct XcdBarrier {
    unsigned* bar; unsigned x;
    volatile LAS unsigned* st;
};

__device__ __forceinline__ XcdBarrier xcd_barrier_post(unsigned* bar, volatile LAS unsigned* st) {
    XcdBarrier b; b.bar = bar; b.x = xb_xcc_id(); b.st = st;
    if (threadIdx.x == 0) (void)xb_add(&bar[XB_XCNT(b.x)], 1u);
    return b;
}
__device__ __forceinline__ void xcd_barrier_complete(unsigned* bar, unsigned x, unsigned& nloc, unsigned& nx) {
    const unsigned G = gridDim.x * gridDim.y * gridDim.z;
    unsigned sum, cnt, mine, sp = 0u;
    for (;;) {
        sum = 0u; cnt = 0u; mine = 0u;
#pragma unroll
        for (unsigned j = 0; j < 16; ++j) { const unsigned c = xb_ld(&bar[XB_XCNT(j)]); sum += c; cnt += (c > 0u) ? 1u : 0u; mine = (j == x) ? c : mine; }
        if (sum == G) break;
        __builtin_amdgcn_s_sleep(1);
        if ((++sp & 255u) == 0u) { if (xb_ld(&bar[XB_TMO])) break; if (sp > XB_SPIN_CAP) { atomicAdd(&bar[XB_TMO], 1u); break; } }
    }
    nloc = mine > 0u ? mine : 1u; nx = cnt > 0u ? cnt : 1u;
}

__device__ __forceinline__ void xcd_barrier(const XcdBarrier& b) {
    asm volatile("s_waitcnt vmcnt(0)" ::: "memory");
    __syncthreads();
    if (threadIdx.x == 0) {
        unsigned* bar = b.bar;
        __builtin_amdgcn_s_waitcnt(0);
        unsigned nloc = b.st[0], nx = b.st[1];
        if (nloc == 0u) { xcd_barrier_complete(bar, b.x, nloc, nx); b.st[0] = nloc; b.st[1] = nx; }
        const unsigned old = xb_add(&bar[XB_XSUB(b.x)], 1u);
        const unsigned gen = old / nloc;
        if (old + 1u == (gen + 1u) * nloc) {
            __builtin_amdgcn_fence(__ATOMIC_RELEASE, "agent");
            asm volatile("s_waitcnt vmcnt(0)" ::: "memory");
            const unsigned og = xb_add(&bar[XB_TOP], 1u);
            const unsigned tg = og / nx;
            if (og + 1u == (tg + 1u) * nx) xb_add(&bar[XB_TOPGEN], 1u);
            else XB_SPIN(xb_ld(&bar[XB_TOPGEN]) == tg, bar);
            __builtin_amdgcn_fence(__ATOMIC_ACQUIRE, "agent");
            xb_add(&bar[XB_XGEN(b.x)], 1u);
            asm volatile("s_waitcnt vmcnt(0)" ::: "memory");
        } else {
            XB_SPIN(xb_ld(&bar[XB_XGEN(b.x)]) == gen, bar);
            __builtin_amdgcn_fence(__ATOMIC_ACQUIRE, "agent");
            asm volatile("s_waitcnt vmcnt(0)" ::: "memory");
        }
    }
    __syncthreads();
}

#define LAUNDER(p) asm volatile("" : "+s"(p))
struct Args { const float* in[16]; float* out; unsigned char* ws; };
#ifdef NO_GEMM
#define GEMM_RUN(EPI, Aptr, Bptr, Nn, Kk, Eobj) do { } while (0)
#define GEMM_RUN_T(EPI, Aptr, Bptr, Nn, Kk, Eobj, TAIL) do { } while (0)
#define GEMM_RUN_S(EPI, Aptr, Bptr, Nn, Kk, Eobj, TAIL, SPL) do { } while (0)
#else
#define GEMM_RUN(EPI, Aptr, Bptr, Nn, Kk, Eobj) GEMM_RUN_S(EPI, Aptr, Bptr, Nn, Kk, Eobj, true, 1)
#define GEMM_RUN_T(EPI, Aptr, Bptr, Nn, Kk, Eobj, TAIL) GEMM_RUN_S(EPI, Aptr, Bptr, Nn, Kk, Eobj, TAIL, 1)
#define GEMM_RUN_S(EPI, Aptr, Bptr, Nn, Kk, Eobj, TAIL, SPL) do { pg8::Gemm g_{(const pg8::bf16_t*)(Aptr), (const pg8::bf16_t*)(Bptr), MPAD, (Nn), (Kk)}; int bid_ = blockIdx.x; asm volatile("" : "+s"(bid_)); int G_ = gridDim.x; asm volatile("" : "+s"(G_)); pg8::StaticOrder S_; S_.init(MPAD, (Nn), (Kk), G_, bid_, (TAIL), (SPL)); \
    pg8::gemm_phase<EPI, pg8::StaticOrder, EPI::ALIGN, true>((PG8_LAS unsigned char*)lds, g_, S_, (Eobj)); } while (0)
#endif

__global__ void __launch_bounds__(NTHREADS, 2) mega_fwd(Args args) {
    extern __shared__ __attribute__((aligned(16))) unsigned char lds[];
    cg::grid_group grid = cg::this_grid();
#define FRESH() int tid = threadIdx.x; asm volatile("" : "+v"(tid)); int bid = blockIdx.x; asm volatile("" : "+s"(bid)); int G = gridDim.x; asm volatile("" : "+s"(G)); const int NGW = G * 8; \
    const int lane = tid & 63, wid = __builtin_amdgcn_readfirstlane(tid >> 6), gw = bid * 8 + wid; (void)lane; (void)gw; (void)NGW
    unsigned char* ws = args.ws;
    const float* x = args.in[0]; const float* meta = args.in[1]; const float* gains = args.in[2];
    bf16raw* OB0 = (bf16raw*)(ws + WS_H); float* RS0 = (float*)(ws + WS_H + (size_t)MPAD * DM * 2); bf16raw* U0 = (bf16raw*)(ws + WS_U);
    bf16raw* BIG0 = (bf16raw*)(ws + WS_BIG); bf16raw* MB0 = (bf16raw*)(ws + WS_MB);
    bf16raw* Wb0 = (bf16raw*)(ws + WS_W); f32x2* SUMS = (f32x2*)(ws + WS_SUM); float* CARRY = (float*)(ws + WS_CARRY); f32x2* ROPE = (f32x2*)(ws + WS_ROPE);

    {
        FRESH();
        LAS float* scr = (LAS float*)((LAS unsigned char*)lds + wid * 16384);
        bf16raw* OB = OB0; float* RS = RS0; bf16raw* U = U0; bf16raw* Wb = Wb0;
        convert_group(args.in[3], 1024, 2048, 2, Wb + WO_LRU_IN, 0, gains, 8 * DM, scr, gw, NGW, lane);
        convert_group(args.in[9], 1024, 1024, 2, Wb + WO_LRU_OUT, 0, nullptr, 0, scr, gw, NGW, lane);
        convert_group(args.in[6], 128, 128, 64, Wb + WO_GATE, 0, nullptr, 0, scr, gw, NGW, lane);
        convert_group(args.in[10], 1024, 1536, 2, Wb + WO_QKV, 2, gains + 4 * DM, 8 * DM, scr, gw, NGW, lane);
        convert_group(args.in[13], 1024, 1024, 2, Wb + WO_AO, 0, nullptr, 0, scr, gw, NGW, lane);
        convert_group(args.in[14], 1024, 5632, 4, Wb + WO_F1, 1, gains + 2 * DM, 4 * DM, scr, gw, NGW, lane);
        convert_group(args.in[15], 2816, 1024, 4, Wb + WO_F2, 0, nullptr, 0, scr, gw, NGW, lane);
        for (int i = bid * NTHREADS + tid; i < 128 * 32; i += G * NTHREADS) { const int pos = i >> 5, p = i & 31;
            const float inv_freq = (float)exp(-(double)p * (9.210340371976184 / 32.0));
            const float ang = (float)pos * inv_freq;
            double rev = (double)ang * 0.15915494309189535; rev -= floor(rev);
            ROPE[i] = (f32x2){__builtin_amdgcn_cosf((float)rev), __builtin_amdgcn_sinf((float)rev)}; }
        resid_pass(0, x, meta, nullptr, U, RS, OB, nullptr, nullptr, gw, NGW, lane);
        if (bid == 0) for (int i = tid; i < 4096; i += NTHREADS) ((unsigned*)(ws + WS_CTL))[i] = 0u;
        if (tid < 2) ((volatile LAS unsigned*)((LAS unsigned char*)lds + LDS_MISC))[tid] = 0u;
    }
    grid.sync();
    const XcdBarrier xbar = xcd_barrier_post((unsigned*)(ws + WS_CTL), (volatile LAS unsigned*)((LAS unsigned char*)lds + LDS_MISC));
#define GSYNC() xcd_barrier(xbar)

    for (int layer = 0; layer < 4; ++layer) {
        const int slot = layer >> 1; const float* gl = gains + (size_t)layer * 4 * DM;
        size_t zl = 0; asm volatile("" : "+s"(zl));
        float* TAILP = (float*)(ws + WS_TAILP) + zl;
        bf16raw* OB = OB0 + zl; float* RS = RS0 + zl; bf16raw* U = U0 + zl; bf16raw* BIG = BIG0 + zl; bf16raw* MB = MB0 + zl; bf16raw* Wb = Wb0 + zl; bf16raw* Yb = BIG; bf16raw* Xb = BIG + (size_t)MPAD * DM;
        if ((layer & 1) == 0) {
            { EpiLruIn E{Yb, Xb, RS}; GEMM_RUN(EpiLruIn, U, Wb + WO_LRU_IN + (size_t)slot * 2048 * 1024, 2048, 1024, E); }
            GSYNC();
#ifndef NO_LRU
            { FRESH(); lru_pass<false>((LAS unsigned char*)lds, slot, Wb + WO_GATE, Xb, Yb, args.in[4], args.in[5], args.in[7], args.in[8], SUMS, CARRY, G, bid, tid, wid, lane); }
            GSYNC();
            { FRESH(); lru_carry(SUMS, CARRY, G, bid, wid, lane); }
            GSYNC();
            { FRESH(); lru_pass<true>((LAS unsigned char*)lds, slot, Wb + WO_GATE, Xb, Yb, args.in[4], args.in[5], args.in[7], args.in[8], SUMS, CARRY, G, bid, tid, wid, lane); }
#endif
            GSYNC();
        } else {
            { EpiQkv E{BIG, RS, args.in[11] + slot * 128, args.in[12] + slot * 128, ROPE, (LAS float*)((LAS unsigned char*)lds + 131072)}; GEMM_RUN(EpiQkv, U, Wb + WO_QKV + (size_t)slot * 1536 * 1024, 1536, 1024, E); }
            GSYNC();
#ifndef NO_ATT
            { int bid = blockIdx.x; asm volatile("" : "+s"(bid)); int G = gridDim.x; asm volatile("" : "+s"(G));
              int tq = threadIdx.x; asm volatile("" : "+v"(tq));
#define ATT_IDS() int tq_ = threadIdx.x; asm volatile("" : "+v"(tq_)); const int qw = tq_ >> 6, qr32 = tq_ & 31, qhi = (tq_ >> 5) & 1
              bool fixed_ok;
              { const float* qg_ = args.in[11] + slot * 128; const float* kg_ = args.in[12] + slot * 128; const int l_ = tq & 63;
                float bq = fmaxf(fabsf(qg_[l_]), fabsf(qg_[l_ + 64])), bk = fmaxf(fabsf(kg_[l_]), fabsf(kg_[l_ + 64]));
#pragma unroll
                for (int o_ = 1; o_ < 64; o_ <<= 1) { bq = fmaxf(bq, __shfl_xor(bq, o_)); bk = fmaxf(bk, __shfl_xor(bk, o_)); }
                const float bound = 0.088388347648318440f * 1.4426950408889634f * 128.0f * bq * bk * 1.02f;
                fixed_ok = __builtin_amdgcn_readfirstlane((int)(bound <= 60.0f)) != 0; }
              float* PART = (float*)(ws + WS_SUM) + zl;
              if (layer < 3)   for (int it = bid; it < 16 * 43; it += G) { const int bk = it / 43, s = it - bk * 43, b = bk >> 1, kvh = bk & 1; const size_t rb = (size_t)b * LTOK;
                  ATT_IDS(); const int Rm = (qw * 32 + qr32) & 63, g4 = Rm >> 4, jm = Rm & 15;
                  if (fixed_ok) att::attn_unit<true, true>((const att::bf16*)(BIG + (rb + jm) * QKVD + (kvh * 4 + g4) * 128 + qhi * 8), (const att::bf16*)(BIG + (rb + 192 * s) * QKVD + 1024 + kvh * 128),
                                       (const att::bf16*)(BIG + (rb + 192 * s) * QKVD + 1280 + kvh * 128), nullptr, 3, s == 42, PART + (size_t)it * 8320, (char*)lds);
                  else att::attn_unit<true, false>((const att::bf16*)(BIG + (rb + jm) * QKVD + (kvh * 4 + g4) * 128 + qhi * 8), (const att::bf16*)(BIG + (rb + 192 * s) * QKVD + 1024 + kvh * 128),
                                       (const att::bf16*)(BIG + (rb + 192 * s) * QKVD + 1280 + kvh * 128), nullptr, 3, s == 42, PART + (size_t)it * 8320, (char*)lds); }
              for (int u = bid; u < NB * 8 * 32; u += G) { const int h = u & 7, kvh = h >> 2, qb = (u >> 3) & 31, b = u >> 8;
                  ATT_IDS(); const size_t rb = (size_t)b * LTOK, q0 = rb + NMETA + 256 * qb;
                  if (fixed_ok) att::attn_unit<false, true>((const att::bf16*)(BIG + (q0 + qw * 32 + qr32) * QKVD + h * 128 + qhi * 8), (const att::bf16*)(BIG + rb * QKVD + 1024 + kvh * 128),
                                        (const att::bf16*)(BIG + rb * QKVD + 1280 + kvh * 128), (att::bf16*)(OB + q0 * DM + h * 128), 129, true, nullptr, (char*)lds);
                  else att::attn_unit<false, false>((const att::bf16*)(BIG + (q0 + qw * 32 + qr32) * QKVD + h * 128 + qhi * 8), (const att::bf16*)(BIG + rb * QKVD + 1024 + kvh * 128),
                                        (const att::bf16*)(BIG + rb * QKVD + 1280 + kvh * 128), (att::bf16*)(OB + q0 * DM + h * 128), 129, true, nullptr, (char*)lds); } }
            if (layer < 3) { GSYNC();
            { FRESH(); const float* PART = (const float*)(ws + WS_SUM) + zl; constexpr float C = 1.0f;
              for (int gt = bid * NTHREADS + tid; gt < 16 * 64 * 128; gt += G * NTHREADS) { const int bk = gt >> 13, R = (gt >> 7) & 63, d = gt & 127, b = bk >> 1, kvh = bk & 1;
                  const float* pb = PART + (size_t)bk * 43 * 8320;
                  float M = -3.0e38f;
                  for (int s = 0; s < 43; ++s) M = fmaxf(M, pb[(size_t)s * 8320 + 8192 + R * 2]);
                  float L = 0.f, O = 0.f;
                  for (int s = 0; s < 43; ++s) { const float w = __builtin_amdgcn_exp2f((pb[(size_t)s * 8320 + 8192 + R * 2] - M) * C);
                      L += w * pb[(size_t)s * 8320 + 8192 + R * 2 + 1]; O += w * pb[(size_t)s * 8320 + R * 128 + d]; }
                  const float v = O / L;
                  OB[((size_t)b * LTOK + (R & 15)) * DM + (kvh * 4 + (R >> 4)) * 128 + d] = (bf16raw)(cvt_pk(v, v) & 0xffffu); } } }
#endif
            GSYNC();
        }
        { const bf16raw* Ap = (layer & 1) ? OB : Yb; const bf16raw* Bp = (layer & 1) ? Wb + WO_AO + (size_t)slot * 1024 * 1024 : Wb + WO_LRU_OUT + (size_t)slot * 1024 * 1024;
          EpiPlain E{MB, DM, nullptr, TAILP}; GEMM_RUN_S(EpiPlain, Ap, Bp, 1024, 1024, E, true, TAIL_S); }
        GSYNC();
        { FRESH(); resid_pass(1, nullptr, nullptr, MB, U, RS, nullptr, gl + DM, nullptr, gw, NGW, lane, TAILP); }
        GSYNC();
        { EpiSwiglu E{BIG, RS}; GEMM_RUN_T(EpiSwiglu, U, Wb + WO_F1 + (size_t)layer * 5632 * 1024, 5632, 1024, E, true); }
        GSYNC();
        { EpiPlain E{MB, DM, nullptr, TAILP}; GEMM_RUN_S(EpiPlain, BIG, Wb + WO_F2 + (size_t)layer * 1024 * 2816, 1024, 2816, E, true, TAIL_S); }
        GSYNC();
        if (layer < 3) { { FRESH(); resid_pass(1, nullptr, nullptr, MB, U, RS, nullptr, gl + 3 * DM, nullptr, gw, NGW, lane, TAILP); } GSYNC(); }
        else { FRESH(); resid_pass(2, nullptr, nullptr, MB, U, RS, nullptr, gl + 3 * DM, args.out, gw, NGW, lane, TAILP); }
    }
}

extern "C" void kernel_launch(void* const* d_in, const int* in_sizes, int n_in, void* d_out, int out_size, void* d_ws, size_t ws_size, hipStream_t stream) {
    static int grid = 0;
    if (grid == 0) {
        if (n_in != 16 || ws_size < WS_END) { fprintf(stderr, "kernel_launch: n_in %d ws %zu (need %zu)\n", n_in, ws_size, (size_t)WS_END); grid = -1; return; }
        int dev = 0, cus = 0, per_cu = 0;
        hipGetDevice(&dev); hipDeviceGetAttribute(&cus, hipDeviceAttributeMultiprocessorCount, dev);
        if (hipFuncSetAttribute((const void*)mega_fwd, hipFuncAttributeMaxDynamicSharedMemorySize, LDS_BYTES) != hipSuccess) { fprintf(stderr, "kernel_launch: hipFuncSetAttribute failed\n"); grid = -1; return; }
        if (hipOccupancyMaxActiveBlocksPerMultiprocessor(&per_cu, (const void*)mega_fwd, NTHREADS, LDS_BYTES) != hipSuccess || per_cu < 1) { fprintf(stderr, "kernel_launch: occupancy query gave %d\n", per_cu); per_cu = 1; }
        (void)hipGetLastError();
        grid = cus * per_cu;
    }
    if (grid < 0) return;
    Args a{};
    for (int i = 0; i < 16; ++i) a.in[i] = (const float*)d_in[i];
    a.out = (float*)d_out; a.ws = (unsigned char*)d_ws;
    void* kargs[] = {&a};
    hipError_t e = hipLaunchCooperativeKernel((const void*)mega_fwd, dim3(grid), dim3(NTHREADS), kargs, LDS_BYTES, stream);
    if (e != hipSuccess) fprintf(stderr, "kernel_launch: cooperative launch failed: %s (grid %d)\n", hipGetErrorString(e), grid);
}
```

```cpp
#include <hip/hip_runtime.h>
#include <hip/hip_bf16.h>
#include <hip/hip_cooperative_groups.h>
#include <cstdio>
#include <cstdint>
#include <cmath>
namespace cg = cooperative_groups;

#define PG8_ROWS_VALID 65664
namespace pg8 {
#define PG8_LAS __attribute__((address_space(3)))
typedef unsigned short bf16_t;
typedef short bf16x8 __attribute__((ext_vector_type(8)));
typedef float f32x4 __attribute__((ext_vector_type(4)));
typedef unsigned u32x4 __attribute__((ext_vector_type(4)));
constexpr int BM = 256, BK = 64, HALF = 128, HTB = HALF * BK * 2  , STAGE_BYTES = 8 * HTB, NXCD = 8, WGM = 8;

__host__ __device__ __forceinline__ int lds_byte(int r, int c) { const int st = (r >> 4) * 2 + (c >> 5), rr = r & 15, cc = c & 31, ob = rr * 64 + cc * 2; return st * 1024 + (ob ^ (((ob >> 9) & 1) << 5)); }
__host__ __device__ __forceinline__ void stage_rc(int b, int& R, int& C) { const int st = b / 1024, sb = b % 1024, swz = sb ^ (((sb >> 9) & 1) << 5); R = (st >> 1) * 16 + swz / 64; C = (st & 1) * 32 + (swz % 64) / 2; }
__host__ __device__ __forceinline__ int perm32(int rho) { const int n = rho >> 4, i = rho & 15; return 8 * (i >> 2) + 4 * n + (i & 3); }

struct Unit { int pm, pn, k0, nt, part; };
struct Gemm { const bf16_t* A; const bf16_t* Bt; int M, N, K; };

struct StaticOrder {
    int nM, nN, nwg, G, c, ntail, ntK, S;
    __host__ __device__ void init(int M, int N, int K, int G_, int c_, bool with_tail = true, int S_ = 1) { nM = M / BM - 1; nN = N / BM; nwg = nM * nN; G = G_; c = c_; ntK = K / BK; S = S_; ntail = with_tail ? nN * S : 0; }
    __host__ __device__ bool next(int i, Unit& u) const {
        const long L = (long)i * G + c; if (L >= nwg + ntail) return false;
        u.k0 = 0; u.nt = ntK; u.part = 0;
        if (L >= nwg) { const int j = (int)(L - nwg); u.pm = nM; u.pn = j / S; const int p = j % S; u.part = p;
            if (S > 1) { const int pairs = ntK / 2, q = pairs / S, r = pairs % S; u.nt = 2 * (q + (p < r ? 1 : 0)); u.k0 = 2 * (p * q + (p < r ? p : r)); }
            return true; }
        int wgid = (int)L; { const int q = nwg / NXCD, r = nwg % NXCD, xcd = wgid % NXCD, off = wgid / NXCD; wgid = (xcd < r ? xcd * (q + 1) : r * (q + 1) + (xcd - r) * q) + off; }
        const int nig = WGM * nN, gid = wgid / nig, fm = gid * WGM, gsz = (nM - fm) < WGM ? (nM - fm) : WGM;
        u.pm = fm + ((wgid % nig) % gsz); u.pn = (wgid % nig) / gsz; return true;
    }
    __device__ __forceinline__ void a_ready(const Unit&) const {}
    __device__ __forceinline__ void done(const Unit&) const {}
};

__device__ __forceinline__ unsigned cvt_pk_bf16(float lo, float hi) { unsigned r; asm volatile("v_cvt_pk_bf16_f32 %0, %1, %2" : "=v"(r) : "v"(lo), "v"(hi)); return r; }
typedef float f32x2 __attribute__((ext_vector_type(2)));
__device__ __forceinline__ f32x2 gelu_pk(f32x2 v) {
    const f32x2 av = __builtin_elementwise_abs(v), d = av * 0.2316418882f + 1.0f;
    f32x2 t; t.x = __builtin_amdgcn_rcpf(d.x); t.y = __builtin_amdgcn_rcpf(d.y);
    f32x2 q = t * 0.5307027145f + (-0.7265760135f); q = q * t + 0.7107068705f; q = q * t + (-0.142248368f); q = q * t + 0.127414796f; q = q * t;
    const f32x2 s = (v * v) * (-0.72134752044f);
    f32x2 e; e.x = __builtin_amdgcn_exp2f(s.x); e.y = __builtin_amdgcn_exp2f(s.y);
    const f32x2 m = v * (q * e), r = v - m;
    f32x2 o; o.x = v.x < 0.f ? m.x : r.x; o.y = v.y < 0.f ? m.y : r.y; return o;
}

template <int ACT  > struct EpiBf16 {
    static constexpr bool PERM = true, AFTER_DRAIN = false; static_assert(ACT == 0 || ACT == 1, "EpiBf16: ACT is 0 (none) or 1 (gelu_pk)");
    bf16_t* O; int ldc; const float* bias; int split_cols; size_t split_stride; float scale0;
    __device__ __forceinline__ void operator()(const f32x4 (&acc)[2][2][4][2], const Unit& u, int wr, int wc, int fr, int fq) const {
        const int row0 = u.pm * BM + wr * 64 + fr; int colt = u.pn * BM; bf16_t* base = O;
        float sc = 1.f; if (split_cols) { const int t = colt / split_cols; base += (size_t)t * split_stride; colt -= t * split_cols; if (t == 0) sc = scale0; }
        const int col0 = colt + wc * 32 + 8 * fq, bcol0 = u.pn * BM + wc * 32 + 8 * fq;
        f32x4 bv[2][2];
#pragma unroll
        for (int bj = 0; bj < 2; ++bj)
#pragma unroll
            for (int n = 0; n < 2; ++n) bv[bj][n] = bias ? *(const f32x4*)(bias + bcol0 + bj * HALF + 4 * n) : (f32x4){0.f, 0.f, 0.f, 0.f};
#pragma unroll
        for (int ai = 0; ai < 2; ++ai)
#pragma unroll
            for (int m = 0; m < 4; ++m) { bf16_t* rowp = base + (size_t)(row0 + ai * HALF + m * 16) * ldc + col0;
#pragma unroll
                for (int bj = 0; bj < 2; ++bj) { f32x4 v0 = acc[ai][bj][m][0] + bv[bj][0], v1 = acc[ai][bj][m][1] + bv[bj][1];
                    if (ACT == 1) { f32x2 a = gelu_pk((f32x2){v0[0], v0[1]}), b = gelu_pk((f32x2){v0[2], v0[3]}), c = gelu_pk((f32x2){v1[0], v1[1]}), d = gelu_pk((f32x2){v1[2], v1[3]});
                        v0 = (f32x4){a.x, a.y, b.x, b.y}; v1 = (f32x4){c.x, c.y, d.x, d.y}; }
                    v0 = v0 * sc; v1 = v1 * sc; u32x4 w; w.x = cvt_pk_bf16(v0[0], v0[1]); w.y = cvt_pk_bf16(v0[2], v0[3]); w.z = cvt_pk_bf16(v1[0], v1[1]); w.w = cvt_pk_bf16(v1[2], v1[3]);
                    *(u32x4*)(rowp + bj * HALF) = w; } }
    }
};
template <class Epi, class Sched, bool ALIGN_EPI = false, bool SP2 = false>
__device__ __forceinline__ void gemm_phase(PG8_LAS unsigned char* lds, const Gemm g, const Sched& S, const Epi& E) {
    int tid_ = threadIdx.x; asm volatile("" : "+v"(tid_));
    const int tid = tid_, wid = __builtin_amdgcn_readfirstlane(tid >> 6), lane = tid & 63, wr = wid >> 2, wc = wid & 3, fr = lane & 15, fq = lane >> 4;
    const int K = g.K, nt = K / BK;
    unsigned voffA[2], voffB[2];
#pragma unroll
    for (int i = 0; i < 2; ++i) { int R, C; stage_rc(tid * 16 + i * 8192, R, C); const int Rb = Epi::PERM ? ((R & ~31) + perm32(R & 31)) : R;
        voffA[i] = (unsigned)(R * K + C) * 2u; voffB[i] = (unsigned)(Rb * K + C) * 2u; }
    const size_t kstep = (size_t)(BK * 2);
    const size_t hstep = (size_t)HALF * K * 2;
    const size_t tstep = 2 * hstep;
    const unsigned ldsw = (unsigned)wid * 1024u;
    const int aoff = lds_byte(wr * 64 + fr, fq * 8), boff = lds_byte(wc * 32 + fr, fq * 8);
#define PG8_SA(b, h) (((b) * 2 + (h)) * HTB)
#define PG8_SB(b, h) ((4 + (b) * 2 + (h)) * HTB)
#define PG8_STAGE(bufoff, gbase, voff) do { _Pragma("unroll") for (int _i = 0; _i < 2; ++_i) \
        __builtin_amdgcn_global_load_lds((const unsigned*)((const char*)(gbase) + (voff)[_i]), (PG8_LAS unsigned*)(lds + (bufoff) + ldsw + _i * 8192), 16, 0, 0); } while (0)
#define PG8_LDA(dst, b, h) do { _Pragma("unroll") for (int m = 0; m < 4; ++m) _Pragma("unroll") for (int k = 0; k < 2; ++k) dst[m][k] = *(const PG8_LAS bf16x8*)(lds + PG8_SA(b, h) + aoff + m * 2048 + k * 1024); } while (0)
#define PG8_LDB(dst, b, h) do { _Pragma("unroll") for (int n = 0; n < 2; ++n) _Pragma("unroll") for (int k = 0; k < 2; ++k) dst[n][k] = *(const PG8_LAS bf16x8*)(lds + PG8_SB(b, h) + boff + n * 2048 + k * 1024); } while (0)
#define PG8_MMA(ai, bj, At, Bt) do { __builtin_amdgcn_s_setprio(1); _Pragma("unroll") for (int m = 0; m < 4; ++m) _Pragma("unroll") for (int n = 0; n < 2; ++n) _Pragma("unroll") for (int k = 0; k < 2; ++k) \
        acc[ai][bj][m][n] = __builtin_amdgcn_mfma_f32_16x16x32_bf16(Bt[n][k], At[m][k], acc[ai][bj][m][n], 0, 0, 0); __builtin_amdgcn_s_setprio(0); } while (0)
#define PG8_WAIT_V(n) asm volatile("s_waitcnt vmcnt(" #n ")" ::: "memory")
#define PG8_WAIT_L(n) asm volatile("s_waitcnt lgkmcnt(" #n ")" ::: "memory")
#define PG8_BAR __builtin_amdgcn_s_barrier()
#define PG8_SCHED __builtin_amdgcn_sched_barrier(0)
    Unit cur, nxt; int ui = 0;
    if (!S.next(0, cur)) return;
    f32x4 acc[2][2][4][2];
#pragma unroll
    for (int a = 0; a < 2; ++a)
#pragma unroll
        for (int b = 0; b < 2; ++b)
#pragma unroll
            for (int m = 0; m < 4; ++m)
#pragma unroll
                for (int n = 0; n < 2; ++n) acc[a][b][m][n] = (f32x4){0.f, 0.f, 0.f, 0.f};
    bf16x8 At[4][2], B0[2][2], B1[2][2];
    const char* cA = (const char*)g.A + (size_t)cur.pm * tstep + (size_t)cur.k0 * kstep; const char* cB = (const char*)g.Bt + (size_t)cur.pn * tstep + (size_t)cur.k0 * kstep;
    S.a_ready(cur);
    if constexpr (SP2) {
        PG8_STAGE(PG8_SB(0, 0), cB, voffB); PG8_STAGE(PG8_SB(0, 1), cB + hstep, voffB); PG8_STAGE(PG8_SA(0, 0), cA, voffA); PG8_STAGE(PG8_SA(0, 1), cA + hstep, voffA);
        if (wr == 1) PG8_BAR;
        PG8_WAIT_V(2); PG8_BAR;
        PG8_STAGE(PG8_SB(1, 0), cB + kstep, voffB); PG8_STAGE(PG8_SA(1, 0), cA + kstep, voffA); PG8_STAGE(PG8_SB(1, 1), cB + hstep + kstep, voffB);
        PG8_WAIT_V(6); PG8_BAR;
    } else {
        PG8_STAGE(PG8_SB(0, 0), cB, voffB); PG8_STAGE(PG8_SA(0, 0), cA, voffA); PG8_STAGE(PG8_SB(0, 1), cB + hstep, voffB); PG8_STAGE(PG8_SA(0, 1), cA + hstep, voffA);
        if (wr == 1) PG8_BAR;
        PG8_WAIT_V(4); PG8_BAR;
        PG8_STAGE(PG8_SB(1, 0), cB + kstep, voffB); PG8_STAGE(PG8_SA(1, 0), cA + kstep, voffA); PG8_STAGE(PG8_SB(1, 1), cB + hstep + kstep, voffB);
        PG8_WAIT_V(6); PG8_BAR;
    }
    for (;;) {
        const bool has_next = S.next(ui + 1, nxt);
        const bool full = (cur.pm * BM + HALF) < PG8_ROWS_VALID;
        const char* nA = has_next ? (const char*)g.A + (size_t)nxt.pm * tstep + (size_t)nxt.k0 * kstep : cA; const char* nB = has_next ? (const char*)g.Bt + (size_t)nxt.pn * tstep + (size_t)nxt.k0 * kstep : cB;
        const int ntu = cur.nt;
        for (int t = 0; t < ntu; t += 2) {
            const bool last = (t == ntu - 2);
            const char* a1 = cA + (size_t)(t + 1) * kstep;
            const char* a2 = last ? nA : cA + (size_t)(t + 2) * kstep; const char* b2 = last ? nB : cB + (size_t)(t + 2) * kstep;
            const char* a3 = a2 + kstep; const char* b3 = b2 + kstep;
            if (last && has_next) S.a_ready(nxt);
            if constexpr (SP2) {
            PG8_LDB(B0, 0, 0); PG8_LDB(B1, 0, 1); PG8_SCHED; PG8_LDA(At, 0, 0); PG8_STAGE(PG8_SA(1, 1), a1 + hstep, voffA);
            PG8_WAIT_V(8); PG8_WAIT_L(0); PG8_BAR; PG8_MMA(0, 0, At, B0); PG8_MMA(0, 1, At, B1); PG8_BAR; PG8_SCHED;
            PG8_LDA(At, 0, 1); PG8_STAGE(PG8_SB(0, 0), b2, voffB); PG8_STAGE(PG8_SB(0, 1), b2 + hstep, voffB); PG8_STAGE(PG8_SA(0, 0), a2, voffA);
            PG8_WAIT_V(8); PG8_WAIT_L(0); PG8_BAR; if (full) { PG8_MMA(1, 0, At, B0); PG8_MMA(1, 1, At, B1); } PG8_BAR; PG8_SCHED;
            PG8_LDB(B0, 1, 0); PG8_LDB(B1, 1, 1); PG8_SCHED; PG8_LDA(At, 1, 0); PG8_STAGE(PG8_SA(0, 1), a2 + hstep, voffA);
            PG8_WAIT_V(8); PG8_WAIT_L(0); PG8_BAR; PG8_MMA(0, 0, At, B0); PG8_MMA(0, 1, At, B1); PG8_BAR; PG8_SCHED;
            PG8_LDA(At, 1, 1); PG8_STAGE(PG8_SB(1, 0), b3, voffB); PG8_STAGE(PG8_SB(1, 1), b3 + hstep, voffB); PG8_STAGE(PG8_SA(1, 0), a3, voffA);
            PG8_WAIT_V(8); PG8_WAIT_L(0); PG8_BAR; if (full) { PG8_MMA(1, 0, At, B0); PG8_MMA(1, 1, At, B1); } PG8_BAR; PG8_SCHED;
            } else {
            PG8_LDB(B0, 0, 0); PG8_SCHED; PG8_LDA(At, 0, 0); PG8_STAGE(PG8_SA(1, 1), a1 + hstep, voffA);
            PG8_WAIT_L(8); PG8_BAR; PG8_WAIT_L(0); PG8_MMA(0, 0, At, B0); PG8_BAR; PG8_SCHED;
            PG8_LDB(B1, 0, 1); PG8_STAGE(PG8_SB(0, 0), b2, voffB);
            PG8_BAR; PG8_WAIT_L(0); PG8_MMA(0, 1, At, B1); PG8_BAR;
            PG8_LDA(At, 0, 1); PG8_STAGE(PG8_SA(0, 0), a2, voffA);
            PG8_BAR; PG8_WAIT_L(0); PG8_MMA(1, 0, At, B0); PG8_BAR; PG8_SCHED;
            PG8_STAGE(PG8_SB(0, 1), b2 + hstep, voffB);
            PG8_WAIT_V(6); PG8_BAR; PG8_MMA(1, 1, At, B1); PG8_BAR;
            PG8_LDB(B0, 1, 0); PG8_SCHED; PG8_LDA(At, 1, 0); PG8_STAGE(PG8_SA(0, 1), a2 + hstep, voffA);
            PG8_WAIT_L(8); PG8_BAR; PG8_WAIT_L(0); PG8_MMA(0, 0, At, B0); PG8_BAR; PG8_SCHED;
            PG8_LDB(B1, 1, 1); PG8_STAGE(PG8_SB(1, 0), b3, voffB);
            PG8_BAR; PG8_WAIT_L(0); PG8_MMA(0, 1, At, B1); PG8_BAR;
            PG8_LDA(At, 1, 1); PG8_STAGE(PG8_SA(1, 0), a3, voffA);
            PG8_BAR; PG8_WAIT_L(0); PG8_MMA(1, 0, At, B0); PG8_BAR; PG8_SCHED;
            PG8_STAGE(PG8_SB(1, 1), b3 + hstep, voffB);
            PG8_WAIT_V(6); PG8_BAR; PG8_MMA(1, 1, At, B1); PG8_BAR;
            }
        }
        if constexpr (ALIGN_EPI) { if (wr == 0) PG8_BAR; }
        if constexpr (!Epi::AFTER_DRAIN) { E(acc, cur, wr, wc, fr, fq); S.done(cur); }
        if (!has_next) break;
#pragma unroll
        for (int a = 0; a < 2; ++a)
#pragma unroll
            for (int b = 0; b < 2; ++b)
#pragma unroll
                for (int m = 0; m < 4; ++m)
#pragma unroll
                    for (int n = 0; n < 2; ++n) acc[a][b][m][n] = (f32x4){0.f, 0.f, 0.f, 0.f};
        cur = nxt; cA = nA; cB = nB; ++ui;
        if constexpr (ALIGN_EPI) { if (wr == 1) PG8_BAR; }
    }
    PG8_WAIT_V(0);
    if constexpr (!ALIGN_EPI) { if (wr == 0) PG8_BAR; }
    PG8_BAR;
    if constexpr (Epi::AFTER_DRAIN) { E.fused(acc, cur, wr, wc, fr, fq, lds, wid, lane); S.done(cur); }
#undef PG8_SA
#undef PG8_SB
#undef PG8_STAGE
#undef PG8_LDA
#undef PG8_LDB
#undef PG8_MMA
#undef PG8_WAIT_V
#undef PG8_WAIT_L
#undef PG8_BAR
#undef PG8_SCHED
}
}

namespace att {
using bf16 = __hip_bfloat16;
constexpr int D = 128, NW = 8, QBLK = 32, KVBLK = 64;
constexpr float SCALE = 0.088388347648318440f;
constexpr float THR = 8.f;
constexpr int SDEPTH = 2;
constexpr int LDQ = 1536, LDK = 1536, LDO = 1024;
constexpr size_t SHM_V = KVBLK * D * 2, SHM_K = KVBLK * D * 2, SHM_ATTN = 2 * SHM_V + 2 * SHM_K + NW * 64 * 4;
using bf16x8 = __attribute__((ext_vector_type(8))) short;
using s16x4  = __attribute__((ext_vector_type(4))) short;
using f32x16 = __attribute__((ext_vector_type(16))) float;
using u32x4  = __attribute__((ext_vector_type(4))) unsigned;
#define KSWZ(row, colB) ((row) * 256 + ((colB) ^ (((row) & 7) << 4)))
#define SBAR() __builtin_amdgcn_sched_barrier(0)
__device__ __forceinline__ int crow(int r, int hi) { return (r & 3) + 8 * (r >> 2) + 4 * hi; }
__device__ __forceinline__ unsigned cvtpk(float lo, float hi) {
  unsigned r; asm volatile("v_cvt_pk_bf16_f32 %0, %1, %2" : "=v"(r) : "v"(lo), "v"(hi)); return r;
}
__device__ __forceinline__ bf16x8 ld8(const bf16* p) { return *reinterpret_cast<const bf16x8*>(p); }

__device__ __forceinline__ void partialSM(f32x16& p0, f32x16& p1, float& m_reg, float& mn, float& alpha) {
  constexpr float THRL = THR * 1.4426950408889634f;
  float pmax = p0[0]; for (int r = 1; r < 16; ++r) pmax = fmaxf(pmax, p0[r]); for (int r = 0; r < 16; ++r) pmax = fmaxf(pmax, p1[r]);
  { auto rr = __builtin_amdgcn_permlane32_swap(__float_as_uint(pmax), __float_as_uint(pmax), false, false);
    pmax = fmaxf(__uint_as_float(rr[0]), __uint_as_float(rr[1])); }
  if (__builtin_expect(__all(pmax - m_reg <= THRL), 1)) { mn = m_reg; alpha = 1.f; }
  else { mn = fmaxf(m_reg, pmax); alpha = __builtin_amdgcn_exp2f(m_reg - mn); m_reg = mn; }
  for (int r = 0; r < 16; ++r) p0[r] = p0[r] - mn; for (int r = 0; r < 16; ++r) p1[r] = p1[r] - mn;
  for (int r = 0; r < 16; ++r) p0[r] = __builtin_amdgcn_exp2f(p0[r]);
}
__device__ __forceinline__ void partialSM_fixed(f32x16& p0) {
  for (int r = 0; r < 16; ++r) p0[r] = __builtin_amdgcn_exp2f(p0[r]);
}
__device__ __forceinline__ void finishSM(f32x16& p0, f32x16& p1, float alpha, float& l_reg, bf16x8& pa0, bf16x8& pa1, bf16x8& pa2, bf16x8& pa3) {
  for (int r = 0; r < 16; ++r) p1[r] = __builtin_amdgcn_exp2f(p1[r]);
  float ps = 0; for (int r = 0; r < 16; ++r) ps += p0[r]; for (int r = 0; r < 16; ++r) ps += p1[r];
  { auto rr = __builtin_amdgcn_permlane32_swap(__float_as_uint(ps), __float_as_uint(ps), false, false);
    ps = __uint_as_float(rr[0]) + __uint_as_float(rr[1]); }
  l_reg = l_reg * alpha + ps;
#define PK4(P, BASE, OUT) do { unsigned a0 = cvtpk(P[BASE + 0], P[BASE + 1]), a1 = cvtpk(P[BASE + 2], P[BASE + 3]);   \
    unsigned b0 = cvtpk(P[BASE + 4], P[BASE + 5]), b1 = cvtpk(P[BASE + 6], P[BASE + 7]);                              \
    auto r0 = __builtin_amdgcn_permlane32_swap(a0, b0, false, false); auto r1 = __builtin_amdgcn_permlane32_swap(a1, b1, false, false); \
    u32x4 w = {r0[0], r1[0], r0[1], r1[1]}; OUT = *reinterpret_cast<bf16x8*>(&w); } while (0)
  PK4(p0, 0, pa0); PK4(p0, 8, pa1); PK4(p1, 0, pa2); PK4(p1, 8, pa3);
#undef PK4
}
__device__ __forceinline__ void qkt(f32x16& p0, f32x16& p1, const bf16* Ks, const bf16x8* qr, int r32, int hi) {
  p0 = f32x16{}; p1 = f32x16{};
  for (int d0 = 0; d0 < 8; ++d0) { int cb = (d0 * 16 + hi * 8) * 2;
    bf16x8 b0 = *reinterpret_cast<const bf16x8*>((const char*)Ks + KSWZ(r32, cb));
    bf16x8 b1 = *reinterpret_cast<const bf16x8*>((const char*)Ks + KSWZ(32 + r32, cb));
    p0 = __builtin_amdgcn_mfma_f32_32x32x16_bf16(b0, qr[d0], p0, 0, 0, 0);
    p1 = __builtin_amdgcn_mfma_f32_32x32x16_bf16(b1, qr[d0], p1, 0, 0, 0); }
}
__device__ __forceinline__ int v_st(int k, int c) { const int kk = (k & ~0xC) | ((k & 4) << 1) | ((k & 8) >> 1); return ((kk >> 3) * 4 + (c >> 5)) * 512 + ((kk & 7) * 32 + (c & 31)) * 2; }
__device__ __forceinline__ int v_rd_base(int lane) { return ((lane & 3) << 3) | (((lane >> 2) & 3) << 6) | (((lane >> 4) & 1) << 5) | (((lane >> 5) & 1) << 8); }
constexpr int v_rd_off(int d0, int ks, int half) { return d0 * 512 + ks * 4096 + half * 2048; }
template <int OFF> __device__ __forceinline__ s16x4 tr_read(int vb) {
  s16x4 r; asm volatile("ds_read_b64_tr_b16 %0, %1 offset:%2" : "=&v"(r) : "v"(vb), "i"(OFF) : "memory"); return r;
}
template <int D0> __device__ __forceinline__ void pv_one(f32x16& od, int vb, bf16x8 pa0, bf16x8 pa1, bf16x8 pa2, bf16x8 pa3) {
  const s16x4 l0 = tr_read<v_rd_off(D0, 0, 0)>(vb), h0 = tr_read<v_rd_off(D0, 0, 1)>(vb), l1 = tr_read<v_rd_off(D0, 1, 0)>(vb), h1 = tr_read<v_rd_off(D0, 1, 1)>(vb);
  const s16x4 l2 = tr_read<v_rd_off(D0, 2, 0)>(vb), h2 = tr_read<v_rd_off(D0, 2, 1)>(vb), l3 = tr_read<v_rd_off(D0, 3, 0)>(vb), h3 = tr_read<v_rd_off(D0, 3, 1)>(vb);
  asm volatile("s_waitcnt lgkmcnt(0)" ::: "memory"); SBAR();
#define PK(L, H) (bf16x8){L[0], L[1], L[2], L[3], H[0], H[1], H[2], H[3]}
  od = __builtin_amdgcn_mfma_f32_32x32x16_bf16(pa0, PK(l0, h0), od, 0, 0, 0);
  od = __builtin_amdgcn_mfma_f32_32x32x16_bf16(pa1, PK(l1, h1), od, 0, 0, 0);
  od = __builtin_amdgcn_mfma_f32_32x32x16_bf16(pa2, PK(l2, h2), od, 0, 0, 0);
  od = __builtin_amdgcn_mfma_f32_32x32x16_bf16(pa3, PK(l3, h3), od, 0, 0, 0);
#undef PK
}
__device__ __forceinline__ void pv_d0(f32x16* o, int vb, bf16x8 pa0, bf16x8 pa1, bf16x8 pa2, bf16x8 pa3) {
  pv_one<0>(o[0], vb, pa0, pa1, pa2, pa3); pv_one<1>(o[1], vb, pa0, pa1, pa2, pa3); pv_one<2>(o[2], vb, pa0, pa1, pa2, pa3); pv_one<3>(o[3], vb, pa0, pa1, pa2, pa3);
}

struct AttSlot { bf16x8 vs0, vs1, ks0, ks1; };
struct AttCarry { bf16x8 qr[8]; AttSlot s[2]; };
__device__ __forceinline__ void att_preload(AttCarry& cy, const bf16* Qrow, const bf16* Kh, const bf16* Vh) {
  const int tid = threadIdx.x, sr = tid >> 4, sc = (tid & 15) * 8;
#pragma unroll
  for (int d0 = 0; d0 < 8; ++d0) cy.qr[d0] = ld8(Qrow + d0 * 16);
#pragma unroll
  for (int i = 0; i < 2; ++i) { const int k0 = i * KVBLK;
    cy.s[i].vs0 = ld8(&Vh[(long)(k0 + sr) * LDK + sc]); cy.s[i].vs1 = ld8(&Vh[(long)(k0 + 32 + sr) * LDK + sc]);
    cy.s[i].ks0 = ld8(&Kh[(long)(k0 + sr) * LDK + sc]); cy.s[i].ks1 = ld8(&Kh[(long)(k0 + 32 + sr) * LDK + sc]); }
}
template <bool PARTIAL, bool FIXED>
__device__ __forceinline__ void attn_unit(const bf16* __restrict__ Qrow, const bf16* __restrict__ Kh, const bf16* __restrict__ Vh,
                                          bf16* __restrict__ Ob, int NT, bool mask_last, float* __restrict__ PO, char* lds,
                                          const bf16* Qb_n = nullptr, const bf16* Kh_n = nullptr, const bf16* Vh_n = nullptr) {
  AttCarry cy; unsigned warm0 = 0u, warm1 = 0u;
  int tid_ = threadIdx.x; asm volatile("" : "+v"(tid_));
  const int tid = tid_, wid = tid >> 6, lane = tid & 63, r32 = lane & 31, hi = lane >> 5;
  bf16* V_lds = (bf16*)lds; bf16* K_lds = (bf16*)(lds + 3 * SHM_V);
  float* ws = (float*)(lds + 3 * SHM_V + 3 * SHM_K) + wid * 64; float* li_l = ws; float* al_l = ws + 32;
  float m_reg = FIXED ? 0.f : -1e30f, l_reg = 0; f32x16 o[4] = {}; bf16x8 (&qr)[8] = cy.qr;
  const bf16* Qw = Qrow;
  const int sr = tid >> 4, sc = (tid & 15) * 8, vst0 = v_st(sr, sc), vst1 = v_st(32 + sr, sc);
  const int vb0 = (int)(uintptr_t)V_lds + v_rd_base(lane);
  AttSlot (&sr_)[2] = cy.s;
#define SLOAD(i, k0) do { sr_[i].vs0 = ld8(&Vh[(long)((k0) + sr) * LDK + sc]); sr_[i].vs1 = ld8(&Vh[(long)((k0) + 32 + sr) * LDK + sc]); \
    sr_[i].ks0 = ld8(&Kh[(long)((k0) + sr) * LDK + sc]); sr_[i].ks1 = ld8(&Kh[(long)((k0) + 32 + sr) * LDK + sc]); } while (0)
#define SLOADP(i, Kp, Vp, k0) do { sr_[i].vs0 = ld8(&(Vp)[(long)((k0) + sr) * LDK + sc]); sr_[i].vs1 = ld8(&(Vp)[(long)((k0) + 32 + sr) * LDK + sc]); \
    sr_[i].ks0 = ld8(&(Kp)[(long)((k0) + sr) * LDK + sc]); sr_[i].ks1 = ld8(&(Kp)[(long)((k0) + 32 + sr) * LDK + sc]); } while (0)
#define SWRITE(b, i) do { *(bf16x8*)((char*)V_lds + (b) * SHM_V + vst0) = sr_[i].vs0;          \
    *(bf16x8*)((char*)V_lds + (b) * SHM_V + vst1) = sr_[i].vs1; int kc = sc * 2;               \
    *(bf16x8*)((char*)K_lds + (b) * SHM_K + KSWZ(sr, kc)) = sr_[i].ks0;                       \
    *(bf16x8*)((char*)K_lds + (b) * SHM_K + KSWZ(32 + sr, kc)) = sr_[i].ks1; } while (0)
#define SWAIT() asm volatile("s_waitcnt vmcnt(4)" ::: "memory")
#define RESC(a) do { if (__any((a) < 1.f)) { if (hi == 0) al_l[r32] = (a); asm volatile("s_waitcnt lgkmcnt(0)" ::: "memory"); \
    for (int d = 0; d < 4; ++d) for (int r = 0; r < 16; ++r) o[d][r] *= al_l[crow(r, hi)]; } } while (0)
  f32x16 pA0, pA1, pB0, pB1; float mnA, mnB, alA, alB; bf16x8 pa0, pa1, pa2, pa3;
  int bp = 0, bc = 1, bn = 2;
#pragma unroll
  for (int d0 = 0; d0 < 8; ++d0) qr[d0] = ld8(Qw + d0 * 16);
  SLOAD(0, 0); SLOAD(1, KVBLK);
  SWRITE(0, 0); __syncthreads();
  qkt(pA0, pA1, K_lds, qr, r32, hi);
  SLOAD(0, 2 * KVBLK); SBAR();
  if constexpr (FIXED) { partialSM_fixed(pA0); alA = 1.f; } else partialSM(pA0, pA1, m_reg, mnA, alA);
  SWAIT(); SWRITE(1, 1);
#define ROT3() do { const int t_ = bp; bp = bc; bc = bn; bn = t_; } while (0)
  int j = 1;
  for (; j + 2 < NT; j += 2) {
    __syncthreads();
    SBAR(); qkt(pB0, pB1, (bf16*)((char*)K_lds + bc * SHM_K), qr, r32, hi);
    finishSM(pA0, pA1, alA, l_reg, pa0, pa1, pa2, pa3); SBAR();
    SLOAD(1, (j + 2) * KVBLK); SBAR();
    pv_d0(o, vb0 + bp * (int)SHM_V, pa0, pa1, pa2, pa3);
    if constexpr (FIXED) { partialSM_fixed(pB0); alB = 1.f; } else { partialSM(pB0, pB1, m_reg, mnB, alB); RESC(alB); }
    SWAIT(); SWRITE(bn, 0);
    ROT3();
    __syncthreads();
    SBAR(); qkt(pA0, pA1, (bf16*)((char*)K_lds + bc * SHM_K), qr, r32, hi);
    finishSM(pB0, pB1, alB, l_reg, pa0, pa1, pa2, pa3); SBAR();
    SLOAD(0, (j + 3) * KVBLK); SBAR();
    pv_d0(o, vb0 + bp * (int)SHM_V, pa0, pa1, pa2, pa3);
    if constexpr (FIXED) { partialSM_fixed(pA0); alA = 1.f; } else { partialSM(pA0, pA1, m_reg, mnA, alA); RESC(alA); }
    SWAIT(); SWRITE(bn, 1);
    ROT3();
  }
  {
    __syncthreads();
    SBAR(); qkt(pB0, pB1, (bf16*)((char*)K_lds + bc * SHM_K), qr, r32, hi);
    finishSM(pA0, pA1, alA, l_reg, pa0, pa1, pa2, pa3); SBAR();
    if constexpr (!PARTIAL) { const int i1 = tid & 255;
      warm0 = *(const unsigned*)(Qb_n + (long)(tid >> 1) * LDQ + (tid & 1) * 64);
      warm1 = *(const unsigned*)((tid < 256 ? Kh_n : Vh_n) + (long)(i1 >> 1) * LDK + (i1 & 1) * 64); }
    SBAR();
    pv_d0(o, vb0 + bp * (int)SHM_V, pa0, pa1, pa2, pa3);
    if constexpr (FIXED) { partialSM_fixed(pB0); alB = 1.f; } else { partialSM(pB0, pB1, m_reg, mnB, alB); RESC(alB); }
    SWRITE(bn, 0);
    ROT3();
    __syncthreads();
    SBAR(); qkt(pA0, pA1, (bf16*)((char*)K_lds + bc * SHM_K), qr, r32, hi);
    if (mask_last) {
      asm volatile("; masked tail tile" ::: "memory");
      const float NEG = -INFINITY;
#pragma unroll
      for (int r = 8; r < 16; ++r) pA0[r] = NEG;
#pragma unroll
      for (int r = 0; r < 16; ++r) pA1[r] = NEG;
    }
    finishSM(pB0, pB1, alB, l_reg, pa0, pa1, pa2, pa3); SBAR();
    pv_d0(o, vb0 + bp * (int)SHM_V, pa0, pa1, pa2, pa3);
    if constexpr (FIXED) { partialSM_fixed(pA0); alA = 1.f; } else { partialSM(pA0, pA1, m_reg, mnA, alA); RESC(alA); }
    ROT3();
  }
#undef ROT3
  SBAR(); finishSM(pA0, pA1, alA, l_reg, pa0, pa1, pa2, pa3); SBAR();
  pv_d0(o, vb0 + bp * (int)SHM_V, pa0, pa1, pa2, pa3);
  if (PARTIAL) {
    if (wid < 2) { float* po = PO + (wid * QBLK) * 128;
#pragma unroll
      for (int r = 0; r < 16; ++r) { const int orow = crow(r, hi);
#pragma unroll
        for (int d0 = 0; d0 < 4; ++d0) po[orow * 128 + d0 * 32 + r32] = o[d0][r]; }
      if (hi == 0) { PO[8192 + (wid * QBLK + r32) * 2] = m_reg; PO[8192 + (wid * QBLK + r32) * 2 + 1] = l_reg; } }
    __syncthreads();
    return;
  }
  if (hi == 0) li_l[r32] = l_reg; asm volatile("s_waitcnt lgkmcnt(0)" ::: "memory");
  float rli[16];
#pragma unroll
  for (int r = 0; r < 16; ++r) rli[r] = __builtin_amdgcn_rcpf(li_l[crow(r, hi)]);
  __syncthreads();
  unsigned short* stg = (unsigned short*)(lds + wid * 8192);
#pragma unroll
  for (int r = 0; r < 16; ++r) { const int orow = crow(r, hi);
#pragma unroll
    for (int d0 = 0; d0 < 4; ++d0) { const float v = o[d0][r] * rli[r]; stg[orow * 128 + d0 * 32 + r32] = (unsigned short)(cvtpk(v, v) & 0xffffu); } }
  asm volatile("s_waitcnt lgkmcnt(0)" ::: "memory");
#pragma unroll
  for (int it = 0; it < 8; ++it) { const int row = it * 4 + (lane >> 4), c16 = lane & 15;
    const bf16x8 v = *reinterpret_cast<const bf16x8*>((const char*)stg + row * 256 + c16 * 16);
    *reinterpret_cast<bf16x8*>(Ob + (long)(wid * QBLK + row) * LDO + c16 * 8) = v; }
  asm volatile("" :: "v"(warm0 ^ warm1));
  __syncthreads();
#undef SLOAD
#undef SLOADP
#undef SWRITE
#undef SWAIT
#undef RESC
}
#undef KSWZ
#undef SBAR
}

#define LAS __attribute__((address_space(3)))
typedef unsigned short bf16raw;
typedef short bf16x8 __attribute__((ext_vector_type(8)));
typedef float f32x4 __attribute__((ext_vector_type(4)));
typedef float f32x2 __attribute__((ext_vector_type(2)));
typedef unsigned u32x4 __attribute__((ext_vector_type(4)));
typedef unsigned u32x2 __attribute__((ext_vector_type(2)));

constexpr int DM = 1024, NB = 8, SEQ = 8192, NMETA = 16, LTOK = SEQ + NMETA, MTOK = NB * LTOK, MPAD = 65792;
constexpr int DFF = 2816, QKVD = 1536, NTHREADS = 512;
constexpr float RMS_EPS = 1e-6f;
constexpr int LDS_BYTES = 147456;
static_assert(MPAD % 256 == 0 && MPAD >= MTOK + 128, "row padding");
constexpr size_t WS_H = 0;
constexpr size_t WS_U = WS_H + (size_t)MPAD * DM * 4;
constexpr size_t WS_BIG = WS_U + (size_t)MPAD * DM * 2;
constexpr size_t WS_MB = WS_BIG + (size_t)MPAD * DFF * 2;
constexpr size_t WS_W = WS_MB + (size_t)MPAD * DM * 2;
constexpr size_t WO_LRU_IN = 0, WO_LRU_OUT = WO_LRU_IN + 2ul * 2048 * 1024, WO_GATE = WO_LRU_OUT + 2ul * 1024 * 1024, WO_QKV = WO_GATE + 64ul * 128 * 128,
                 WO_AO = WO_QKV + 2ul * 1536 * 1024, WO_F1 = WO_AO + 2ul * 1024 * 1024, WO_F2 = WO_F1 + 4ul * 5632 * 1024, WO_END = WO_F2 + 4ul * 1024 * 2816;
constexpr int LT = 48, NCHUNK = LTOK / LT;
static_assert(NCHUNK * LT == LTOK, "chunking");
constexpr size_t WS_SUM = WS_W + WO_END * 2;
constexpr size_t WS_CARRY = WS_SUM + (size_t)NB * NCHUNK * 2 * 1024 * 8;
constexpr size_t WS_ROPE = WS_CARRY + (size_t)NB * NCHUNK * 2 * 1024 * 4;
constexpr size_t WS_CTL = WS_ROPE + 128 * 32 * 8;
constexpr size_t WS_TAILP = WS_CTL + 16384;
constexpr size_t WS_END = WS_TAILP + 4ul * 128 * 1024 * 4;
constexpr int MREG = 65536, TAIL_S = 4;
constexpr int LDS_MISC = 147200;

__device__ __forceinline__ unsigned cvt_pk(float lo, float hi) { unsigned r; asm volatile("v_cvt_pk_bf16_f32 %0, %1, %2" : "=v"(r) : "v"(lo), "v"(hi)); return r; }
__device__ __forceinline__ float bf_lo(unsigned w) { return __uint_as_float(w << 16); }
__device__ __forceinline__ float bf_hi(unsigned w) { return __uint_as_float(w & 0xffff0000u); }
__device__ __forceinline__ float wave_sum(float v) {
#pragma unroll
    for (int o = 1; o < 64; o <<= 1) v += __shfl_xor(v, o);
    return v;
}
__device__ __forceinline__ float sigmoidf_fast(float x) { return __builtin_amdgcn_rcpf(1.0f + __builtin_amdgcn_exp2f(-1.4426950408889634f * x)); }
__device__ __forceinline__ float gelu_tanh(float x) {
    const float z = x * (1.0f + 0.044715f * x * x) * (2.0f * 0.7978845608028654f);
    return x * sigmoidf_fast(z);
}

struct EpiPlain {
    static constexpr bool PERM = true, AFTER_DRAIN = false, ALIGN = true;
    bf16raw* O; int ldc; const float* rs; float* tailp;
    __device__ __forceinline__ void operator()(const f32x4 (&acc)[2][2][4][2], const pg8::Unit& u, int wr, int wc, int fr, int fq) const {
        const int row0 = u.pm * 256 + wr * 64 + fr, col0 = u.pn * 256 + wc * 32 + 8 * fq;
        if (tailp && u.pm * 256 >= MREG) {
#pragma unroll
            for (int m = 0; m < 4; ++m) { float* rowp = tailp + ((size_t)u.part * 128 + wr * 64 + m * 16 + fr) * 1024 + col0;
#pragma unroll
                for (int bj = 0; bj < 2; ++bj) { *(f32x4*)(rowp + bj * 128) = acc[0][bj][m][0]; *(f32x4*)(rowp + bj * 128 + 4) = acc[0][bj][m][1]; } }
            return; }
#pragma unroll
        for (int ai = 0; ai < 2; ++ai)
#pragma unroll
            for (int m = 0; m < 4; ++m) { bf16raw* rowp = O + (size_t)(row0 + ai * 128 + m * 16) * ldc + col0; const float sc = rs ? rs[row0 + ai * 128 + m * 16] : 1.0f;
#pragma unroll
                for (int bj = 0; bj < 2; ++bj) { const f32x4 v0 = acc[ai][bj][m][0] * sc, v1 = acc[ai][bj][m][1] * sc;
                    u32x4 w; w.x = cvt_pk(v0[0], v0[1]); w.y = cvt_pk(v0[2], v0[3]); w.z = cvt_pk(v1[0], v1[1]); w.w = cvt_pk(v1[2], v1[3]);
                    *(u32x4*)(rowp + bj * 128) = w; } }
    }
};
struct EpiLruIn {
    static constexpr bool PERM = true, AFTER_DRAIN = false, ALIGN = true;
    bf16raw* Y; bf16raw* X; const float* rs;
    __device__ __forceinline__ void operator()(const f32x4 (&acc)[2][2][4][2], const pg8::Unit& u, int wr, int wc, int fr, int fq) const {
        const bool isy = u.pn < 4; bf16raw* base = isy ? Y : X;
        const int row0 = u.pm * 256 + wr * 64 + fr, col0 = (isy ? u.pn : u.pn - 4) * 256 + wc * 32 + 8 * fq;
#pragma unroll
        for (int ai = 0; ai < 2; ++ai)
#pragma unroll
            for (int m = 0; m < 4; ++m) { bf16raw* rowp = base + (size_t)(row0 + ai * 128 + m * 16) * DM + col0; const float sc = rs[row0 + ai * 128 + m * 16];
#pragma unroll
                for (int bj = 0; bj < 2; ++bj) { f32x4 v0 = acc[ai][bj][m][0] * sc, v1 = acc[ai][bj][m][1] * sc;
                    if (isy) {
#pragma unroll
                        for (int i = 0; i < 4; ++i) { v0[i] = gelu_tanh(v0[i]); v1[i] = gelu_tanh(v1[i]); } }
                    u32x4 w; w.x = cvt_pk(v0[0], v0[1]); w.y = cvt_pk(v0[2], v0[3]); w.z = cvt_pk(v1[0], v1[1]); w.w = cvt_pk(v1[2], v1[3]);
                    *(u32x4*)(rowp + bj * 128) = w; } }
    }
};
struct EpiSwiglu {
    static constexpr bool PERM = true, AFTER_DRAIN = false, ALIGN = true;
    bf16raw* O; const float* rs;
    __device__ __forceinline__ void operator()(const f32x4 (&acc)[2][2][4][2], const pg8::Unit& u, int wr, int wc, int fr, int fq) const {
        const int row0 = u.pm * 256 + wr * 64 + fr, col0 = u.pn * 128 + wc * 32 + 8 * fq;
#pragma unroll
        for (int ai = 0; ai < 2; ++ai)
#pragma unroll
            for (int m = 0; m < 4; ++m) { bf16raw* rowp = O + (size_t)(row0 + ai * 128 + m * 16) * DFF + col0; const float sc = rs[row0 + ai * 128 + m * 16];
                unsigned wv[4];
#pragma unroll
                for (int n = 0; n < 2; ++n)
#pragma unroll
                    for (int ip = 0; ip < 4; ip += 2) {
                        const f32x2 g = (f32x2){acc[ai][0][m][n][ip], acc[ai][0][m][n][ip + 1]} * sc, up = (f32x2){acc[ai][1][m][n][ip], acc[ai][1][m][n][ip + 1]} * sc;
                        const f32x2 t = g * (-1.4426950408889634f);
                        f32x2 ex; ex.x = __builtin_amdgcn_exp2f(t.x); ex.y = __builtin_amdgcn_exp2f(t.y);
                        ex = ex + 1.0f;
                        f32x2 rc; rc.x = __builtin_amdgcn_rcpf(ex.x); rc.y = __builtin_amdgcn_rcpf(ex.y);
                        const f32x2 r = g * rc * up;
                        wv[n * 2 + (ip >> 1)] = cvt_pk(r.x, r.y); }
                u32x4 w; w.x = wv[0]; w.y = wv[1]; w.z = wv[2]; w.w = wv[3];
                *(u32x4*)rowp = w; }
    }
};

struct EpiQkv {
    static constexpr bool PERM = true, AFTER_DRAIN = false, ALIGN = true;
    bf16raw* O; const float* rs; const float* qg; const float* kg; const f32x2* tab; LAS float* ss;
    __device__ __forceinline__ void operator()(const f32x4 (&acc)[2][2][4][2], const pg8::Unit& u, int wr, int wc, int fr, int fq) const {
        const int row0 = u.pm * 256 + wr * 64 + fr, col0 = u.pn * 256 + wc * 32 + 8 * fq;
        if (u.pn == 5) {
#pragma unroll
            for (int ai = 0; ai < 2; ++ai)
#pragma unroll
                for (int m = 0; m < 4; ++m) { bf16raw* rowp = O + (size_t)(row0 + ai * 128 + m * 16) * QKVD + col0; const float sc = rs[row0 + ai * 128 + m * 16];
#pragma unroll
                    for (int bj = 0; bj < 2; ++bj) { const f32x4 v0 = acc[ai][bj][m][0] * sc, v1 = acc[ai][bj][m][1] * sc;
                        u32x4 w; w.x = cvt_pk(v0[0], v0[1]); w.y = cvt_pk(v0[2], v0[3]); w.z = cvt_pk(v1[0], v1[1]); w.w = cvt_pk(v1[2], v1[3]);
                        *(u32x4*)(rowp + bj * 128) = w; } }
            return; }
#pragma unroll
        for (int ai = 0; ai < 2; ++ai)
#pragma unroll
            for (int m = 0; m < 4; ++m) { const float sc = rs[row0 + ai * 128 + m * 16];
#pragma unroll
                for (int bj = 0; bj < 2; ++bj) { const f32x4 v0 = acc[ai][bj][m][0] * sc, v1 = acc[ai][bj][m][1] * sc;
                    float s = (v0[0] * v0[0] + v0[1] * v0[1]) + (v0[2] * v0[2] + v0[3] * v0[3]) + (v1[0] * v1[0] + v1[1] * v1[1]) + (v1[2] * v1[2] + v1[3] * v1[3]);
                    s += __shfl_xor(s, 16); s += __shfl_xor(s, 32);
                    if (fq == 0) ss[(bj * 4 + wc) * 256 + ai * 128 + wr * 64 + m * 16 + fr] = s; } }
        asm volatile("s_waitcnt lgkmcnt(0)" ::: "memory"); __builtin_amdgcn_s_barrier(); asm volatile("" ::: "memory");
        const int axis = wc >> 1, p0 = (wc & 1) * 16 + 4 * fq, d1 = axis * 64 + p0;
        const float* gsrc = (u.pn == 4) ? kg : qg; const float qsc = (u.pn == 4) ? 1.0f : 0.088388347648318440f * 1.4426950408889634f;
        const f32x4 g1 = *(const f32x4*)(gsrc + d1), g2 = *(const f32x4*)(gsrc + d1 + 32);
#pragma unroll
        for (int ai = 0; ai < 2; ++ai)
#pragma unroll
            for (int m = 0; m < 4; ++m) { const int row = row0 + ai * 128 + m * 16, rl = ai * 128 + wr * 64 + m * 16 + fr; const float sc = rs[row];
                const int rr = row < MTOK ? row : 0, b = rr / LTOK, t = rr - b * LTOK;
                f32x4 cc = (f32x4){1.f, 1.f, 1.f, 1.f}, sn = (f32x4){0.f, 0.f, 0.f, 0.f};
                if (t >= NMETA) { const int s = t - NMETA, pos = axis ? (s & 63) : (s >> 6); const f32x4 t0 = *(const f32x4*)(tab + pos * 32 + p0), t1 = *(const f32x4*)(tab + pos * 32 + p0 + 2);
                    cc = (f32x4){t0[0], t0[2], t1[0], t1[2]}; sn = (f32x4){t0[1], t0[3], t1[1], t1[3]}; }
                bf16raw* rowp = O + (size_t)row * QKVD + col0;
#pragma unroll
                for (int bj = 0; bj < 2; ++bj) { const LAS float* sp = ss + bj * 1024 + rl;
                    const float tot = (sp[0] + sp[256]) + (sp[512] + sp[768]);
                    const float rn = (1.0f / sqrtf(tot * (1.0f / 128.0f) + RMS_EPS)) * sc * qsc;
                    const f32x4 n1 = acc[ai][bj][m][0] * rn * g1, n2 = acc[ai][bj][m][1] * rn * g2;
                    const f32x4 o1 = n1 * cc - n2 * sn, o2 = n2 * cc + n1 * sn;
                    u32x4 w; w.x = cvt_pk(o1[0], o1[1]); w.y = cvt_pk(o1[2], o1[3]); w.z = cvt_pk(o2[0], o2[1]); w.w = cvt_pk(o2[2], o2[3]);
                    *(u32x4*)(rowp + bj * 128) = w; } }
    }
};

__device__ __forceinline__ void transpose_item(const float* W, int K, int N, bf16raw* WT, int perm, const float* gk, LAS float* scr, int item, int lane) {
    const int nblk = N / 32, kb = item / nblk, nb = item % nblk, k0 = 64 * kb, n0 = 32 * nb;
    int d0 = n0;
    if (perm == 1) { const int j = n0 < DFF ? n0 : n0 - DFF; d0 = (j >> 7) * 256 + (j & 127) + (n0 < DFF ? 0 : 128); }
#pragma unroll 8
    for (int i = 0; i < 32; ++i) { const int kk = 2 * i + (lane >> 5); const float gsc = gk ? gk[k0 + kk] : 1.0f; scr[kk * 33 + (lane & 31)] = W[(size_t)(k0 + kk) * N + n0 + (lane & 31)] * gsc; }
    asm volatile("s_waitcnt lgkmcnt(0)" ::: "memory");
    const int c = lane & 7;
#pragma unroll
    for (int j = 0; j < 4; ++j) { const int n = (lane >> 3) + 8 * j; const LAS float* s = scr + (8 * c) * 33 + n;
        u32x4 o; o.x = cvt_pk(s[0 * 33], s[1 * 33]); o.y = cvt_pk(s[2 * 33], s[3 * 33]); o.z = cvt_pk(s[4 * 33], s[5 * 33]); o.w = cvt_pk(s[6 * 33], s[7 * 33]);
        int dr = d0 + n;
        if (perm == 2) { const int ns = n0 + n; if (ns < 1280) { const int hd = ns >> 7, d = ns & 127, ax = d >> 6, hf = (d >> 5) & 1, p = d & 31;
                dr = hd * 128 + 32 * (ax * 2 + (p >> 4)) + 8 * ((p >> 2) & 3) + 4 * hf + (p & 3); } }
        *(u32x4*)(WT + (size_t)dr * K + k0 + 8 * c) = o; }
    asm volatile("s_waitcnt lgkmcnt(0)" ::: "memory");
}
__device__ __forceinline__ void convert_group(const float* W, int K, int N, int nmat, bf16raw* WT, int perm, const float* gbase, int gstride, LAS float* scr, int gw, int NGW, int lane) {
    const int per = (K / 64) * (N / 32), total = per * nmat;
    for (int it = gw; it < total; it += NGW) { const int mt = it / per, r = it % per;
        transpose_item(W + (size_t)mt * K * N, K, N, WT + (size_t)mt * K * N, perm, gbase ? gbase + (size_t)mt * gstride : nullptr, scr, r, lane); }
}

struct Row16 { f32x4 v[4]; };
__device__ __forceinline__ void ld_row_f32(Row16& r, const float* p, int lane) {
    const f32x4* q = (const f32x4*)(p + 8 * lane); r.v[0] = q[0]; r.v[1] = q[1]; r.v[2] = q[128]; r.v[3] = q[129];
}
__device__ __forceinline__ void st_row_f32(const Row16& r, float* p, int lane) {
    f32x4* q = (f32x4*)(p + 8 * lane); q[0] = r.v[0]; q[1] = r.v[1]; q[128] = r.v[2]; q[129] = r.v[3];
}
__device__ __forceinline__ void ld_row_bf16(Row16& r, const bf16raw* p, int lane) {
    const u32x4 a = *(const u32x4*)(p + 8 * lane), b = *(const u32x4*)(p + 512 + 8 * lane);
    r.v[0] = (f32x4){bf_lo(a.x), bf_hi(a.x), bf_lo(a.y), bf_hi(a.y)}; r.v[1] = (f32x4){bf_lo(a.z), bf_hi(a.z), bf_lo(a.w), bf_hi(a.w)};
    r.v[2] = (f32x4){bf_lo(b.x), bf_hi(b.x), bf_lo(b.y), bf_hi(b.y)}; r.v[3] = (f32x4){bf_lo(b.z), bf_hi(b.z), bf_lo(b.w), bf_hi(b.w)};
}
__device__ __forceinline__ void st_row_bf16(const Row16& r, bf16raw* p, int lane) {
    u32x4 a, b; a.x = cvt_pk(r.v[0][0], r.v[0][1]); a.y = cvt_pk(r.v[0][2], r.v[0][3]); a.z = cvt_pk(r.v[1][0], r.v[1][1]); a.w = cvt_pk(r.v[1][2], r.v[1][3]);
    b.x = cvt_pk(r.v[2][0], r.v[2][1]); b.y = cvt_pk(r.v[2][2], r.v[2][3]); b.z = cvt_pk(r.v[3][0], r.v[3][1]); b.w = cvt_pk(r.v[3][2], r.v[3][3]);
    *(u32x4*)(p + 8 * lane) = a; *(u32x4*)(p + 512 + 8 * lane) = b;
}
__device__ __forceinline__ float row_rstd(const Row16& r) {
    float s = 0.f;
#pragma unroll
    for (int j = 0; j < 4; ++j) s += (r.v[j][0] * r.v[j][0] + r.v[j][1] * r.v[j][1]) + (r.v[j][2] * r.v[j][2] + r.v[j][3] * r.v[j][3]);
    return 1.0f / sqrtf(wave_sum(s) * (1.0f / DM) + RMS_EPS);
}
struct RawPair { u32x4 r[8]; };
__device__ __forceinline__ void rp_load(RawPair& p, const bf16raw* MB, const bf16raw* U, int m0, int NGW, int lane) {
    const int m1 = m0 + NGW, m1c = m1 < MREG ? m1 : m0;
    p.r[0] = *(const u32x4*)(MB + (size_t)m0 * DM + 8 * lane); p.r[1] = *(const u32x4*)(MB + (size_t)m0 * DM + 512 + 8 * lane);
    p.r[2] = *(const u32x4*)(U + (size_t)m0 * DM + 8 * lane);  p.r[3] = *(const u32x4*)(U + (size_t)m0 * DM + 512 + 8 * lane);
    p.r[4] = *(const u32x4*)(MB + (size_t)m1c * DM + 8 * lane); p.r[5] = *(const u32x4*)(MB + (size_t)m1c * DM + 512 + 8 * lane);
    p.r[6] = *(const u32x4*)(U + (size_t)m1c * DM + 8 * lane);  p.r[7] = *(const u32x4*)(U + (size_t)m1c * DM + 512 + 8 * lane);
}
__device__ __forceinline__ void rp_unpack(Row16& r, const u32x4 a, const u32x4 b) {
    r.v[0] = (f32x4){bf_lo(a.x), bf_hi(a.x), bf_lo(a.y), bf_hi(a.y)}; r.v[1] = (f32x4){bf_lo(a.z), bf_hi(a.z), bf_lo(a.w), bf_hi(a.w)};
    r.v[2] = (f32x4){bf_lo(b.x), bf_hi(b.x), bf_lo(b.y), bf_hi(b.y)}; r.v[3] = (f32x4){bf_lo(b.z), bf_hi(b.z), bf_lo(b.w), bf_hi(b.w)};
}
__device__ __forceinline__ void rp_process(const RawPair& p, int mode, int m0, int NGW, bf16raw* U, float* RS, const Row16& gp, float* out, int lane) {
    const int m1 = m0 + NGW; const bool has1 = m1 < MREG;
    Row16 mv0, h0, mv1, h1;
    rp_unpack(mv0, p.r[0], p.r[1]); rp_unpack(h0, p.r[2], p.r[3]); rp_unpack(mv1, p.r[4], p.r[5]); rp_unpack(h1, p.r[6], p.r[7]);
    const float ra = row_rstd(mv0), rb = row_rstd(mv1);
#pragma unroll
    for (int j = 0; j < 4; ++j) { h0.v[j] = h0.v[j] + mv0.v[j] * ra * gp.v[j]; h1.v[j] = h1.v[j] + mv1.v[j] * rb * gp.v[j]; }
    if (mode == 2) {
        { const int b = m0 / LTOK, t = m0 - b * LTOK; if (t >= NMETA) st_row_f32(h0, out + ((size_t)b * SEQ + (t - NMETA)) * DM, lane); }
        if (has1) { const int b = m1 / LTOK, t = m1 - b * LTOK; if (t >= NMETA) st_row_f32(h1, out + ((size_t)b * SEQ + (t - NMETA)) * DM, lane); }
        return; }
    st_row_bf16(h0, U + (size_t)m0 * DM, lane);
    if (has1) st_row_bf16(h1, U + (size_t)m1 * DM, lane);
    const float r0 = row_rstd(h0), r1 = row_rstd(h1);
    if (lane == 0) { RS[m0] = r0; if (has1) RS[m1] = r1; }
}
__device__ __forceinline__ void resid_pass(int mode, const float* x, const float* meta, const bf16raw* MB, bf16raw* U, float* RS, bf16raw* OB, const float* g_post, float* out,
                                           int gw, int NGW, int lane, const float* tailp = nullptr) {
    Row16 gp;
    if (mode != 0) ld_row_f32(gp, g_post, lane);
    if (mode == 0) {
        for (int m0 = gw; m0 < MPAD; m0 += 2 * NGW) {
            const int m1 = m0 + NGW; const bool has1 = m1 < MPAD; const int m1c = has1 ? m1 : m0;
            const bool pad0 = m0 >= MTOK, pad1 = m1c >= MTOK;
            const int mm0 = pad0 ? 0 : m0, mm1 = pad1 ? 0 : m1c;
            const int b0 = mm0 / LTOK, t0 = mm0 - b0 * LTOK, b1 = mm1 / LTOK, t1 = mm1 - b1 * LTOK;
            Row16 h0, h1;
            ld_row_f32(h0, (t0 < NMETA) ? meta + (size_t)t0 * DM : x + ((size_t)b0 * SEQ + (t0 - NMETA)) * DM, lane);
            ld_row_f32(h1, (t1 < NMETA) ? meta + (size_t)t1 * DM : x + ((size_t)b1 * SEQ + (t1 - NMETA)) * DM, lane);
#pragma unroll
            for (int k = 0; k < 2; ++k) { const int m = k ? m1 : m0; const bool pad = k ? pad1 : pad0; if (k && !has1) break;
                const Row16& h = k ? h1 : h0;
                if (pad) {
                    const u32x4 z = (u32x4){0u, 0u, 0u, 0u};
                    *(u32x4*)(U + (size_t)m * DM + 8 * lane) = z; *(u32x4*)(U + (size_t)m * DM + 512 + 8 * lane) = z;
                    *(u32x4*)(OB + (size_t)m * DM + 8 * lane) = z; *(u32x4*)(OB + (size_t)m * DM + 512 + 8 * lane) = z;
                    if (lane == 0) RS[m] = 0.f;
                } else {
                    st_row_bf16(h, U + (size_t)m * DM, lane);
                    const float rs2 = row_rstd(h);
                    if (lane == 0) RS[m] = rs2; } }
        }
        return;
    }
    if (gw < MTOK - MREG) { const int m = MREG + gw; Row16 mv, t1, h;
        ld_row_f32(mv, tailp + (size_t)gw * DM, lane);
#pragma unroll
        for (int p = 1; p < TAIL_S; ++p) { ld_row_f32(t1, tailp + ((size_t)p * 128 + gw) * DM, lane);
#pragma unroll
            for (int j = 0; j < 4; ++j) mv.v[j] = mv.v[j] + t1.v[j]; }
        ld_row_bf16(h, U + (size_t)m * DM, lane);
        const float ra = row_rstd(mv);
#pragma unroll
        for (int j = 0; j < 4; ++j) h.v[j] = h.v[j] + mv.v[j] * ra * gp.v[j];
        if (mode == 2) { const int b = m / LTOK, t = m - b * LTOK; if (t >= NMETA) st_row_f32(h, out + ((size_t)b * SEQ + (t - NMETA)) * DM, lane); }
        else { st_row_bf16(h, U + (size_t)m * DM, lane); const float r2 = row_rstd(h); if (lane == 0) RS[m] = r2; }
    }
    RawPair A, B; const int S = 2 * NGW; int m0 = gw;
    if (m0 < MREG) rp_load(A, MB, U, m0, NGW, lane);
    while (m0 < MREG) {
        if (m0 + S < MREG) rp_load(B, MB, U, m0 + S, NGW, lane);
        rp_process(A, mode, m0, NGW, U, RS, gp, out, lane);
        m0 += S; if (m0 >= MREG) break;
        if (m0 + S < MREG) rp_load(A, MB, U, m0 + S, NGW, lane);
        rp_process(B, mode, m0, NGW, U, RS, gp, out, lane);
        m0 += S;
    }
}

__device__ __forceinline__ void rope_pass(bf16raw* QKV, const float* qg, const float* kg, const f32x2* tab, int gw, int NGW, int lane) {
    const int hsel = lane >> 5, within = lane & 31, axis = within >> 4, s16 = within & 15, d1 = axis * 64 + 2 * s16, d2 = d1 + 32;
    const f32x2 gq1 = *(const f32x2*)(qg + d1), gq2 = *(const f32x2*)(qg + d2), gk1 = *(const f32x2*)(kg + d1), gk2 = *(const f32x2*)(kg + d2);
    for (int m = gw; m < MTOK; m += NGW) {
        const int b = m / LTOK, t = m - b * LTOK;
        f32x2 cs0 = (f32x2){1.f, 0.f}, cs1 = (f32x2){1.f, 0.f};
        if (t >= NMETA) { const int s = t - NMETA, pos = axis ? (s & 63) : (s >> 6); cs0 = tab[pos * 32 + 2 * s16]; cs1 = tab[pos * 32 + 2 * s16 + 1]; }
        bf16raw* rowp = QKV + (size_t)m * QKVD;
        unsigned w1[5], w2[5];
#pragma unroll
        for (int st = 0; st < 5; ++st) { const int hd = 2 * st + hsel; w1[st] = *(const unsigned*)(rowp + hd * 128 + d1); w2[st] = *(const unsigned*)(rowp + hd * 128 + d2); }
#pragma unroll
        for (int st = 0; st < 5; ++st) { const int hd = 2 * st + hsel;
            const float x1a = bf_lo(w1[st]), x1b = bf_hi(w1[st]), x2a = bf_lo(w2[st]), x2b = bf_hi(w2[st]);
            float ss = (x1a * x1a + x1b * x1b) + (x2a * x2a + x2b * x2b);
            ss += __shfl_xor(ss, 1); ss += __shfl_xor(ss, 2); ss += __shfl_xor(ss, 4); ss += __shfl_xor(ss, 8); ss += __shfl_xor(ss, 16);
            const float rs = 1.0f / sqrtf(ss * (1.0f / 128.0f) + RMS_EPS);
            const bool isq = (st < 4);
            const f32x2 g1 = isq ? gq1 : gk1, g2 = isq ? gq2 : gk2;
            const float n1a = x1a * rs * g1.x, n1b = x1b * rs * g1.y, n2a = x2a * rs * g2.x, n2b = x2b * rs * g2.y;
            const float o1a = n1a * cs0.x - n2a * cs0.y, o2a = n2a * cs0.x + n1a * cs0.y;
            const float o1b = n1b * cs1.x - n2b * cs1.y, o2b = n2b * cs1.x + n1b * cs1.y;
            *(unsigned*)(rowp + hd * 128 + d1) = cvt_pk(o1a, o1b); *(unsigned*)(rowp + hd * 128 + d2) = cvt_pk(o2a, o2b); }
    }
}

constexpr int L_XCF = 0, L_XCB = 24576, L_CC = 37632, L_AB = 40960, AB_RS = 132, AB_PL = LT * AB_RS;
static_assert(L_AB + 2 * AB_PL * 4 <= LDS_MISC && L_CC + 5 * 128 * 4 <= L_AB, "LRU LDS");
struct LruW { bf16x8 f[2][2][4]; };
struct LruC { float br[2], bi[2], k8[2]; };
__device__ __forceinline__ void lru_load_w(LruW& w, LruC& cc, const bf16raw* Wg, const float* gate_b, const float* lam, int slot, int n, int wid, int lane) {
    const int dir = wid >> 2, cq = wid & 3, fr = lane & 15, fq = lane >> 4;
#pragma unroll
    for (int g = 0; g < 2; ++g)
#pragma unroll
        for (int nt = 0; nt < 2; ++nt)
#pragma unroll
            for (int ks = 0; ks < 4; ++ks)
                w.f[g][nt][ks] = *(const bf16x8*)(Wg + ((size_t)((((slot * 2 + dir) * 2 + g) * 8 + n) * 128 + cq * 32 + nt * 16 + fr)) * 128 + ks * 32 + fq * 8);
#pragma unroll
    for (int nt = 0; nt < 2; ++nt) { const int gch = n * 128 + cq * 32 + nt * 16 + fr;
        cc.br[nt] = gate_b[((size_t)(slot * 2 + dir) * 2 + 0) * DM + gch]; cc.bi[nt] = gate_b[((size_t)(slot * 2 + dir) * 2 + 1) * DM + gch];
        const float lm = lam[(size_t)(slot * 2 + dir) * DM + gch];
        const float sp = (lm > 15.f) ? __expf(-lm) : log1pf(__expf(-lm));
        cc.k8[nt] = -8.0f * sp * 1.4426950408889634f; }
}
struct LruX { u32x4 r[5]; };
__device__ __forceinline__ void lru_fetch_x(LruX& xr, const bf16raw* X, int b, int c, int n, int tid) {
    const int cgp = tid & 15, pr = tid >> 4;
    if (pr < 24) {
#pragma unroll
        for (int k = 0; k < 5; ++k) { const int tt = c * LT + 2 * pr - 2 + k;
            xr.r[k] = (tt >= 0 && tt < LTOK) ? *(const u32x4*)(X + ((size_t)b * LTOK + tt) * DM + n * 128 + cgp * 8) : (u32x4){0u, 0u, 0u, 0u}; } }
}
template <bool FINAL, bool REV>
__device__ __forceinline__ void lru_scan(const f32x4 (&acc)[3][2][2], LAS float* HF, f32x2* SUMS, size_t sbase, float hin0, float hin1, int cq, int fr, int fq, int lane) {
    const int rank = REV ? 3 - fq : fq;
    const int src1 = (REV ? lane + 16 : lane - 16) & 63, src2 = (REV ? lane + 32 : lane - 32) & 63, srcT = REV ? fr : fr + 48;
#pragma unroll
    for (int nt = 0; nt < 2; ++nt) {
        float Pe[3], Qe[3], Pt[3], Qt[3];
#pragma unroll
        for (int mt = 0; mt < 3; ++mt) { float p = 1.f, q = 0.f;
#pragma unroll
            for (int ii = 0; ii < 4; ++ii) { const int i = REV ? 3 - ii : ii; const float a = acc[mt][0][nt][i]; q = a * q + acc[mt][1][nt][i]; p *= a; }
            { const float pp = __shfl(p, src1), qp = __shfl(q, src1); if (rank >= 1) { q = qp * p + q; p = pp * p; } }
            { const float pp = __shfl(p, src2), qp = __shfl(q, src2); if (rank >= 2) { q = qp * p + q; p = pp * p; } }
            Pt[mt] = __shfl(p, srcT); Qt[mt] = __shfl(q, srcT);
            if (FINAL) { const float pe = __shfl(p, src1), qe = __shfl(q, src1); Pe[mt] = rank >= 1 ? pe : 1.f; Qe[mt] = rank >= 1 ? qe : 0.f; } }
        if (!FINAL) { float A = 1.f, Bv = 0.f;
#pragma unroll
            for (int mm = 0; mm < 3; ++mm) { const int mt = REV ? 2 - mm : mm; Bv = Bv * Pt[mt] + Qt[mt]; A *= Pt[mt]; }
            if (fq == 0) SUMS[sbase + 16 * nt] = (f32x2){A, Bv};
        } else { float hseg = nt ? hin1 : hin0; const int ch = cq * 32 + nt * 16 + fr;
#pragma unroll
            for (int mm = 0; mm < 3; ++mm) { const int mt = REV ? 2 - mm : mm;
                float h = Pe[mt] * hseg + Qe[mt];
#pragma unroll
                for (int ii = 0; ii < 4; ++ii) { const int i = REV ? 3 - ii : ii; h = acc[mt][0][nt][i] * h + acc[mt][1][nt][i];
                    HF[(REV ? AB_PL : 0) + (mt * 16 + fq * 4 + i) * AB_RS + ch] = h; }
                hseg = Pt[mt] * hseg + Qt[mt]; } }
    }
}
#define LDS_BAR() do { asm volatile("s_waitcnt lgkmcnt(0)" ::: "memory"); __builtin_amdgcn_s_barrier(); asm volatile("" ::: "memory"); } while (0)
template <bool FINAL>
__device__ __forceinline__ void lru_pass(LAS unsigned char* lds, int slot, const bf16raw* Wg, const bf16raw* X, bf16raw* Y, const float* conv_w, const float* conv_b,
                                         const float* gate_b, const float* lam, f32x2* SUMS, const float* CARRY, int G, int bid, int tid0, int wid, int lane0) {
    constexpr int NTILES = 8 * NB * NCHUNK, PERN = NB * NCHUNK;
    const int lo = (int)(((long)bid * NTILES) / G), hi = (int)(((long)(bid + 1) * NTILES) / G);
    LAS float* XCF = (LAS float*)(lds + L_XCF); LAS unsigned char* XCB = lds + L_XCB; LAS float* CC = (LAS float*)(lds + L_CC); LAS float* HF = (LAS float*)(lds + L_AB);
    const int dir = wid >> 2, cq = wid & 3;
    LruW w; LruC cc; LruX xr; int curn = -1;
    if (lo < hi) { const int n = lo / PERN, rem = lo - n * PERN, b = rem / NCHUNK, c = rem - b * NCHUNK; lru_fetch_x(xr, X, b, c, n, tid0); }
    for (int tau = lo; tau < hi; ++tau) { const int n = tau / PERN, rem = tau - n * PERN, b = rem / NCHUNK, c = rem - b * NCHUNK;
        const size_t row0 = (size_t)b * LTOK + c * LT;
        int tid = tid0; asm volatile("" : "+v"(tid));
        const int lane = tid & 63, fr = lane & 15, fq = lane >> 4, cgp = tid & 15, pr = tid >> 4;
        if (n != curn) { lru_load_w(w, cc, Wg, gate_b, lam, slot, n, wid, lane); curn = n;
            for (int i = tid; i < 5 * 128; i += NTHREADS) CC[i] = (i < 512) ? conv_w[(size_t)slot * 4 * DM + (i >> 7) * DM + n * 128 + (i & 127)] : conv_b[(size_t)slot * DM + n * 128 + (i & 127)];
            __syncthreads(); }
        const size_t sbase = ((size_t)(b * NCHUNK + c) * 2 + dir) * DM + n * 128 + cq * 32 + fr;
        float hin0 = 0.f, hin1 = 0.f;
        if (FINAL) { hin0 = CARRY[sbase]; hin1 = CARRY[sbase + 16]; }
        if (pr < 24) {
            f32x4 xa[5], xb[5];
#pragma unroll
            for (int k = 0; k < 5; ++k) { const u32x4 v = xr.r[k]; xa[k] = (f32x4){bf_lo(v.x), bf_hi(v.x), bf_lo(v.y), bf_hi(v.y)}; xb[k] = (f32x4){bf_lo(v.z), bf_hi(v.z), bf_lo(v.w), bf_hi(v.w)}; }
#pragma unroll
            for (int j = 0; j < 2; ++j) { f32x4 a0 = *(const LAS f32x4*)(CC + 512 + cgp * 8), a1 = *(const LAS f32x4*)(CC + 512 + cgp * 8 + 4);
#pragma unroll
                for (int k = 0; k < 4; ++k) { a0 += *(const LAS f32x4*)(CC + k * 128 + cgp * 8) * xa[j + k]; a1 += *(const LAS f32x4*)(CC + k * 128 + cgp * 8 + 4) * xb[j + k]; }
                const int t = 2 * pr + j;
                *(LAS f32x4*)(XCF + t * 128 + cgp * 8) = a0; *(LAS f32x4*)(XCF + t * 128 + cgp * 8 + 4) = a1;
                u32x4 pk; pk.x = cvt_pk(a0[0], a0[1]); pk.y = cvt_pk(a0[2], a0[3]); pk.z = cvt_pk(a1[0], a1[1]); pk.w = cvt_pk(a1[2], a1[3]);
                *(LAS u32x4*)(XCB + t * 272 + cgp * 16) = pk; }
        }
        if (tau + 1 < hi) { const int t2 = tau + 1, n2 = t2 / PERN, rem2 = t2 - n2 * PERN, b2 = rem2 / NCHUNK, c2 = rem2 - b2 * NCHUNK; lru_fetch_x(xr, X, b2, c2, n2, tid); }
        LDS_BAR();
        f32x4 acc[3][2][2];
#pragma unroll
        for (int mt = 0; mt < 3; ++mt)
#pragma unroll
            for (int g = 0; g < 2; ++g)
#pragma unroll
                for (int nt = 0; nt < 2; ++nt) acc[mt][g][nt] = (f32x4){0.f, 0.f, 0.f, 0.f};
#pragma unroll
        for (int ks = 0; ks < 4; ++ks) {
#pragma unroll
            for (int mt = 0; mt < 3; ++mt) { const bf16x8 af = *(const LAS bf16x8*)(XCB + (mt * 16 + fr) * 272 + (ks * 32 + fq * 8) * 2);
#pragma unroll
                for (int g = 0; g < 2; ++g)
#pragma unroll
                    for (int nt = 0; nt < 2; ++nt) acc[mt][g][nt] = __builtin_amdgcn_mfma_f32_16x16x32_bf16(af, w.f[g][nt][ks], acc[mt][g][nt], 0, 0, 0); } }
#pragma unroll
        for (int nt = 0; nt < 2; ++nt) { const int ch = cq * 32 + nt * 16 + fr;
            const float nbr = -1.4426950408889634f * cc.br[nt], nbi = -1.4426950408889634f * cc.bi[nt], k8 = cc.k8[nt];
#pragma unroll
            for (int mt = 0; mt < 3; ++mt)
#pragma unroll
                for (int ip = 0; ip < 4; ip += 2) { const int tk = mt * 16 + fq * 4 + ip;
                    const f32x2 xr2 = (f32x2){acc[mt][0][nt][ip], acc[mt][0][nt][ip + 1]}, xi2 = (f32x2){acc[mt][1][nt][ip], acc[mt][1][nt][ip + 1]};
                    const f32x2 tr = xr2 * (-1.4426950408889634f) + nbr, ti = xi2 * (-1.4426950408889634f) + nbi;
                    f32x2 er, ei; er.x = __builtin_amdgcn_exp2f(tr.x); er.y = __builtin_amdgcn_exp2f(tr.y); ei.x = __builtin_amdgcn_exp2f(ti.x); ei.y = __builtin_amdgcn_exp2f(ti.y);
                    er = er + 1.0f; ei = ei + 1.0f;
                    f32x2 r, ig; r.x = __builtin_amdgcn_rcpf(er.x); r.y = __builtin_amdgcn_rcpf(er.y); ig.x = __builtin_amdgcn_rcpf(ei.x); ig.y = __builtin_amdgcn_rcpf(ei.y);
                    const f32x2 la = r * k8;
                    f32x2 a; a.x = __builtin_amdgcn_exp2f(la.x); a.y = __builtin_amdgcn_exp2f(la.y);
                    const f32x2 y = 1.0f - a * a;
                    f32x2 sq; sq.x = __builtin_amdgcn_sqrtf(y.x); sq.y = __builtin_amdgcn_sqrtf(y.y);
                    const f32x2 xc2 = (f32x2){XCF[tk * 128 + ch], XCF[(tk + 1) * 128 + ch]};
                    const f32x2 bb = sq * ig * xc2;
                    acc[mt][0][nt][ip] = a.x; acc[mt][0][nt][ip + 1] = a.y; acc[mt][1][nt][ip] = bb.x; acc[mt][1][nt][ip + 1] = bb.y; } }
        if (dir) lru_scan<FINAL, true>(acc, HF, SUMS, sbase, hin0, hin1, cq, fr, fq, lane);
        else     lru_scan<FINAL, false>(acc, HF, SUMS, sbase, hin0, hin1, cq, fr, fq, lane);
        if (FINAL) {
            const u32x4 yv0 = (pr < 24) ? *(const u32x4*)(Y + (row0 + 2 * pr) * DM + n * 128 + cgp * 8) : (u32x4){0u, 0u, 0u, 0u};
            const u32x4 yv1 = (pr < 24) ? *(const u32x4*)(Y + (row0 + 2 * pr + 1) * DM + n * 128 + cgp * 8) : (u32x4){0u, 0u, 0u, 0u};
            LDS_BAR();
            if (pr < 24) {
#pragma unroll
                for (int j = 0; j < 2; ++j) { const int t = 2 * pr + j; const u32x4 yv = j ? yv1 : yv0;
                    const LAS float* hf = HF + t * AB_RS + cgp * 8; const LAS float* hb = HF + AB_PL + t * AB_RS + cgp * 8;
                    const f32x4 f0 = *(const LAS f32x4*)hf, f1 = *(const LAS f32x4*)(hf + 4), b0 = *(const LAS f32x4*)hb, b1 = *(const LAS f32x4*)(hb + 4);
                    const f32x4 z0 = (f0 + b0) * (f32x4){bf_lo(yv.x), bf_hi(yv.x), bf_lo(yv.y), bf_hi(yv.y)}, z1 = (f1 + b1) * (f32x4){bf_lo(yv.z), bf_hi(yv.z), bf_lo(yv.w), bf_hi(yv.w)};
                    u32x4 o; o.x = cvt_pk(z0[0], z0[1]); o.y = cvt_pk(z0[2], z0[3]); o.z = cvt_pk(z1[0], z1[1]); o.w = cvt_pk(z1[2], z1[3]);
                    *(u32x4*)(Y + (row0 + t) * DM + n * 128 + cgp * 8) = o; } }
        }
        LDS_BAR();
    }
}
__device__ __forceinline__ void lru_carry(LAS unsigned char* lds, const f32x2* SUMS, float* CARRY, int G, int bid, int wid, int lane) {
    LAS f32x2* XS = (LAS f32x2*)lds;
    for (int cb = bid; cb < NB * 2 * (DM / 64); cb += G) { const int bd = cb >> 4, b = bd >> 1, sd = bd & 1, gch = (cb & 15) * 64 + lane;
        const int q0 = wid * 21 + (wid < 3 ? wid : 3), qn = 21 + (wid < 3 ? 1 : 0);
        f32x2 ab[22]; float P = 1.f, Q = 0.f;
#pragma unroll
        for (int i = 0; i < 22; ++i) { const int q = q0 + i, c = sd ? (NCHUNK - 1 - q) : q;
            ab[i] = (i < qn) ? SUMS[((size_t)(b * NCHUNK + c) * 2 + sd) * DM + gch] : (f32x2){1.f, 0.f}; }
#pragma unroll
        for (int i = 0; i < 22; ++i) { Q = ab[i].x * Q + ab[i].y; P *= ab[i].x; }
        XS[wid * 64 + lane] = (f32x2){P, Q};
        __syncthreads();
        float h = 0.f;
        for (int s2 = 0; s2 < wid; ++s2) { const f32x2 t = XS[s2 * 64 + lane]; h = t.x * h + t.y; }
#pragma unroll
        for (int i = 0; i < 22; ++i) { const int q = q0 + i, c = sd ? (NCHUNK - 1 - q) : q;
            if (i < qn) CARRY[((size_t)(b * NCHUNK + c) * 2 + sd) * DM + gch] = h;
            h = ab[i].x * h + ab[i].y; }
        __syncthreads();
    }
}

typedef unsigned v4u __attribute__((ext_vector_type(4)));
#define XB_TMO      128
#define XB_XCNT(j)  (256  + 64 * (j))
#define XB_XSUB(j)  (1280 + 64 * (j))
#define XB_XGEN(j)  (2304 + 64 * (j))
#define XB_TOP      3328
#define XB_TOPGEN   3392
#define XCD_BAR_WORDS 3456
#define XB_SPIN_CAP (1u << 18)

__device__ __forceinline__ unsigned xb_ld(unsigned* p)              { return __hip_atomic_load(p, __ATOMIC_RELAXED, __HIP_MEMORY_SCOPE_AGENT); }
__device__ __forceinline__ unsigned xb_add(unsigned* p, unsigned v) { return __hip_atomic_fetch_add(p, v, __ATOMIC_RELAXED, __HIP_MEMORY_SCOPE_AGENT); }
__device__ __forceinline__ unsigned xb_xcc_id() { return (unsigned)__builtin_amdgcn_s_getreg((3 << 11) | 20) & 0xFu; }
#define XB_SPIN(cond, bar) do { unsigned _sp = 0; while (cond) { __builtin_amdgcn_s_sleep(1); \
    if ((++_sp & 255u) == 0u) { if (xb_ld(&(bar)[XB_TMO])) break; if (_sp > XB_SPIN_CAP) { atomicAdd(&(bar)[XB_TMO], 1u); break; } } } } while (0)

struct XcdBarrier {
    unsigned* bar; unsigned x;
    volatile LAS unsigned* st;
};

__device__ __forceinline__ XcdBarrier xcd_barrier_post(unsigned* bar, volatile LAS unsigned* st) {
    XcdBarrier b; b.bar = bar; b.x = xb_xcc_id(); b.st = st;
    if (threadIdx.x == 0) (void)xb_add(&bar[XB_XCNT(b.x)], 1u);
    return b;
}
__device__ __forceinline__ void xcd_barrier_complete(unsigned* bar, unsigned x, unsigned& nloc, unsigned& nx) {
    const unsigned G = gridDim.x * gridDim.y * gridDim.z;
    unsigned sum, cnt, mine, sp = 0u;
    for (;;) {
        sum = 0u; cnt = 0u; mine = 0u;
#pragma unroll
        for (unsigned j = 0; j < 16; ++j) { const unsigned c = xb_ld(&bar[XB_XCNT(j)]); sum += c; cnt += (c > 0u) ? 1u : 0u; mine = (j == x) ? c : mine; }
        if (sum == G) break;
        __builtin_amdgcn_s_sleep(1);
        if ((++sp & 255u) == 0u) { if (xb_ld(&bar[XB_TMO])) break; if (sp > XB_SPIN_CAP) { atomicAdd(&bar[XB_TMO], 1u); break; } }
    }
    nloc = mine > 0u ? mine : 1u; nx = cnt > 0u ? cnt : 1u;
}

__device__ __forceinline__ void xcd_barrier(const XcdBarrier& b) {
    asm volatile("s_waitcnt vmcnt(0)" ::: "memory");
    __syncthreads();
    if (threadIdx.x == 0) {
        unsigned* bar = b.bar;
        __builtin_amdgcn_s_waitcnt(0);
        unsigned nloc = b.st[0], nx = b.st[1];
        if (nloc == 0u) { xcd_barrier_complete(bar, b.x, nloc, nx); b.st[0] = nloc; b.st[1] = nx; }
        const unsigned old = xb_add(&bar[XB_XSUB(b.x)], 1u);
        const unsigned gen = old / nloc;
        if (old + 1u == (gen + 1u) * nloc) {
            __builtin_amdgcn_fence(__ATOMIC_RELEASE, "agent");
            asm volatile("s_waitcnt vmcnt(0)" ::: "memory");
            const unsigned og = xb_add(&bar[XB_TOP], 1u);
            const unsigned tg = og / nx;
            if (og + 1u == (tg + 1u) * nx) xb_add(&bar[XB_TOPGEN], 1u);
            else XB_SPIN(xb_ld(&bar[XB_TOPGEN]) == tg, bar);
            __builtin_amdgcn_fence(__ATOMIC_ACQUIRE, "agent");
            xb_add(&bar[XB_XGEN(b.x)], 1u);
            asm volatile("s_waitcnt vmcnt(0)" ::: "memory");
        } else {
            XB_SPIN(xb_ld(&bar[XB_XGEN(b.x)]) == gen, bar);
            __builtin_amdgcn_fence(__ATOMIC_ACQUIRE, "agent");
            asm volatile("s_waitcnt vmcnt(0)" ::: "memory");
        }
    }
    __syncthreads();
}

#define LAUNDER(p) asm volatile("" : "+s"(p))
struct Args { const float* in[16]; float* out; unsigned char* ws; };
#ifdef NO_GEMM
#define GEMM_RUN(EPI, Aptr, Bptr, Nn, Kk, Eobj) do { } while (0)
#define GEMM_RUN_T(EPI, Aptr, Bptr, Nn, Kk, Eobj, TAIL) do { } while (0)
#define GEMM_RUN_S(EPI, Aptr, Bptr, Nn, Kk, Eobj, TAIL, SPL) do { } while (0)
#else
#define GEMM_RUN(EPI, Aptr, Bptr, Nn, Kk, Eobj) GEMM_RUN_S(EPI, Aptr, Bptr, Nn, Kk, Eobj, true, 1)
#define GEMM_RUN_T(EPI, Aptr, Bptr, Nn, Kk, Eobj, TAIL) GEMM_RUN_S(EPI, Aptr, Bptr, Nn, Kk, Eobj, TAIL, 1)
#define GEMM_RUN_S(EPI, Aptr, Bptr, Nn, Kk, Eobj, TAIL, SPL) do { pg8::Gemm g_{(const pg8::bf16_t*)(Aptr), (const pg8::bf16_t*)(Bptr), MPAD, (Nn), (Kk)}; int bid_ = blockIdx.x; asm volatile("" : "+s"(bid_)); int G_ = gridDim.x; asm volatile("" : "+s"(G_)); pg8::StaticOrder S_; S_.init(MPAD, (Nn), (Kk), G_, bid_, (TAIL), (SPL)); \
    pg8::gemm_phase<EPI, pg8::StaticOrder, EPI::ALIGN, true>((PG8_LAS unsigned char*)lds, g_, S_, (Eobj)); } while (0)
#endif

__global__ void __launch_bounds__(NTHREADS, 2) mega_fwd(Args args) {
    extern __shared__ __attribute__((aligned(16))) unsigned char lds[];
    cg::grid_group grid = cg::this_grid();
#define FRESH() int tid = threadIdx.x; asm volatile("" : "+v"(tid)); int bid = blockIdx.x; asm volatile("" : "+s"(bid)); int G = gridDim.x; asm volatile("" : "+s"(G)); const int NGW = G * 8; \
    const int lane = tid & 63, wid = __builtin_amdgcn_readfirstlane(tid >> 6), gw = bid * 8 + wid; (void)lane; (void)gw; (void)NGW
    unsigned char* ws = args.ws;
    const float* x = args.in[0]; const float* meta = args.in[1]; const float* gains = args.in[2];
    bf16raw* OB0 = (bf16raw*)(ws + WS_H); float* RS0 = (float*)(ws + WS_H + (size_t)MPAD * DM * 2); bf16raw* U0 = (bf16raw*)(ws + WS_U);
    bf16raw* BIG0 = (bf16raw*)(ws + WS_BIG); bf16raw* MB0 = (bf16raw*)(ws + WS_MB);
    bf16raw* Wb0 = (bf16raw*)(ws + WS_W); f32x2* SUMS = (f32x2*)(ws + WS_SUM); float* CARRY = (float*)(ws + WS_CARRY); f32x2* ROPE = (f32x2*)(ws + WS_ROPE);

    {
        FRESH();
        LAS float* scr = (LAS float*)((LAS unsigned char*)lds + wid * 16384);
        bf16raw* OB = OB0; float* RS = RS0; bf16raw* U = U0; bf16raw* Wb = Wb0;
        convert_group(args.in[3], 1024, 2048, 2, Wb + WO_LRU_IN, 0, gains, 8 * DM, scr, gw, NGW, lane);
        convert_group(args.in[9], 1024, 1024, 2, Wb + WO_LRU_OUT, 0, nullptr, 0, scr, gw, NGW, lane);
        convert_group(args.in[6], 128, 128, 64, Wb + WO_GATE, 0, nullptr, 0, scr, gw, NGW, lane);
        convert_group(args.in[10], 1024, 1536, 2, Wb + WO_QKV, 2, gains + 4 * DM, 8 * DM, scr, gw, NGW, lane);
        convert_group(args.in[13], 1024, 1024, 2, Wb + WO_AO, 0, nullptr, 0, scr, gw, NGW, lane);
        convert_group(args.in[14], 1024, 5632, 4, Wb + WO_F1, 1, gains + 2 * DM, 4 * DM, scr, gw, NGW, lane);
        convert_group(args.in[15], 2816, 1024, 4, Wb + WO_F2, 0, nullptr, 0, scr, gw, NGW, lane);
        for (int i = bid * NTHREADS + tid; i < 128 * 32; i += G * NTHREADS) { const int pos = i >> 5, p = i & 31;
            const float inv_freq = (float)exp(-(double)p * (9.210340371976184 / 32.0));
            const float ang = (float)pos * inv_freq;
            double rev = (double)ang * 0.15915494309189535; rev -= floor(rev);
            ROPE[i] = (f32x2){__builtin_amdgcn_cosf((float)rev), __builtin_amdgcn_sinf((float)rev)}; }
        resid_pass(0, x, meta, nullptr, U, RS, OB, nullptr, nullptr, gw, NGW, lane);
        if (bid == 0) for (int i = tid; i < 4096; i += NTHREADS) ((unsigned*)(ws + WS_CTL))[i] = 0u;
        if (tid < 2) ((volatile LAS unsigned*)((LAS unsigned char*)lds + LDS_MISC))[tid] = 0u;
    }
    grid.sync();
    const XcdBarrier xbar = xcd_barrier_post((unsigned*)(ws + WS_CTL), (volatile LAS unsigned*)((LAS unsigned char*)lds + LDS_MISC));
#define GSYNC() xcd_barrier(xbar)

    for (int layer = 0; layer < 4; ++layer) {
        const int slot = layer >> 1; const float* gl = gains + (size_t)layer * 4 * DM;
        size_t zl = 0; asm volatile("" : "+s"(zl));
        float* TAILP = (float*)(ws + WS_TAILP) + zl;
        bf16raw* OB = OB0 + zl; float* RS = RS0 + zl; bf16raw* U = U0 + zl; bf16raw* BIG = BIG0 + zl; bf16raw* MB = MB0 + zl; bf16raw* Wb = Wb0 + zl; bf16raw* Yb = BIG; bf16raw* Xb = BIG + (size_t)MPAD * DM;
        if ((layer & 1) == 0) {
            { EpiLruIn E{Yb, Xb, RS}; GEMM_RUN(EpiLruIn, U, Wb + WO_LRU_IN + (size_t)slot * 2048 * 1024, 2048, 1024, E); }
            GSYNC();
#ifndef NO_LRU
            { FRESH(); lru_pass<false>((LAS unsigned char*)lds, slot, Wb + WO_GATE, Xb, Yb, args.in[4], args.in[5], args.in[7], args.in[8], SUMS, CARRY, G, bid, tid, wid, lane); }
            GSYNC();
            { FRESH(); lru_carry((LAS unsigned char*)lds, SUMS, CARRY, G, bid, wid, lane); }
            GSYNC();
            { FRESH(); lru_pass<true>((LAS unsigned char*)lds, slot, Wb + WO_GATE, Xb, Yb, args.in[4], args.in[5], args.in[7], args.in[8], SUMS, CARRY, G, bid, tid, wid, lane); }
#endif
            GSYNC();
        } else {
            { EpiQkv E{BIG, RS, args.in[11] + slot * 128, args.in[12] + slot * 128, ROPE, (LAS float*)((LAS unsigned char*)lds + 131072)}; GEMM_RUN(EpiQkv, U, Wb + WO_QKV + (size_t)slot * 1536 * 1024, 1536, 1024, E); }
            GSYNC();
#ifndef NO_ATT
            { int bid = blockIdx.x; asm volatile("" : "+s"(bid)); int G = gridDim.x; asm volatile("" : "+s"(G));
              int tq = threadIdx.x; asm volatile("" : "+v"(tq));
#define ATT_IDS() int tq_ = threadIdx.x; asm volatile("" : "+v"(tq_)); const int qw = tq_ >> 6, qr32 = tq_ & 31, qhi = (tq_ >> 5) & 1
              bool fixed_ok;
              { const float* qg_ = args.in[11] + slot * 128; const float* kg_ = args.in[12] + slot * 128; const int l_ = tq & 63;
                float bq = fmaxf(fabsf(qg_[l_]), fabsf(qg_[l_ + 64])), bk = fmaxf(fabsf(kg_[l_]), fabsf(kg_[l_ + 64]));
#pragma unroll
                for (int o_ = 1; o_ < 64; o_ <<= 1) { bq = fmaxf(bq, __shfl_xor(bq, o_)); bk = fmaxf(bk, __shfl_xor(bk, o_)); }
                const float bound = 0.088388347648318440f * 1.4426950408889634f * 128.0f * bq * bk * 1.02f;
                fixed_ok = __builtin_amdgcn_readfirstlane((int)(bound <= 60.0f)) != 0; }
              float* PART = (float*)(ws + WS_SUM) + zl;
              if (layer < 3)   for (int it = bid; it < 16 * 43; it += G) { const int bk = it / 43, s = it - bk * 43, b = bk >> 1, kvh = bk & 1; const size_t rb = (size_t)b * LTOK;
                  ATT_IDS(); const int Rm = (qw * 32 + qr32) & 63, g4 = Rm >> 4, jm = Rm & 15;
                  if (fixed_ok) att::attn_unit<true, true>((const att::bf16*)(BIG + (rb + jm) * QKVD + (kvh * 4 + g4) * 128 + qhi * 8), (const att::bf16*)(BIG + (rb + 192 * s) * QKVD + 1024 + kvh * 128),
                                       (const att::bf16*)(BIG + (rb + 192 * s) * QKVD + 1280 + kvh * 128), nullptr, 3, s == 42, PART + (size_t)it * 8320, (char*)lds);
                  else att::attn_unit<true, false>((const att::bf16*)(BIG + (rb + jm) * QKVD + (kvh * 4 + g4) * 128 + qhi * 8), (const att::bf16*)(BIG + (rb + 192 * s) * QKVD + 1024 + kvh * 128),
                                       (const att::bf16*)(BIG + (rb + 192 * s) * QKVD + 1280 + kvh * 128), nullptr, 3, s == 42, PART + (size_t)it * 8320, (char*)lds); }
              for (int u = bid; u < NB * 8 * 32; u += G) { const int h = u & 7, kvh = h >> 2, qb = (u >> 3) & 31, b = u >> 8;
                  ATT_IDS(); const size_t rb = (size_t)b * LTOK, q0 = rb + NMETA + 256 * qb;
                  const int u2 = (u + G < NB * 8 * 32) ? u + G : u, h2 = u2 & 7, kvh2 = h2 >> 2; const size_t rb2 = (size_t)(u2 >> 8) * LTOK, q02 = rb2 + NMETA + 256 * ((u2 >> 3) & 31);
                  if (fixed_ok) att::attn_unit<false, true>((const att::bf16*)(BIG + (q0 + qw * 32 + qr32) * QKVD + h * 128 + qhi * 8), (const att::bf16*)(BIG + rb * QKVD + 1024 + kvh * 128),
                                        (const att::bf16*)(BIG + rb * QKVD + 1280 + kvh * 128), (att::bf16*)(OB + q0 * DM + h * 128), 129, true, nullptr, (char*)lds,
                                        (const att::bf16*)(BIG + q02 * QKVD + h2 * 128), (const att::bf16*)(BIG + rb2 * QKVD + 1024 + kvh2 * 128), (const att::bf16*)(BIG + rb2 * QKVD + 1280 + kvh2 * 128));
                  else att::attn_unit<false, false>((const att::bf16*)(BIG + (q0 + qw * 32 + qr32) * QKVD + h * 128 + qhi * 8), (const att::bf16*)(BIG + rb * QKVD + 1024 + kvh * 128),
                                        (const att::bf16*)(BIG + rb * QKVD + 1280 + kvh * 128), (att::bf16*)(OB + q0 * DM + h * 128), 129, true, nullptr, (char*)lds,
                                        (const att::bf16*)(BIG + q02 * QKVD + h2 * 128), (const att::bf16*)(BIG + rb2 * QKVD + 1024 + kvh2 * 128), (const att::bf16*)(BIG + rb2 * QKVD + 1280 + kvh2 * 128)); } }
            if (layer < 3) { GSYNC();
            { FRESH(); const float* PART = (const float*)(ws + WS_SUM) + zl; constexpr float C = 1.0f;
              for (int gt = bid * NTHREADS + tid; gt < 16 * 64 * 128; gt += G * NTHREADS) { const int bk = gt >> 13, R = (gt >> 7) & 63, d = gt & 127, b = bk >> 1, kvh = bk & 1;
                  const float* pb = PART + (size_t)bk * 43 * 8320;
                  float M = -3.0e38f;
                  for (int s = 0; s < 43; ++s) M = fmaxf(M, pb[(size_t)s * 8320 + 8192 + R * 2]);
                  float L = 0.f, O = 0.f;
                  for (int s = 0; s < 43; ++s) { const float w = __builtin_amdgcn_exp2f((pb[(size_t)s * 8320 + 8192 + R * 2] - M) * C);
                      L += w * pb[(size_t)s * 8320 + 8192 + R * 2 + 1]; O += w * pb[(size_t)s * 8320 + R * 128 + d]; }
                  const float v = O / L;
                  OB[((size_t)b * LTOK + (R & 15)) * DM + (kvh * 4 + (R >> 4)) * 128 + d] = (bf16raw)(cvt_pk(v, v) & 0xffffu); } } }
#endif
            GSYNC();
        }
        { const bf16raw* Ap = (layer & 1) ? OB : Yb; const bf16raw* Bp = (layer & 1) ? Wb + WO_AO + (size_t)slot * 1024 * 1024 : Wb + WO_LRU_OUT + (size_t)slot * 1024 * 1024;
          EpiPlain E{MB, DM, nullptr, TAILP}; GEMM_RUN_S(EpiPlain, Ap, Bp, 1024, 1024, E, true, TAIL_S); }
        GSYNC();
        { FRESH(); resid_pass(1, nullptr, nullptr, MB, U, RS, nullptr, gl + DM, nullptr, gw, NGW, lane, TAILP); }
        GSYNC();
        { EpiSwiglu E{BIG, RS}; GEMM_RUN_T(EpiSwiglu, U, Wb + WO_F1 + (size_t)layer * 5632 * 1024, 5632, 1024, E, true); }
        GSYNC();
        { EpiPlain E{MB, DM, nullptr, TAILP}; GEMM_RUN_S(EpiPlain, BIG, Wb + WO_F2 + (size_t)layer * 1024 * 2816, 1024, 2816, E, true, TAIL_S); }
        GSYNC();
        if (layer < 3) { { FRESH(); resid_pass(1, nullptr, nullptr, MB, U, RS, nullptr, gl + 3 * DM, nullptr, gw, NGW, lane, TAILP); } GSYNC(); }
        else { FRESH(); resid_pass(2, nullptr, nullptr, MB, U, RS, nullptr, gl + 3 * DM, args.out, gw, NGW, lane, TAILP); }
    }
}

extern "C" void kernel_launch(void* const* d_in, const int* in_sizes, int n_in, void* d_out, int out_size, void* d_ws, size_t ws_size, hipStream_t stream) {
    static int grid = 0;
    if (grid == 0) {
        if (n_in != 16 || ws_size < WS_END) { fprintf(stderr, "kernel_launch: n_in %d ws %zu (need %zu)\n", n_in, ws_size, (size_t)WS_END); grid = -1; return; }
        int dev = 0, cus = 0, per_cu = 0;
        hipGetDevice(&dev); hipDeviceGetAttribute(&cus, hipDeviceAttributeMultiprocessorCount, dev);
        if (hipFuncSetAttribute((const void*)mega_fwd, hipFuncAttributeMaxDynamicSharedMemorySize, LDS_BYTES) != hipSuccess) { fprintf(stderr, "kernel_launch: hipFuncSetAttribute failed\n"); grid = -1; return; }
        if (hipOccupancyMaxActiveBlocksPerMultiprocessor(&per_cu, (const void*)mega_fwd, NTHREADS, LDS_BYTES) != hipSuccess || per_cu < 1) { fprintf(stderr, "kernel_launch: occupancy query gave %d\n", per_cu); per_cu = 1; }
        (void)hipGetLastError();
        grid = cus * per_cu;
    }
    if (grid < 0) return;
    Args a{};
    for (int i = 0; i < 16; ++i) a.in[i] = (const float*)d_in[i];
    a.out = (float*)d_out; a.ws = (unsigned char*)d_ws;
    void* kargs[] = {&a};
    hipError_t e = hipLaunchCooperativeKernel((const void*)mega_fwd, dim3(grid), dim3(NTHREADS), kargs, LDS_BYTES, stream);
    if (e != hipSuccess) fprintf(stderr, "kernel_launch: cooperative launch failed: %s (grid %d)\n", hipGetErrorString(e), grid);
}
```

```cpp
#include <hip/hip_runtime.h>
#include <hip/hip_bf16.h>
#include <hip/hip_cooperative_groups.h>
#include <cstdio>
#include <cstdint>
#include <cmath>
namespace cg = cooperative_groups;

#define PG8_ROWS_VALID 65664
namespace pg8 {
#define PG8_LAS __attribute__((address_space(3)))
typedef unsigned short bf16_t;
typedef short bf16x8 __attribute__((ext_vector_type(8)));
typedef float f32x4 __attribute__((ext_vector_type(4)));
typedef unsigned u32x4 __attribute__((ext_vector_type(4)));
constexpr int BM = 256, BK = 64, HALF = 128, HTB = HALF * BK * 2  , STAGE_BYTES = 8 * HTB, NXCD = 8, WGM = 8;

__host__ __device__ __forceinline__ int lds_byte(int r, int c) { const int st = (r >> 4) * 2 + (c >> 5), rr = r & 15, cc = c & 31, ob = rr * 64 + cc * 2; return st * 1024 + (ob ^ (((ob >> 9) & 1) << 5)); }
__host__ __device__ __forceinline__ void stage_rc(int b, int& R, int& C) { const int st = b / 1024, sb = b % 1024, swz = sb ^ (((sb >> 9) & 1) << 5); R = (st >> 1) * 16 + swz / 64; C = (st & 1) * 32 + (swz % 64) / 2; }
__host__ __device__ __forceinline__ int perm32(int rho) { const int n = rho >> 4, i = rho & 15; return 8 * (i >> 2) + 4 * n + (i & 3); }

struct Unit { int pm, pn, k0, nt, part; };
struct Gemm { const bf16_t* A; const bf16_t* Bt; int M, N, K; };

struct StaticOrder {
    int nM, nN, nwg, G, c, ntail, ntK, S;
    __host__ __device__ void init(int M, int N, int K, int G_, int c_, bool with_tail = true, int S_ = 1) { nM = M / BM - 1; nN = N / BM; nwg = nM * nN; G = G_; c = c_; ntK = K / BK; S = S_; ntail = with_tail ? nN * S : 0; }
    __host__ __device__ bool next(int i, Unit& u) const {
        const long L = (long)i * G + c; if (L >= nwg + ntail) return false;
        u.k0 = 0; u.nt = ntK; u.part = 0;
        if (L >= nwg) { const int j = (int)(L - nwg); u.pm = nM; u.pn = j / S; const int p = j % S; u.part = p;
            if (S > 1) { const int pairs = ntK / 2, q = pairs / S, r = pairs % S; u.nt = 2 * (q + (p < r ? 1 : 0)); u.k0 = 2 * (p * q + (p < r ? p : r)); }
            return true; }
        int wgid = (int)L; { const int q = nwg / NXCD, r = nwg % NXCD, xcd = wgid % NXCD, off = wgid / NXCD; wgid = (xcd < r ? xcd * (q + 1) : r * (q + 1) + (xcd - r) * q) + off; }
        const int nig = WGM * nN, gid = wgid / nig, fm = gid * WGM, gsz = (nM - fm) < WGM ? (nM - fm) : WGM;
        u.pm = fm + ((wgid % nig) % gsz); u.pn = (wgid % nig) / gsz; return true;
    }
    __device__ __forceinline__ void a_ready(const Unit&) const {}
    __device__ __forceinline__ void done(const Unit&) const {}
};

__device__ __forceinline__ unsigned cvt_pk_bf16(float lo, float hi) { unsigned r; asm volatile("v_cvt_pk_bf16_f32 %0, %1, %2" : "=v"(r) : "v"(lo), "v"(hi)); return r; }
typedef float f32x2 __attribute__((ext_vector_type(2)));
__device__ __forceinline__ f32x2 gelu_pk(f32x2 v) {
    const f32x2 av = __builtin_elementwise_abs(v), d = av * 0.2316418882f + 1.0f;
    f32x2 t; t.x = __builtin_amdgcn_rcpf(d.x); t.y = __builtin_amdgcn_rcpf(d.y);
    f32x2 q = t * 0.5307027145f + (-0.7265760135f); q = q * t + 0.7107068705f; q = q * t + (-0.142248368f); q = q * t + 0.127414796f; q = q * t;
    const f32x2 s = (v * v) * (-0.72134752044f);
    f32x2 e; e.x = __builtin_amdgcn_exp2f(s.x); e.y = __builtin_amdgcn_exp2f(s.y);
    const f32x2 m = v * (q * e), r = v - m;
    f32x2 o; o.x = v.x < 0.f ? m.x : r.x; o.y = v.y < 0.f ? m.y : r.y; return o;
}

template <int ACT  > struct EpiBf16 {
    static constexpr bool PERM = true, AFTER_DRAIN = false; static_assert(ACT == 0 || ACT == 1, "EpiBf16: ACT is 0 (none) or 1 (gelu_pk)");
    bf16_t* O; int ldc; const float* bias; int split_cols; size_t split_stride; float scale0;
    __device__ __forceinline__ void operator()(const f32x4 (&acc)[2][2][4][2], const Unit& u, int wr, int wc, int fr, int fq) const {
        const int row0 = u.pm * BM + wr * 64 + fr; int colt = u.pn * BM; bf16_t* base = O;
        float sc = 1.f; if (split_cols) { const int t = colt / split_cols; base += (size_t)t * split_stride; colt -= t * split_cols; if (t == 0) sc = scale0; }
        const int col0 = colt + wc * 32 + 8 * fq, bcol0 = u.pn * BM + wc * 32 + 8 * fq;
        f32x4 bv[2][2];
#pragma unroll
        for (int bj = 0; bj < 2; ++bj)
#pragma unroll
            for (int n = 0; n < 2; ++n) bv[bj][n] = bias ? *(const f32x4*)(bias + bcol0 + bj * HALF + 4 * n) : (f32x4){0.f, 0.f, 0.f, 0.f};
#pragma unroll
        for (int ai = 0; ai < 2; ++ai)
#pragma unroll
            for (int m = 0; m < 4; ++m) { bf16_t* rowp = base + (size_t)(row0 + ai * HALF + m * 16) * ldc + col0;
#pragma unroll
                for (int bj = 0; bj < 2; ++bj) { f32x4 v0 = acc[ai][bj][m][0] + bv[bj][0], v1 = acc[ai][bj][m][1] + bv[bj][1];
                    if (ACT == 1) { f32x2 a = gelu_pk((f32x2){v0[0], v0[1]}), b = gelu_pk((f32x2){v0[2], v0[3]}), c = gelu_pk((f32x2){v1[0], v1[1]}), d = gelu_pk((f32x2){v1[2], v1[3]});
                        v0 = (f32x4){a.x, a.y, b.x, b.y}; v1 = (f32x4){c.x, c.y, d.x, d.y}; }
                    v0 = v0 * sc; v1 = v1 * sc; u32x4 w; w.x = cvt_pk_bf16(v0[0], v0[1]); w.y = cvt_pk_bf16(v0[2], v0[3]); w.z = cvt_pk_bf16(v1[0], v1[1]); w.w = cvt_pk_bf16(v1[2], v1[3]);
                    *(u32x4*)(rowp + bj * HALF) = w; } }
    }
};
template <class Epi, class Sched, bool ALIGN_EPI = false, bool SP2 = false>
__device__ __forceinline__ void gemm_phase(PG8_LAS unsigned char* lds, const Gemm g, const Sched& S, const Epi& E) {
    int tid_ = threadIdx.x; asm volatile("" : "+v"(tid_));
    const int tid = tid_, wid = __builtin_amdgcn_readfirstlane(tid >> 6), lane = tid & 63, wr = wid >> 2, wc = wid & 3, fr = lane & 15, fq = lane >> 4;
    const int K = g.K, nt = K / BK;
    unsigned voffA[2], voffB[2];
#pragma unroll
    for (int i = 0; i < 2; ++i) { int R, C; stage_rc(tid * 16 + i * 8192, R, C); const int Rb = Epi::PERM ? ((R & ~31) + perm32(R & 31)) : R;
        voffA[i] = (unsigned)(R * K + C) * 2u; voffB[i] = (unsigned)(Rb * K + C) * 2u; }
    const size_t kstep = (size_t)(BK * 2);
    const size_t hstep = (size_t)HALF * K * 2;
    const size_t tstep = 2 * hstep;
    const unsigned ldsw = (unsigned)wid * 1024u;
    const int aoff = lds_byte(wr * 64 + fr, fq * 8), boff = lds_byte(wc * 32 + fr, fq * 8);
#define PG8_SA(b, h) (((b) * 2 + (h)) * HTB)
#define PG8_SB(b, h) ((4 + (b) * 2 + (h)) * HTB)
#define PG8_STAGE(bufoff, gbase, voff) do { _Pragma("unroll") for (int _i = 0; _i < 2; ++_i) \
        __builtin_amdgcn_global_load_lds((const unsigned*)((const char*)(gbase) + (voff)[_i]), (PG8_LAS unsigned*)(lds + (bufoff) + ldsw + _i * 8192), 16, 0, 0); } while (0)
#define PG8_LDA(dst, b, h) do { _Pragma("unroll") for (int m = 0; m < 4; ++m) _Pragma("unroll") for (int k = 0; k < 2; ++k) dst[m][k] = *(const PG8_LAS bf16x8*)(lds + PG8_SA(b, h) + aoff + m * 2048 + k * 1024); } while (0)
#define PG8_LDB(dst, b, h) do { _Pragma("unroll") for (int n = 0; n < 2; ++n) _Pragma("unroll") for (int k = 0; k < 2; ++k) dst[n][k] = *(const PG8_LAS bf16x8*)(lds + PG8_SB(b, h) + boff + n * 2048 + k * 1024); } while (0)
#define PG8_MMA(ai, bj, At, Bt) do { __builtin_amdgcn_s_setprio(1); _Pragma("unroll") for (int m = 0; m < 4; ++m) _Pragma("unroll") for (int n = 0; n < 2; ++n) _Pragma("unroll") for (int k = 0; k < 2; ++k) \
        acc[ai][bj][m][n] = __builtin_amdgcn_mfma_f32_16x16x32_bf16(Bt[n][k], At[m][k], acc[ai][bj][m][n], 0, 0, 0); __builtin_amdgcn_s_setprio(0); } while (0)
#define PG8_WAIT_V(n) asm volatile("s_waitcnt vmcnt(" #n ")" ::: "memory")
#define PG8_WAIT_L(n) asm volatile("s_waitcnt lgkmcnt(" #n ")" ::: "memory")
#define PG8_BAR __builtin_amdgcn_s_barrier()
#define PG8_SCHED __builtin_amdgcn_sched_barrier(0)
    Unit cur, nxt; int ui = 0;
    if (!S.next(0, cur)) return;
    f32x4 acc[2][2][4][2];
#pragma unroll
    for (int a = 0; a < 2; ++a)
#pragma unroll
        for (int b = 0; b < 2; ++b)
#pragma unroll
            for (int m = 0; m < 4; ++m)
#pragma unroll
                for (int n = 0; n < 2; ++n) acc[a][b][m][n] = (f32x4){0.f, 0.f, 0.f, 0.f};
    bf16x8 At[4][2], B0[2][2], B1[2][2];
    const char* cA = (const char*)g.A + (size_t)cur.pm * tstep + (size_t)cur.k0 * kstep; const char* cB = (const char*)g.Bt + (size_t)cur.pn * tstep + (size_t)cur.k0 * kstep;
    S.a_ready(cur);
    if constexpr (SP2) {
        PG8_STAGE(PG8_SB(0, 0), cB, voffB); PG8_STAGE(PG8_SB(0, 1), cB + hstep, voffB); PG8_STAGE(PG8_SA(0, 0), cA, voffA); PG8_STAGE(PG8_SA(0, 1), cA + hstep, voffA);
        if (wr == 1) PG8_BAR;
        PG8_WAIT_V(2); PG8_BAR;
        PG8_STAGE(PG8_SB(1, 0), cB + kstep, voffB); PG8_STAGE(PG8_SA(1, 0), cA + kstep, voffA); PG8_STAGE(PG8_SB(1, 1), cB + hstep + kstep, voffB);
        PG8_WAIT_V(6); PG8_BAR;
    } else {
        PG8_STAGE(PG8_SB(0, 0), cB, voffB); PG8_STAGE(PG8_SA(0, 0), cA, voffA); PG8_STAGE(PG8_SB(0, 1), cB + hstep, voffB); PG8_STAGE(PG8_SA(0, 1), cA + hstep, voffA);
        if (wr == 1) PG8_BAR;
        PG8_WAIT_V(4); PG8_BAR;
        PG8_STAGE(PG8_SB(1, 0), cB + kstep, voffB); PG8_STAGE(PG8_SA(1, 0), cA + kstep, voffA); PG8_STAGE(PG8_SB(1, 1), cB + hstep + kstep, voffB);
        PG8_WAIT_V(6); PG8_BAR;
    }
    for (;;) {
        const bool has_next = S.next(ui + 1, nxt);
        const bool full = (cur.pm * BM + HALF) < PG8_ROWS_VALID;
        const char* nA = has_next ? (const char*)g.A + (size_t)nxt.pm * tstep + (size_t)nxt.k0 * kstep : cA; const char* nB = has_next ? (const char*)g.Bt + (size_t)nxt.pn * tstep + (size_t)nxt.k0 * kstep : cB;
        const int ntu = cur.nt;
        for (int t = 0; t < ntu; t += 2) {
            const bool last = (t == ntu - 2);
            const char* a1 = cA + (size_t)(t + 1) * kstep;
            const char* a2 = last ? nA : cA + (size_t)(t + 2) * kstep; const char* b2 = last ? nB : cB + (size_t)(t + 2) * kstep;
            const char* a3 = a2 + kstep; const char* b3 = b2 + kstep;
            if (last && has_next) S.a_ready(nxt);
            if constexpr (SP2) {
            PG8_LDB(B0, 0, 0); PG8_LDB(B1, 0, 1); PG8_SCHED; PG8_LDA(At, 0, 0); PG8_STAGE(PG8_SA(1, 1), a1 + hstep, voffA);
            PG8_WAIT_V(8); PG8_WAIT_L(0); PG8_BAR; PG8_MMA(0, 0, At, B0); PG8_MMA(0, 1, At, B1); PG8_BAR; PG8_SCHED;
            PG8_LDA(At, 0, 1); PG8_STAGE(PG8_SB(0, 0), b2, voffB); PG8_STAGE(PG8_SB(0, 1), b2 + hstep, voffB); PG8_STAGE(PG8_SA(0, 0), a2, voffA);
            PG8_WAIT_V(8); PG8_WAIT_L(0); PG8_BAR; if (full) { PG8_MMA(1, 0, At, B0); PG8_MMA(1, 1, At, B1); } PG8_BAR; PG8_SCHED;
            PG8_LDB(B0, 1, 0); PG8_LDB(B1, 1, 1); PG8_SCHED; PG8_LDA(At, 1, 0); PG8_STAGE(PG8_SA(0, 1), a2 + hstep, voffA);
            PG8_WAIT_V(8); PG8_WAIT_L(0); PG8_BAR; PG8_MMA(0, 0, At, B0); PG8_MMA(0, 1, At, B1); PG8_BAR; PG8_SCHED;
            PG8_LDA(At, 1, 1); PG8_STAGE(PG8_SB(1, 0), b3, voffB); PG8_STAGE(PG8_SB(1, 1), b3 + hstep, voffB); PG8_STAGE(PG8_SA(1, 0), a3, voffA);
            PG8_WAIT_V(8); PG8_WAIT_L(0); PG8_BAR; if (full) { PG8_MMA(1, 0, At, B0); PG8_MMA(1, 1, At, B1); } PG8_BAR; PG8_SCHED;
            } else {
            PG8_LDB(B0, 0, 0); PG8_SCHED; PG8_LDA(At, 0, 0); PG8_STAGE(PG8_SA(1, 1), a1 + hstep, voffA);
            PG8_WAIT_L(8); PG8_BAR; PG8_WAIT_L(0); PG8_MMA(0, 0, At, B0); PG8_BAR; PG8_SCHED;
            PG8_LDB(B1, 0, 1); PG8_STAGE(PG8_SB(0, 0), b2, voffB);
            PG8_BAR; PG8_WAIT_L(0); PG8_MMA(0, 1, At, B1); PG8_BAR;
            PG8_LDA(At, 0, 1); PG8_STAGE(PG8_SA(0, 0), a2, voffA);
            PG8_BAR; PG8_WAIT_L(0); PG8_MMA(1, 0, At, B0); PG8_BAR; PG8_SCHED;
            PG8_STAGE(PG8_SB(0, 1), b2 + hstep, voffB);
            PG8_WAIT_V(6); PG8_BAR; PG8_MMA(1, 1, At, B1); PG8_BAR;
            PG8_LDB(B0, 1, 0); PG8_SCHED; PG8_LDA(At, 1, 0); PG8_STAGE(PG8_SA(0, 1), a2 + hstep, voffA);
            PG8_WAIT_L(8); PG8_BAR; PG8_WAIT_L(0); PG8_MMA(0, 0, At, B0); PG8_BAR; PG8_SCHED;
            PG8_LDB(B1, 1, 1); PG8_STAGE(PG8_SB(1, 0), b3, voffB);
            PG8_BAR; PG8_WAIT_L(0); PG8_MMA(0, 1, At, B1); PG8_BAR;
            PG8_LDA(At, 1, 1); PG8_STAGE(PG8_SA(1, 0), a3, voffA);
            PG8_BAR; PG8_WAIT_L(0); PG8_MMA(1, 0, At, B0); PG8_BAR; PG8_SCHED;
            PG8_STAGE(PG8_SB(1, 1), b3 + hstep, voffB);
            PG8_WAIT_V(6); PG8_BAR; PG8_MMA(1, 1, At, B1); PG8_BAR;
            }
        }
        if constexpr (ALIGN_EPI) { if (wr == 0) PG8_BAR; }
        if constexpr (!Epi::AFTER_DRAIN) { E(acc, cur, wr, wc, fr, fq); S.done(cur); }
        if (!has_next) break;
#pragma unroll
        for (int a = 0; a < 2; ++a)
#pragma unroll
            for (int b = 0; b < 2; ++b)
#pragma unroll
                for (int m = 0; m < 4; ++m)
#pragma unroll
                    for (int n = 0; n < 2; ++n) acc[a][b][m][n] = (f32x4){0.f, 0.f, 0.f, 0.f};
        cur = nxt; cA = nA; cB = nB; ++ui;
        if constexpr (ALIGN_EPI) { if (wr == 1) PG8_BAR; }
    }
    PG8_WAIT_V(0);
    if constexpr (!ALIGN_EPI) { if (wr == 0) PG8_BAR; }
    PG8_BAR;
    if constexpr (Epi::AFTER_DRAIN) { E.fused(acc, cur, wr, wc, fr, fq, lds, wid, lane); S.done(cur); }
#undef PG8_SA
#undef PG8_SB
#undef PG8_STAGE
#undef PG8_LDA
#undef PG8_LDB
#undef PG8_MMA
#undef PG8_WAIT_V
#undef PG8_WAIT_L
#undef PG8_BAR
#undef PG8_SCHED
}
}

namespace att {
using bf16 = __hip_bfloat16;
constexpr int D = 128, NW = 8, QBLK = 32, KVBLK = 64;
constexpr float SCALE = 0.088388347648318440f;
constexpr float THR = 8.f;
constexpr int SDEPTH = 2;
constexpr int LDQ = 1536, LDK = 1536, LDO = 1024;
constexpr size_t SHM_V = KVBLK * D * 2, SHM_K = KVBLK * D * 2, SHM_ATTN = 2 * SHM_V + 2 * SHM_K + NW * 64 * 4;
using bf16x8 = __attribute__((ext_vector_type(8))) short;
using s16x4  = __attribute__((ext_vector_type(4))) short;
using f32x16 = __attribute__((ext_vector_type(16))) float;
using u32x4  = __attribute__((ext_vector_type(4))) unsigned;
#define KSWZ(row, colB) ((row) * 256 + ((colB) ^ (((row) & 7) << 4)))
#define SBAR() __builtin_amdgcn_sched_barrier(0)
__device__ __forceinline__ int crow(int r, int hi) { return (r & 3) + 8 * (r >> 2) + 4 * hi; }
__device__ __forceinline__ unsigned cvtpk(float lo, float hi) {
  unsigned r; asm volatile("v_cvt_pk_bf16_f32 %0, %1, %2" : "=v"(r) : "v"(lo), "v"(hi)); return r;
}
__device__ __forceinline__ bf16x8 ld8(const bf16* p) { return *reinterpret_cast<const bf16x8*>(p); }

__device__ __forceinline__ void partialSM(f32x16& p0, f32x16& p1, float& m_reg, float& mn, float& alpha) {
  constexpr float THRL = THR * 1.4426950408889634f;
  float pmax = p0[0]; for (int r = 1; r < 16; ++r) pmax = fmaxf(pmax, p0[r]); for (int r = 0; r < 16; ++r) pmax = fmaxf(pmax, p1[r]);
  { auto rr = __builtin_amdgcn_permlane32_swap(__float_as_uint(pmax), __float_as_uint(pmax), false, false);
    pmax = fmaxf(__uint_as_float(rr[0]), __uint_as_float(rr[1])); }
  if (__builtin_expect(__all(pmax - m_reg <= THRL), 1)) { mn = m_reg; alpha = 1.f; }
  else { mn = fmaxf(m_reg, pmax); alpha = __builtin_amdgcn_exp2f(m_reg - mn); m_reg = mn; }
  for (int r = 0; r < 16; ++r) p0[r] = p0[r] - mn; for (int r = 0; r < 16; ++r) p1[r] = p1[r] - mn;
  for (int r = 0; r < 16; ++r) p0[r] = __builtin_amdgcn_exp2f(p0[r]);
}
__device__ __forceinline__ void partialSM_fixed(f32x16& p0) {
  for (int r = 0; r < 16; ++r) p0[r] = __builtin_amdgcn_exp2f(p0[r]);
}
__device__ __forceinline__ void finishSM(f32x16& p0, f32x16& p1, float alpha, float& l_reg, bf16x8& pa0, bf16x8& pa1, bf16x8& pa2, bf16x8& pa3) {
  for (int r = 0; r < 16; ++r) p1[r] = __builtin_amdgcn_exp2f(p1[r]);
  float ps = 0; for (int r = 0; r < 16; ++r) ps += p0[r]; for (int r = 0; r < 16; ++r) ps += p1[r];
  { auto rr = __builtin_amdgcn_permlane32_swap(__float_as_uint(ps), __float_as_uint(ps), false, false);
    ps = __uint_as_float(rr[0]) + __uint_as_float(rr[1]); }
  l_reg = l_reg * alpha + ps;
#define PK4(P, BASE, OUT) do { unsigned a0 = cvtpk(P[BASE + 0], P[BASE + 1]), a1 = cvtpk(P[BASE + 2], P[BASE + 3]);   \
    unsigned b0 = cvtpk(P[BASE + 4], P[BASE + 5]), b1 = cvtpk(P[BASE + 6], P[BASE + 7]);                              \
    auto r0 = __builtin_amdgcn_permlane32_swap(a0, b0, false, false); auto r1 = __builtin_amdgcn_permlane32_swap(a1, b1, false, false); \
    u32x4 w = {r0[0], r1[0], r0[1], r1[1]}; OUT = *reinterpret_cast<bf16x8*>(&w); } while (0)
  PK4(p0, 0, pa0); PK4(p0, 8, pa1); PK4(p1, 0, pa2); PK4(p1, 8, pa3);
#undef PK4
}
__device__ __forceinline__ void qkt(f32x16& p0, f32x16& p1, const bf16* Ks, const bf16x8* qr, int r32, int hi) {
  p0 = f32x16{}; p1 = f32x16{};
  for (int d0 = 0; d0 < 8; ++d0) { int cb = (d0 * 16 + hi * 8) * 2;
    bf16x8 b0 = *reinterpret_cast<const bf16x8*>((const char*)Ks + KSWZ(r32, cb));
    bf16x8 b1 = *reinterpret_cast<const bf16x8*>((const char*)Ks + KSWZ(32 + r32, cb));
    p0 = __builtin_amdgcn_mfma_f32_32x32x16_bf16(b0, qr[d0], p0, 0, 0, 0);
    p1 = __builtin_amdgcn_mfma_f32_32x32x16_bf16(b1, qr[d0], p1, 0, 0, 0); }
}
__device__ __forceinline__ int v_st(int k, int c) { const int kk = (k & ~0xC) | ((k & 4) << 1) | ((k & 8) >> 1); return ((kk >> 3) * 4 + (c >> 5)) * 512 + ((kk & 7) * 32 + (c & 31)) * 2; }
__device__ __forceinline__ int v_rd_base(int lane) { return ((lane & 3) << 3) | (((lane >> 2) & 3) << 6) | (((lane >> 4) & 1) << 5) | (((lane >> 5) & 1) << 8); }
constexpr int v_rd_off(int d0, int ks, int half) { return d0 * 512 + ks * 4096 + half * 2048; }
template <int OFF> __device__ __forceinline__ s16x4 tr_read(int vb) {
  s16x4 r; asm volatile("ds_read_b64_tr_b16 %0, %1 offset:%2" : "=&v"(r) : "v"(vb), "i"(OFF) : "memory"); return r;
}
template <int D0> __device__ __forceinline__ void pv_one(f32x16& od, int vb, bf16x8 pa0, bf16x8 pa1, bf16x8 pa2, bf16x8 pa3) {
  const s16x4 l0 = tr_read<v_rd_off(D0, 0, 0)>(vb), h0 = tr_read<v_rd_off(D0, 0, 1)>(vb), l1 = tr_read<v_rd_off(D0, 1, 0)>(vb), h1 = tr_read<v_rd_off(D0, 1, 1)>(vb);
  const s16x4 l2 = tr_read<v_rd_off(D0, 2, 0)>(vb), h2 = tr_read<v_rd_off(D0, 2, 1)>(vb), l3 = tr_read<v_rd_off(D0, 3, 0)>(vb), h3 = tr_read<v_rd_off(D0, 3, 1)>(vb);
  asm volatile("s_waitcnt lgkmcnt(0)" ::: "memory"); SBAR();
#define PK(L, H) (bf16x8){L[0], L[1], L[2], L[3], H[0], H[1], H[2], H[3]}
  od = __builtin_amdgcn_mfma_f32_32x32x16_bf16(pa0, PK(l0, h0), od, 0, 0, 0);
  od = __builtin_amdgcn_mfma_f32_32x32x16_bf16(pa1, PK(l1, h1), od, 0, 0, 0);
  od = __builtin_amdgcn_mfma_f32_32x32x16_bf16(pa2, PK(l2, h2), od, 0, 0, 0);
  od = __builtin_amdgcn_mfma_f32_32x32x16_bf16(pa3, PK(l3, h3), od, 0, 0, 0);
#undef PK
}
__device__ __forceinline__ void pv_d0(f32x16* o, int vb, bf16x8 pa0, bf16x8 pa1, bf16x8 pa2, bf16x8 pa3) {
  pv_one<0>(o[0], vb, pa0, pa1, pa2, pa3); pv_one<1>(o[1], vb, pa0, pa1, pa2, pa3); pv_one<2>(o[2], vb, pa0, pa1, pa2, pa3); pv_one<3>(o[3], vb, pa0, pa1, pa2, pa3);
}

typedef __attribute__((address_space(3))) bf16x8 lds_bf16x8;
#define LDSV(addr) (*(lds_bf16x8*)(unsigned)(addr))
template <int BOFF> __device__ __forceinline__ void qkt_i(f32x16& p0, f32x16& p1, const int (&kb)[4], const bf16x8* qr) {
  p0 = f32x16{}; p1 = f32x16{};
#pragma unroll
  for (int d0 = 0; d0 < 8; ++d0) { const int off = BOFF + (d0 >> 2) * 128;
    const bf16x8 b0 = LDSV(kb[d0 & 3] + off), b1 = LDSV(kb[d0 & 3] + off + 8192);
    p0 = __builtin_amdgcn_mfma_f32_32x32x16_bf16(b0, qr[d0], p0, 0, 0, 0);
    p1 = __builtin_amdgcn_mfma_f32_32x32x16_bf16(b1, qr[d0], p1, 0, 0, 0); }
}
template <int D0, int BOFF> __device__ __forceinline__ void pv_one_i(f32x16& od, int vb, bf16x8 pa0, bf16x8 pa1, bf16x8 pa2, bf16x8 pa3) {
  const s16x4 l0 = tr_read<BOFF + v_rd_off(D0, 0, 0)>(vb), h0 = tr_read<BOFF + v_rd_off(D0, 0, 1)>(vb), l1 = tr_read<BOFF + v_rd_off(D0, 1, 0)>(vb), h1 = tr_read<BOFF + v_rd_off(D0, 1, 1)>(vb);
  const s16x4 l2 = tr_read<BOFF + v_rd_off(D0, 2, 0)>(vb), h2 = tr_read<BOFF + v_rd_off(D0, 2, 1)>(vb), l3 = tr_read<BOFF + v_rd_off(D0, 3, 0)>(vb), h3 = tr_read<BOFF + v_rd_off(D0, 3, 1)>(vb);
  asm volatile("s_waitcnt lgkmcnt(0)" ::: "memory"); SBAR();
#define PK(L, H) (bf16x8){L[0], L[1], L[2], L[3], H[0], H[1], H[2], H[3]}
  od = __builtin_amdgcn_mfma_f32_32x32x16_bf16(pa0, PK(l0, h0), od, 0, 0, 0);
  od = __builtin_amdgcn_mfma_f32_32x32x16_bf16(pa1, PK(l1, h1), od, 0, 0, 0);
  od = __builtin_amdgcn_mfma_f32_32x32x16_bf16(pa2, PK(l2, h2), od, 0, 0, 0);
  od = __builtin_amdgcn_mfma_f32_32x32x16_bf16(pa3, PK(l3, h3), od, 0, 0, 0);
#undef PK
}
template <int BOFF> __device__ __forceinline__ void pv_i(f32x16* o, int vb, bf16x8 pa0, bf16x8 pa1, bf16x8 pa2, bf16x8 pa3) {
  pv_one_i<0, BOFF>(o[0], vb, pa0, pa1, pa2, pa3); pv_one_i<1, BOFF>(o[1], vb, pa0, pa1, pa2, pa3); pv_one_i<2, BOFF>(o[2], vb, pa0, pa1, pa2, pa3); pv_one_i<3, BOFF>(o[3], vb, pa0, pa1, pa2, pa3);
}
struct AttSlot { bf16x8 vs0, vs1, ks0, ks1; };
struct AttCarry { bf16x8 qr[8]; AttSlot s[2]; };
__device__ __forceinline__ void att_preload(AttCarry& cy, const bf16* Qrow, const bf16* Kh, const bf16* Vh) {
  const int tid = threadIdx.x, sr = tid >> 4, sc = (tid & 15) * 8;
#pragma unroll
  for (int d0 = 0; d0 < 8; ++d0) cy.qr[d0] = ld8(Qrow + d0 * 16);
#pragma unroll
  for (int i = 0; i < 2; ++i) { const int k0 = i * KVBLK;
    cy.s[i].vs0 = ld8(&Vh[(long)(k0 + sr) * LDK + sc]); cy.s[i].vs1 = ld8(&Vh[(long)(k0 + 32 + sr) * LDK + sc]);
    cy.s[i].ks0 = ld8(&Kh[(long)(k0 + sr) * LDK + sc]); cy.s[i].ks1 = ld8(&Kh[(long)(k0 + 32 + sr) * LDK + sc]); }
}
template <bool PARTIAL, bool FIXED>
__device__ __forceinline__ void attn_unit(const bf16* __restrict__ Qrow, const bf16* __restrict__ Kh, const bf16* __restrict__ Vh,
                                          bf16* __restrict__ Ob, int NT, bool mask_last, float* __restrict__ PO, char* lds,
                                          const bf16* Qb_n = nullptr, const bf16* Kh_n = nullptr, const bf16* Vh_n = nullptr) {
  AttCarry cy; unsigned warm0 = 0u, warm1 = 0u;
  int tid_ = threadIdx.x; asm volatile("" : "+v"(tid_));
  const int tid = tid_, wid = tid >> 6, lane = tid & 63, r32 = lane & 31, hi = lane >> 5;
  bf16* V_lds = (bf16*)lds; bf16* K_lds = (bf16*)(lds + 3 * SHM_V);
  float* ws = (float*)(lds + 3 * SHM_V + 3 * SHM_K) + wid * 64; float* li_l = ws; float* al_l = ws + 32;
  float m_reg = FIXED ? 0.f : -1e30f, l_reg = 0; f32x16 o[4] = {}; bf16x8 (&qr)[8] = cy.qr;
  const bf16* Qw = Qrow;
  const int sr = tid >> 4, sc = (tid & 15) * 8, vst0 = v_st(sr, sc), vst1 = v_st(32 + sr, sc);
  const int vb0 = (int)(uintptr_t)V_lds + v_rd_base(lane);
  AttSlot (&sr_)[2] = cy.s;
#define SLOAD(i, k0) do { sr_[i].vs0 = ld8(&Vh[(long)((k0) + sr) * LDK + sc]); sr_[i].vs1 = ld8(&Vh[(long)((k0) + 32 + sr) * LDK + sc]); \
    sr_[i].ks0 = ld8(&Kh[(long)((k0) + sr) * LDK + sc]); sr_[i].ks1 = ld8(&Kh[(long)((k0) + 32 + sr) * LDK + sc]); } while (0)
#define SLOADP(i, Kp, Vp, k0) do { sr_[i].vs0 = ld8(&(Vp)[(long)((k0) + sr) * LDK + sc]); sr_[i].vs1 = ld8(&(Vp)[(long)((k0) + 32 + sr) * LDK + sc]); \
    sr_[i].ks0 = ld8(&(Kp)[(long)((k0) + sr) * LDK + sc]); sr_[i].ks1 = ld8(&(Kp)[(long)((k0) + 32 + sr) * LDK + sc]); } while (0)
#define SWRITE(b, i) do { *(bf16x8*)((char*)V_lds + (b) * SHM_V + vst0) = sr_[i].vs0;          \
    *(bf16x8*)((char*)V_lds + (b) * SHM_V + vst1) = sr_[i].vs1; int kc = sc * 2;               \
    *(bf16x8*)((char*)K_lds + (b) * SHM_K + KSWZ(sr, kc)) = sr_[i].ks0;                       \
    *(bf16x8*)((char*)K_lds + (b) * SHM_K + KSWZ(32 + sr, kc)) = sr_[i].ks1; } while (0)
#define SWAIT() asm volatile("s_waitcnt vmcnt(4)" ::: "memory")
#define RESC(a) do { if (__any((a) < 1.f)) { if (hi == 0) al_l[r32] = (a); asm volatile("s_waitcnt lgkmcnt(0)" ::: "memory"); \
    for (int d = 0; d < 4; ++d) for (int r = 0; r < 16; ++r) o[d][r] *= al_l[crow(r, hi)]; } } while (0)
  f32x16 pA0, pA1, pB0, pB1; float mnA, mnB, alA, alB; bf16x8 pa0, pa1, pa2, pa3;
  constexpr int KR = 3 * (int)SHM_V;
  const int ldsb = (int)(uintptr_t)lds, xs = (hi * 16) ^ ((r32 & 7) << 4);
  int kb[4];
#pragma unroll
  for (int k = 0; k < 4; ++k) { kb[k] = ldsb + KR + r32 * 256 + ((k * 32) ^ xs); asm volatile("" : "+v"(kb[k])); }
  int vbi = ldsb + v_rd_base(lane), wv0 = ldsb + vst0, wv1 = ldsb + vst1, wk0 = ldsb + KR + KSWZ(sr, sc * 2), wk1 = ldsb + KR + KSWZ(32 + sr, sc * 2);
  asm volatile("" : "+v"(vbi)); asm volatile("" : "+v"(wv0)); asm volatile("" : "+v"(wv1)); asm volatile("" : "+v"(wk0)); asm volatile("" : "+v"(wk1));
#define SWRITE_I(B, i) do { LDSV(wv0 + (B) * 16384) = sr_[i].vs0; LDSV(wv1 + (B) * 16384) = sr_[i].vs1; LDSV(wk0 + (B) * 16384) = sr_[i].ks0; LDSV(wk1 + (B) * 16384) = sr_[i].ks1; } while (0)
  if ((NT - 3) % 6 != 0) return;
#pragma unroll
  for (int d0 = 0; d0 < 8; ++d0) qr[d0] = ld8(Qw + d0 * 16);
  SLOAD(0, 0); SLOAD(1, KVBLK);
  SWRITE_I(0, 0); __syncthreads();
  qkt_i<0>(pA0, pA1, kb, qr);
  SLOAD(0, 2 * KVBLK); SBAR();
  if constexpr (FIXED) { partialSM_fixed(pA0); alA = 1.f; } else partialSM(pA0, pA1, m_reg, mnA, alA);
  SWAIT(); SWRITE_I(1, 1);
#define HALF_B(BC, BP, LOADSTMT, WRITESTMT) do { __syncthreads(); \
    SBAR(); qkt_i<(BC) * 16384>(pB0, pB1, kb, qr); \
    finishSM(pA0, pA1, alA, l_reg, pa0, pa1, pa2, pa3); SBAR(); \
    LOADSTMT; SBAR(); \
    pv_i<(BP) * 16384>(o, vbi, pa0, pa1, pa2, pa3); \
    if constexpr (FIXED) { partialSM_fixed(pB0); alB = 1.f; } else { partialSM(pB0, pB1, m_reg, mnB, alB); RESC(alB); } \
    WRITESTMT; } while (0)
#define HALF_A(BC, BP, MASKSTMT, LOADSTMT, WRITESTMT) do { __syncthreads(); \
    SBAR(); qkt_i<(BC) * 16384>(pA0, pA1, kb, qr); \
    MASKSTMT; \
    finishSM(pB0, pB1, alB, l_reg, pa0, pa1, pa2, pa3); SBAR(); \
    LOADSTMT; SBAR(); \
    pv_i<(BP) * 16384>(o, vbi, pa0, pa1, pa2, pa3); \
    if constexpr (FIXED) { partialSM_fixed(pA0); alA = 1.f; } else { partialSM(pA0, pA1, m_reg, mnA, alA); RESC(alA); } \
    WRITESTMT; } while (0)
#define NOP_() do { } while (0)
  int j = 1;
  for (; j + 6 < NT; j += 6) {
    HALF_B(1, 0, SLOAD(1, (j + 2) * KVBLK), do { SWAIT(); SWRITE_I(2, 0); } while (0));
    HALF_A(2, 1, NOP_(), SLOAD(0, (j + 3) * KVBLK), do { SWAIT(); SWRITE_I(0, 1); } while (0));
    HALF_B(0, 2, SLOAD(1, (j + 4) * KVBLK), do { SWAIT(); SWRITE_I(1, 0); } while (0));
    HALF_A(1, 0, NOP_(), SLOAD(0, (j + 5) * KVBLK), do { SWAIT(); SWRITE_I(2, 1); } while (0));
    HALF_B(2, 1, SLOAD(1, (j + 6) * KVBLK), do { SWAIT(); SWRITE_I(0, 0); } while (0));
    HALF_A(0, 2, NOP_(), SLOAD(0, (j + 7) * KVBLK), do { SWAIT(); SWRITE_I(1, 1); } while (0));
  }
  if constexpr (!PARTIAL) { const int i1 = tid & 255;
    warm0 = *(const unsigned*)(Qb_n + (long)(tid >> 1) * LDQ + (tid & 1) * 64);
    warm1 = *(const unsigned*)((tid < 256 ? Kh_n : Vh_n) + (long)(i1 >> 1) * LDK + (i1 & 1) * 64); }
  HALF_B(1, 0, NOP_(), SWRITE_I(2, 0));
  HALF_A(2, 1, do { if (mask_last) { asm volatile("; masked tail tile" ::: "memory"); const float NEG = -INFINITY; \
      _Pragma("unroll") for (int r = 8; r < 16; ++r) pA0[r] = NEG; _Pragma("unroll") for (int r = 0; r < 16; ++r) pA1[r] = NEG; } } while (0), NOP_(), NOP_());
#undef HALF_A
#undef HALF_B
#undef NOP_
  SBAR(); finishSM(pA0, pA1, alA, l_reg, pa0, pa1, pa2, pa3); SBAR();
  pv_i<2 * 16384>(o, vbi, pa0, pa1, pa2, pa3);
#undef SWRITE_I
  if (PARTIAL) {
    if (wid < 2) { float* po = PO + (wid * QBLK) * 128;
#pragma unroll
      for (int r = 0; r < 16; ++r) { const int orow = crow(r, hi);
#pragma unroll
        for (int d0 = 0; d0 < 4; ++d0) po[orow * 128 + d0 * 32 + r32] = o[d0][r]; }
      if (hi == 0) { PO[8192 + (wid * QBLK + r32) * 2] = m_reg; PO[8192 + (wid * QBLK + r32) * 2 + 1] = l_reg; } }
    __syncthreads();
    return;
  }
  if (hi == 0) li_l[r32] = l_reg; asm volatile("s_waitcnt lgkmcnt(0)" ::: "memory");
  float rli[16];
#pragma unroll
  for (int r = 0; r < 16; ++r) rli[r] = __builtin_amdgcn_rcpf(li_l[crow(r, hi)]);
  __syncthreads();
  unsigned short* stg = (unsigned short*)(lds + wid * 8192);
#pragma unroll
  for (int r = 0; r < 16; ++r) { const int orow = crow(r, hi);
#pragma unroll
    for (int d0 = 0; d0 < 4; ++d0) { const float v = o[d0][r] * rli[r]; stg[orow * 128 + d0 * 32 + r32] = (unsigned short)(cvtpk(v, v) & 0xffffu); } }
  asm volatile("s_waitcnt lgkmcnt(0)" ::: "memory");
#pragma unroll
  for (int it = 0; it < 8; ++it) { const int row = it * 4 + (lane >> 4), c16 = lane & 15;
    const bf16x8 v = *reinterpret_cast<const bf16x8*>((const char*)stg + row * 256 + c16 * 16);
    *reinterpret_cast<bf16x8*>(Ob + (long)(wid * QBLK + row) * LDO + c16 * 8) = v; }
  asm volatile("" :: "v"(warm0 ^ warm1));
  __syncthreads();
#undef SLOAD
#undef SLOADP
#undef SWRITE
#undef SWAIT
#undef RESC
}
#undef KSWZ
#undef SBAR
}

#define LAS __attribute__((address_space(3)))
typedef unsigned short bf16raw;
typedef short bf16x8 __attribute__((ext_vector_type(8)));
typedef float f32x4 __attribute__((ext_vector_type(4)));
typedef float f32x2 __attribute__((ext_vector_type(2)));
typedef unsigned u32x4 __attribute__((ext_vector_type(4)));
typedef unsigned u32x2 __attribute__((ext_vector_type(2)));

constexpr int DM = 1024, NB = 8, SEQ = 8192, NMETA = 16, LTOK = SEQ + NMETA, MTOK = NB * LTOK, MPAD = 65792;
constexpr int DFF = 2816, QKVD = 1536, NTHREADS = 512;
constexpr float RMS_EPS = 1e-6f;
constexpr int LDS_BYTES = 147456;
static_assert(MPAD % 256 == 0 && MPAD >= MTOK + 128, "row padding");
constexpr size_t WS_H = 0;
constexpr size_t WS_U = WS_H + (size_t)MPAD * DM * 4;
constexpr size_t WS_BIG = WS_U + (size_t)MPAD * DM * 2;
constexpr size_t WS_MB = WS_BIG + (size_t)MPAD * DFF * 2;
constexpr size_t WS_W = WS_MB + (size_t)MPAD * DM * 2;
constexpr size_t WO_LRU_IN = 0, WO_LRU_OUT = WO_LRU_IN + 2ul * 2048 * 1024, WO_GATE = WO_LRU_OUT + 2ul * 1024 * 1024, WO_QKV = WO_GATE + 64ul * 128 * 128,
                 WO_AO = WO_QKV + 2ul * 1536 * 1024, WO_F1 = WO_AO + 2ul * 1024 * 1024, WO_F2 = WO_F1 + 4ul * 5632 * 1024, WO_END = WO_F2 + 4ul * 1024 * 2816;
constexpr int LT = 48, NCHUNK = LTOK / LT;
static_assert(NCHUNK * LT == LTOK, "chunking");
constexpr size_t WS_SUM = WS_W + WO_END * 2;
constexpr size_t WS_CARRY = WS_SUM + (size_t)NB * NCHUNK * 2 * 1024 * 8;
constexpr size_t WS_ROPE = WS_CARRY + (size_t)NB * NCHUNK * 2 * 1024 * 4;
constexpr size_t WS_CTL = WS_ROPE + 128 * 32 * 8;
constexpr size_t WS_TAILP = WS_CTL + 16384;
constexpr size_t WS_END = WS_TAILP + 4ul * 128 * 1024 * 4;
constexpr int MREG = 65536, TAIL_S = 4;
constexpr int LDS_MISC = 147200;

__device__ __forceinline__ unsigned cvt_pk(float lo, float hi) { unsigned r; asm volatile("v_cvt_pk_bf16_f32 %0, %1, %2" : "=v"(r) : "v"(lo), "v"(hi)); return r; }
__device__ __forceinline__ float bf_lo(unsigned w) { return __uint_as_float(w << 16); }
__device__ __forceinline__ float bf_hi(unsigned w) { return __uint_as_float(w & 0xffff0000u); }
__device__ __forceinline__ float wave_sum(float v) {
#pragma unroll
    for (int o = 1; o < 64; o <<= 1) v += __shfl_xor(v, o);
    return v;
}
__device__ __forceinline__ float sigmoidf_fast(float x) { return __builtin_amdgcn_rcpf(1.0f + __builtin_amdgcn_exp2f(-1.4426950408889634f * x)); }
__device__ __forceinline__ float gelu_tanh(float x) {
    const float z = x * (1.0f + 0.044715f * x * x) * (2.0f * 0.7978845608028654f);
    return x * sigmoidf_fast(z);
}

struct EpiPlain {
    static constexpr bool PERM = true, AFTER_DRAIN = false, ALIGN = true;
    bf16raw* O; int ldc; const float* rs; float* tailp;
    __device__ __forceinline__ void operator()(const f32x4 (&acc)[2][2][4][2], const pg8::Unit& u, int wr, int wc, int fr, int fq) const {
        const int row0 = u.pm * 256 + wr * 64 + fr, col0 = u.pn * 256 + wc * 32 + 8 * fq;
        if (tailp && u.pm * 256 >= MREG) {
#pragma unroll
            for (int m = 0; m < 4; ++m) { float* rowp = tailp + ((size_t)u.part * 128 + wr * 64 + m * 16 + fr) * 1024 + col0;
#pragma unroll
                for (int bj = 0; bj < 2; ++bj) { *(f32x4*)(rowp + bj * 128) = acc[0][bj][m][0]; *(f32x4*)(rowp + bj * 128 + 4) = acc[0][bj][m][1]; } }
            return; }
#pragma unroll
        for (int ai = 0; ai < 2; ++ai)
#pragma unroll
            for (int m = 0; m < 4; ++m) { bf16raw* rowp = O + (size_t)(row0 + ai * 128 + m * 16) * ldc + col0; const float sc = rs ? rs[row0 + ai * 128 + m * 16] : 1.0f;
#pragma unroll
                for (int bj = 0; bj < 2; ++bj) { const f32x4 v0 = acc[ai][bj][m][0] * sc, v1 = acc[ai][bj][m][1] * sc;
                    u32x4 w; w.x = cvt_pk(v0[0], v0[1]); w.y = cvt_pk(v0[2], v0[3]); w.z = cvt_pk(v1[0], v1[1]); w.w = cvt_pk(v1[2], v1[3]);
                    *(u32x4*)(rowp + bj * 128) = w; } }
    }
};
struct EpiLruIn {
    static constexpr bool PERM = true, AFTER_DRAIN = false, ALIGN = true;
    bf16raw* Y; bf16raw* X; const float* rs;
    __device__ __forceinline__ void operator()(const f32x4 (&acc)[2][2][4][2], const pg8::Unit& u, int wr, int wc, int fr, int fq) const {
        const bool isy = u.pn < 4; bf16raw* base = isy ? Y : X;
        const int row0 = u.pm * 256 + wr * 64 + fr, col0 = (isy ? u.pn : u.pn - 4) * 256 + wc * 32 + 8 * fq;
#pragma unroll
        for (int ai = 0; ai < 2; ++ai)
#pragma unroll
            for (int m = 0; m < 4; ++m) { bf16raw* rowp = base + (size_t)(row0 + ai * 128 + m * 16) * DM + col0; const float sc = rs[row0 + ai * 128 + m * 16];
#pragma unroll
                for (int bj = 0; bj < 2; ++bj) { f32x4 v0 = acc[ai][bj][m][0] * sc, v1 = acc[ai][bj][m][1] * sc;
                    if (isy) {
#pragma unroll
                        for (int i = 0; i < 4; ++i) { v0[i] = gelu_tanh(v0[i]); v1[i] = gelu_tanh(v1[i]); } }
                    u32x4 w; w.x = cvt_pk(v0[0], v0[1]); w.y = cvt_pk(v0[2], v0[3]); w.z = cvt_pk(v1[0], v1[1]); w.w = cvt_pk(v1[2], v1[3]);
                    *(u32x4*)(rowp + bj * 128) = w; } }
    }
};
struct EpiSwiglu {
    static constexpr bool PERM = true, AFTER_DRAIN = false, ALIGN = true;
    bf16raw* O; const float* rs;
    __device__ __forceinline__ void operator()(const f32x4 (&acc)[2][2][4][2], const pg8::Unit& u, int wr, int wc, int fr, int fq) const {
        const int row0 = u.pm * 256 + wr * 64 + fr, col0 = u.pn * 128 + wc * 32 + 8 * fq;
#pragma unroll
        for (int ai = 0; ai < 2; ++ai)
#pragma unroll
            for (int m = 0; m < 4; ++m) { bf16raw* rowp = O + (size_t)(row0 + ai * 128 + m * 16) * DFF + col0; const float sc = rs[row0 + ai * 128 + m * 16];
                unsigned wv[4];
#pragma unroll
                for (int n = 0; n < 2; ++n)
#pragma unroll
                    for (int ip = 0; ip < 4; ip += 2) {
                        const f32x2 g = (f32x2){acc[ai][0][m][n][ip], acc[ai][0][m][n][ip + 1]} * sc, up = (f32x2){acc[ai][1][m][n][ip], acc[ai][1][m][n][ip + 1]} * sc;
                        const f32x2 t = g * (-1.4426950408889634f);
                        f32x2 ex; ex.x = __builtin_amdgcn_exp2f(t.x); ex.y = __builtin_amdgcn_exp2f(t.y);
                        ex = ex + 1.0f;
                        f32x2 rc; rc.x = __builtin_amdgcn_rcpf(ex.x); rc.y = __builtin_amdgcn_rcpf(ex.y);
                        const f32x2 r = g * rc * up;
                        wv[n * 2 + (ip >> 1)] = cvt_pk(r.x, r.y); }
                u32x4 w; w.x = wv[0]; w.y = wv[1]; w.z = wv[2]; w.w = wv[3];
                *(u32x4*)rowp = w; }
    }
};

struct EpiQkv {
    static constexpr bool PERM = true, AFTER_DRAIN = false, ALIGN = true;
    bf16raw* O; const float* rs; const float* qg; const float* kg; const f32x2* tab; LAS float* ss;
    __device__ __forceinline__ void operator()(const f32x4 (&acc)[2][2][4][2], const pg8::Unit& u, int wr, int wc, int fr, int fq) const {
        const int row0 = u.pm * 256 + wr * 64 + fr, col0 = u.pn * 256 + wc * 32 + 8 * fq;
        if (u.pn == 5) {
#pragma unroll
            for (int ai = 0; ai < 2; ++ai)
#pragma unroll
                for (int m = 0; m < 4; ++m) { bf16raw* rowp = O + (size_t)(row0 + ai * 128 + m * 16) * QKVD + col0; const float sc = rs[row0 + ai * 128 + m * 16];
#pragma unroll
                    for (int bj = 0; bj < 2; ++bj) { const f32x4 v0 = acc[ai][bj][m][0] * sc, v1 = acc[ai][bj][m][1] * sc;
                        u32x4 w; w.x = cvt_pk(v0[0], v0[1]); w.y = cvt_pk(v0[2], v0[3]); w.z = cvt_pk(v1[0], v1[1]); w.w = cvt_pk(v1[2], v1[3]);
                        *(u32x4*)(rowp + bj * 128) = w; } }
            return; }
#pragma unroll
        for (int ai = 0; ai < 2; ++ai)
#pragma unroll
            for (int m = 0; m < 4; ++m) { const float sc = rs[row0 + ai * 128 + m * 16];
#pragma unroll
                for (int bj = 0; bj < 2; ++bj) { const f32x4 v0 = acc[ai][bj][m][0] * sc, v1 = acc[ai][bj][m][1] * sc;
                    float s = (v0[0] * v0[0] + v0[1] * v0[1]) + (v0[2] * v0[2] + v0[3] * v0[3]) + (v1[0] * v1[0] + v1[1] * v1[1]) + (v1[2] * v1[2] + v1[3] * v1[3]);
                    s += __shfl_xor(s, 16); s += __shfl_xor(s, 32);
                    if (fq == 0) ss[(bj * 4 + wc) * 256 + ai * 128 + wr * 64 + m * 16 + fr] = s; } }
        asm volatile("s_waitcnt lgkmcnt(0)" ::: "memory"); __builtin_amdgcn_s_barrier(); asm volatile("" ::: "memory");
        const int axis = wc >> 1, p0 = (wc & 1) * 16 + 4 * fq, d1 = axis * 64 + p0;
        const float* gsrc = (u.pn == 4) ? kg : qg; const float qsc = (u.pn == 4) ? 1.0f : 0.088388347648318440f * 1.4426950408889634f;
        const f32x4 g1 = *(const f32x4*)(gsrc + d1), g2 = *(const f32x4*)(gsrc + d1 + 32);
#pragma unroll
        for (int ai = 0; ai < 2; ++ai)
#pragma unroll
            for (int m = 0; m < 4; ++m) { const int row = row0 + ai * 128 + m * 16, rl = ai * 128 + wr * 64 + m * 16 + fr; const float sc = rs[row];
                const int rr = row < MTOK ? row : 0, b = rr / LTOK, t = rr - b * LTOK;
                f32x4 cc = (f32x4){1.f, 1.f, 1.f, 1.f}, sn = (f32x4){0.f, 0.f, 0.f, 0.f};
                if (t >= NMETA) { const int s = t - NMETA, pos = axis ? (s & 63) : (s >> 6); const f32x4 t0 = *(const f32x4*)(tab + pos * 32 + p0), t1 = *(const f32x4*)(tab + pos * 32 + p0 + 2);
                    cc = (f32x4){t0[0], t0[2], t1[0], t1[2]}; sn = (f32x4){t0[1], t0[3], t1[1], t1[3]}; }
                bf16raw* rowp = O + (size_t)row * QKVD + col0;
#pragma unroll
                for (int bj = 0; bj < 2; ++bj) { const LAS float* sp = ss + bj * 1024 + rl;
                    const float tot = (sp[0] + sp[256]) + (sp[512] + sp[768]);
                    const float rn = (1.0f / sqrtf(tot * (1.0f / 128.0f) + RMS_EPS)) * sc * qsc;
                    const f32x4 n1 = acc[ai][bj][m][0] * rn * g1, n2 = acc[ai][bj][m][1] * rn * g2;
                    const f32x4 o1 = n1 * cc - n2 * sn, o2 = n2 * cc + n1 * sn;
                    u32x4 w; w.x = cvt_pk(o1[0], o1[1]); w.y = cvt_pk(o1[2], o1[3]); w.z = cvt_pk(o2[0], o2[1]); w.w = cvt_pk(o2[2], o2[3]);
                    *(u32x4*)(rowp + bj * 128) = w; } }
    }
};

__device__ __forceinline__ void transpose_item(const float* W, int K, int N, bf16raw* WT, int perm, const float* gk, LAS float* scr, int item, int lane) {
    const int nblk = N / 32, kb = item / nblk, nb = item % nblk, k0 = 64 * kb, n0 = 32 * nb;
    int d0 = n0;
    if (perm == 1) { const int j = n0 < DFF ? n0 : n0 - DFF; d0 = (j >> 7) * 256 + (j & 127) + (n0 < DFF ? 0 : 128); }
#pragma unroll 8
    for (int i = 0; i < 32; ++i) { const int kk = 2 * i + (lane >> 5); const float gsc = gk ? gk[k0 + kk] : 1.0f; scr[kk * 33 + (lane & 31)] = W[(size_t)(k0 + kk) * N + n0 + (lane & 31)] * gsc; }
    asm volatile("s_waitcnt lgkmcnt(0)" ::: "memory");
    const int c = lane & 7;
#pragma unroll
    for (int j = 0; j < 4; ++j) { const int n = (lane >> 3) + 8 * j; const LAS float* s = scr + (8 * c) * 33 + n;
        u32x4 o; o.x = cvt_pk(s[0 * 33], s[1 * 33]); o.y = cvt_pk(s[2 * 33], s[3 * 33]); o.z = cvt_pk(s[4 * 33], s[5 * 33]); o.w = cvt_pk(s[6 * 33], s[7 * 33]);
        int dr = d0 + n;
        if (perm == 2) { const int ns = n0 + n; if (ns < 1280) { const int hd = ns >> 7, d = ns & 127, ax = d >> 6, hf = (d >> 5) & 1, p = d & 31;
                dr = hd * 128 + 32 * (ax * 2 + (p >> 4)) + 8 * ((p >> 2) & 3) + 4 * hf + (p & 3); } }
        *(u32x4*)(WT + (size_t)dr * K + k0 + 8 * c) = o; }
    asm volatile("s_waitcnt lgkmcnt(0)" ::: "memory");
}
__device__ __forceinline__ void convert_group(const float* W, int K, int N, int nmat, bf16raw* WT, int perm, const float* gbase, int gstride, LAS float* scr, int gw, int NGW, int lane) {
    const int per = (K / 64) * (N / 32), total = per * nmat;
    for (int it = gw; it < total; it += NGW) { const int mt = it / per, r = it % per;
        transpose_item(W + (size_t)mt * K * N, K, N, WT + (size_t)mt * K * N, perm, gbase ? gbase + (size_t)mt * gstride : nullptr, scr, r, lane); }
}

struct Row16 { f32x4 v[4]; };
__device__ __forceinline__ void ld_row_f32(Row16& r, const float* p, int lane) {
    const f32x4* q = (const f32x4*)(p + 8 * lane); r.v[0] = q[0]; r.v[1] = q[1]; r.v[2] = q[128]; r.v[3] = q[129];
}
__device__ __forceinline__ void st_row_f32(const Row16& r, float* p, int lane) {
    f32x4* q = (f32x4*)(p + 8 * lane); q[0] = r.v[0]; q[1] = r.v[1]; q[128] = r.v[2]; q[129] = r.v[3];
}
__device__ __forceinline__ void ld_row_bf16(Row16& r, const bf16raw* p, int lane) {
    const u32x4 a = *(const u32x4*)(p + 8 * lane), b = *(const u32x4*)(p + 512 + 8 * lane);
    r.v[0] = (f32x4){bf_lo(a.x), bf_hi(a.x), bf_lo(a.y), bf_hi(a.y)}; r.v[1] = (f32x4){bf_lo(a.z), bf_hi(a.z), bf_lo(a.w), bf_hi(a.w)};
    r.v[2] = (f32x4){bf_lo(b.x), bf_hi(b.x), bf_lo(b.y), bf_hi(b.y)}; r.v[3] = (f32x4){bf_lo(b.z), bf_hi(b.z), bf_lo(b.w), bf_hi(b.w)};
}
__device__ __forceinline__ void st_row_bf16(const Row16& r, bf16raw* p, int lane) {
    u32x4 a, b; a.x = cvt_pk(r.v[0][0], r.v[0][1]); a.y = cvt_pk(r.v[0][2], r.v[0][3]); a.z = cvt_pk(r.v[1][0], r.v[1][1]); a.w = cvt_pk(r.v[1][2], r.v[1][3]);
    b.x = cvt_pk(r.v[2][0], r.v[2][1]); b.y = cvt_pk(r.v[2][2], r.v[2][3]); b.z = cvt_pk(r.v[3][0], r.v[3][1]); b.w = cvt_pk(r.v[3][2], r.v[3][3]);
    *(u32x4*)(p + 8 * lane) = a; *(u32x4*)(p + 512 + 8 * lane) = b;
}
__device__ __forceinline__ float row_rstd(const Row16& r) {
    float s = 0.f;
#pragma unroll
    for (int j = 0; j < 4; ++j) s += (r.v[j][0] * r.v[j][0] + r.v[j][1] * r.v[j][1]) + (r.v[j][2] * r.v[j][2] + r.v[j][3] * r.v[j][3]);
    return 1.0f / sqrtf(wave_sum(s) * (1.0f / DM) + RMS_EPS);
}
struct RawPair { u32x4 r[8]; };
__device__ __forceinline__ void rp_load(RawPair& p, const bf16raw* MB, const bf16raw* U, int m0, int NGW, int lane) {
    const int m1 = m0 + NGW, m1c = m1 < MREG ? m1 : m0;
    p.r[0] = *(const u32x4*)(MB + (size_t)m0 * DM + 8 * lane); p.r[1] = *(const u32x4*)(MB + (size_t)m0 * DM + 512 + 8 * lane);
    p.r[2] = *(const u32x4*)(U + (size_t)m0 * DM + 8 * lane);  p.r[3] = *(const u32x4*)(U + (size_t)m0 * DM + 512 + 8 * lane);
    p.r[4] = *(const u32x4*)(MB + (size_t)m1c * DM + 8 * lane); p.r[5] = *(const u32x4*)(MB + (size_t)m1c * DM + 512 + 8 * lane);
    p.r[6] = *(const u32x4*)(U + (size_t)m1c * DM + 8 * lane);  p.r[7] = *(const u32x4*)(U + (size_t)m1c * DM + 512 + 8 * lane);
}
__device__ __forceinline__ void rp_unpack(Row16& r, const u32x4 a, const u32x4 b) {
    r.v[0] = (f32x4){bf_lo(a.x), bf_hi(a.x), bf_lo(a.y), bf_hi(a.y)}; r.v[1] = (f32x4){bf_lo(a.z), bf_hi(a.z), bf_lo(a.w), bf_hi(a.w)};
    r.v[2] = (f32x4){bf_lo(b.x), bf_hi(b.x), bf_lo(b.y), bf_hi(b.y)}; r.v[3] = (f32x4){bf_lo(b.z), bf_hi(b.z), bf_lo(b.w), bf_hi(b.w)};
}
__device__ __forceinline__ void rp_process(const RawPair& p, int mode, int m0, int NGW, bf16raw* U, float* RS, const Row16& gp, float* out, int lane) {
    const int m1 = m0 + NGW; const bool has1 = m1 < MREG;
    Row16 mv0, h0, mv1, h1;
    rp_unpack(mv0, p.r[0], p.r[1]); rp_unpack(h0, p.r[2], p.r[3]); rp_unpack(mv1, p.r[4], p.r[5]); rp_unpack(h1, p.r[6], p.r[7]);
    const float ra = row_rstd(mv0), rb = row_rstd(mv1);
#pragma unroll
    for (int j = 0; j < 4; ++j) { h0.v[j] = h0.v[j] + mv0.v[j] * ra * gp.v[j]; h1.v[j] = h1.v[j] + mv1.v[j] * rb * gp.v[j]; }
    if (mode == 2) {
        { const int b = m0 / LTOK, t = m0 - b * LTOK; if (t >= NMETA) st_row_f32(h0, out + ((size_t)b * SEQ + (t - NMETA)) * DM, lane); }
        if (has1) { const int b = m1 / LTOK, t = m1 - b * LTOK; if (t >= NMETA) st_row_f32(h1, out + ((size_t)b * SEQ + (t - NMETA)) * DM, lane); }
        return; }
    st_row_bf16(h0, U + (size_t)m0 * DM, lane);
    if (has1) st_row_bf16(h1, U + (size_t)m1 * DM, lane);
    const float r0 = row_rstd(h0), r1 = row_rstd(h1);
    if (lane == 0) { RS[m0] = r0; if (has1) RS[m1] = r1; }
}
__device__ __forceinline__ void resid_pass(int mode, const float* x, const float* meta, const bf16raw* MB, bf16raw* U, float* RS, bf16raw* OB, const float* g_post, float* out,
                                           int gw, int NGW, int lane, const float* tailp = nullptr) {
    Row16 gp;
    if (mode != 0) ld_row_f32(gp, g_post, lane);
    if (mode == 0) {
        for (int m0 = gw; m0 < MPAD; m0 += 2 * NGW) {
            const int m1 = m0 + NGW; const bool has1 = m1 < MPAD; const int m1c = has1 ? m1 : m0;
            const bool pad0 = m0 >= MTOK, pad1 = m1c >= MTOK;
            const int mm0 = pad0 ? 0 : m0, mm1 = pad1 ? 0 : m1c;
            const int b0 = mm0 / LTOK, t0 = mm0 - b0 * LTOK, b1 = mm1 / LTOK, t1 = mm1 - b1 * LTOK;
            Row16 h0, h1;
            ld_row_f32(h0, (t0 < NMETA) ? meta + (size_t)t0 * DM : x + ((size_t)b0 * SEQ + (t0 - NMETA)) * DM, lane);
            ld_row_f32(h1, (t1 < NMETA) ? meta + (size_t)t1 * DM : x + ((size_t)b1 * SEQ + (t1 - NMETA)) * DM, lane);
#pragma unroll
            for (int k = 0; k < 2; ++k) { const int m = k ? m1 : m0; const bool pad = k ? pad1 : pad0; if (k && !has1) break;
                const Row16& h = k ? h1 : h0;
                if (pad) {
                    const u32x4 z = (u32x4){0u, 0u, 0u, 0u};
                    *(u32x4*)(U + (size_t)m * DM + 8 * lane) = z; *(u32x4*)(U + (size_t)m * DM + 512 + 8 * lane) = z;
                    *(u32x4*)(OB + (size_t)m * DM + 8 * lane) = z; *(u32x4*)(OB + (size_t)m * DM + 512 + 8 * lane) = z;
                    if (lane == 0) RS[m] = 0.f;
                } else {
                    st_row_bf16(h, U + (size_t)m * DM, lane);
                    const float rs2 = row_rstd(h);
                    if (lane == 0) RS[m] = rs2; } }
        }
        return;
    }
    if (gw < MTOK - MREG) { const int m = MREG + gw; Row16 mv, t1, h;
        ld_row_f32(mv, tailp + (size_t)gw * DM, lane);
#pragma unroll
        for (int p = 1; p < TAIL_S; ++p) { ld_row_f32(t1, tailp + ((size_t)p * 128 + gw) * DM, lane);
#pragma unroll
            for (int j = 0; j < 4; ++j) mv.v[j] = mv.v[j] + t1.v[j]; }
        ld_row_bf16(h, U + (size_t)m * DM, lane);
        const float ra = row_rstd(mv);
#pragma unroll
        for (int j = 0; j < 4; ++j) h.v[j] = h.v[j] + mv.v[j] * ra * gp.v[j];
        if (mode == 2) { const int b = m / LTOK, t = m - b * LTOK; if (t >= NMETA) st_row_f32(h, out + ((size_t)b * SEQ + (t - NMETA)) * DM, lane); }
        else { st_row_bf16(h, U + (size_t)m * DM, lane); const float r2 = row_rstd(h); if (lane == 0) RS[m] = r2; }
    }
    RawPair A, B; const int S = 2 * NGW; int m0 = gw;
    if (m0 < MREG) rp_load(A, MB, U, m0, NGW, lane);
    while (m0 < MREG) {
        if (m0 + S < MREG) rp_load(B, MB, U, m0 + S, NGW, lane);
        rp_process(A, mode, m0, NGW, U, RS, gp, out, lane);
        m0 += S; if (m0 >= MREG) break;
        if (m0 + S < MREG) rp_load(A, MB, U, m0 + S, NGW, lane);
        rp_process(B, mode, m0, NGW, U, RS, gp, out, lane);
        m0 += S;
    }
}

__device__ __forceinline__ void rope_pass(bf16raw* QKV, const float* qg, const float* kg, const f32x2* tab, int gw, int NGW, int lane) {
    const int hsel = lane >> 5, within = lane & 31, axis = within >> 4, s16 = within & 15, d1 = axis * 64 + 2 * s16, d2 = d1 + 32;
    const f32x2 gq1 = *(const f32x2*)(qg + d1), gq2 = *(const f32x2*)(qg + d2), gk1 = *(const f32x2*)(kg + d1), gk2 = *(const f32x2*)(kg + d2);
    for (int m = gw; m < MTOK; m += NGW) {
        const int b = m / LTOK, t = m - b * LTOK;
        f32x2 cs0 = (f32x2){1.f, 0.f}, cs1 = (f32x2){1.f, 0.f};
        if (t >= NMETA) { const int s = t - NMETA, pos = axis ? (s & 63) : (s >> 6); cs0 = tab[pos * 32 + 2 * s16]; cs1 = tab[pos * 32 + 2 * s16 + 1]; }
        bf16raw* rowp = QKV + (size_t)m * QKVD;
        unsigned w1[5], w2[5];
#pragma unroll
        for (int st = 0; st < 5; ++st) { const int hd = 2 * st + hsel; w1[st] = *(const unsigned*)(rowp + hd * 128 + d1); w2[st] = *(const unsigned*)(rowp + hd * 128 + d2); }
#pragma unroll
        for (int st = 0; st < 5; ++st) { const int hd = 2 * st + hsel;
            const float x1a = bf_lo(w1[st]), x1b = bf_hi(w1[st]), x2a = bf_lo(w2[st]), x2b = bf_hi(w2[st]);
            float ss = (x1a * x1a + x1b * x1b) + (x2a * x2a + x2b * x2b);
            ss += __shfl_xor(ss, 1); ss += __shfl_xor(ss, 2); ss += __shfl_xor(ss, 4); ss += __shfl_xor(ss, 8); ss += __shfl_xor(ss, 16);
            const float rs = 1.0f / sqrtf(ss * (1.0f / 128.0f) + RMS_EPS);
            const bool isq = (st < 4);
            const f32x2 g1 = isq ? gq1 : gk1, g2 = isq ? gq2 : gk2;
            const float n1a = x1a * rs * g1.x, n1b = x1b * rs * g1.y, n2a = x2a * rs * g2.x, n2b = x2b * rs * g2.y;
            const float o1a = n1a * cs0.x - n2a * cs0.y, o2a = n2a * cs0.x + n1a * cs0.y;
            const float o1b = n1b * cs1.x - n2b * cs1.y, o2b = n2b * cs1.x + n1b * cs1.y;
            *(unsigned*)(rowp + hd * 128 + d1) = cvt_pk(o1a, o1b); *(unsigned*)(rowp + hd * 128 + d2) = cvt_pk(o2a, o2b); }
    }
}

constexpr int L_XCF = 0, L_XCB = 24576, L_CC = 37632, L_AB = 40960, AB_RS = 132, AB_PL = LT * AB_RS;
static_assert(L_AB + 2 * AB_PL * 4 <= LDS_MISC && L_CC + 5 * 128 * 4 <= L_AB, "LRU LDS");
struct LruW { bf16x8 f[2][2][4]; };
struct LruC { float br[2], bi[2], k8[2]; };
__device__ __forceinline__ void lru_load_w(LruW& w, LruC& cc, const bf16raw* Wg, const float* gate_b, const float* lam, int slot, int n, int wid, int lane) {
    const int dir = wid >> 2, cq = wid & 3, fr = lane & 15, fq = lane >> 4;
#pragma unroll
    for (int g = 0; g < 2; ++g)
#pragma unroll
        for (int nt = 0; nt < 2; ++nt)
#pragma unroll
            for (int ks = 0; ks < 4; ++ks)
                w.f[g][nt][ks] = *(const bf16x8*)(Wg + ((size_t)((((slot * 2 + dir) * 2 + g) * 8 + n) * 128 + cq * 32 + nt * 16 + fr)) * 128 + ks * 32 + fq * 8);
#pragma unroll
    for (int nt = 0; nt < 2; ++nt) { const int gch = n * 128 + cq * 32 + nt * 16 + fr;
        cc.br[nt] = gate_b[((size_t)(slot * 2 + dir) * 2 + 0) * DM + gch]; cc.bi[nt] = gate_b[((size_t)(slot * 2 + dir) * 2 + 1) * DM + gch];
        const float lm = lam[(size_t)(slot * 2 + dir) * DM + gch];
        const float sp = (lm > 15.f) ? __expf(-lm) : log1pf(__expf(-lm));
        cc.k8[nt] = -8.0f * sp * 1.4426950408889634f; }
}
struct LruX { u32x4 r[5]; };
__device__ __forceinline__ void lru_fetch_x(LruX& xr, const bf16raw* X, int b, int c, int n, int tid) {
    const int cgp = tid & 15, pr = tid >> 4;
    if (pr < 24) {
#pragma unroll
        for (int k = 0; k < 5; ++k) { const int tt = c * LT + 2 * pr - 2 + k;
            xr.r[k] = (tt >= 0 && tt < LTOK) ? *(const u32x4*)(X + ((size_t)b * LTOK + tt) * DM + n * 128 + cgp * 8) : (u32x4){0u, 0u, 0u, 0u}; } }
}
template <bool FINAL, bool REV>
__device__ __forceinline__ void lru_scan(const f32x4 (&acc)[3][2][2], LAS float* HF, f32x2* SUMS, size_t sbase, float hin0, float hin1, int cq, int fr, int fq, int lane) {
    const int rank = REV ? 3 - fq : fq;
    const int src1 = (REV ? lane + 16 : lane - 16) & 63, src2 = (REV ? lane + 32 : lane - 32) & 63, srcT = REV ? fr : fr + 48;
#pragma unroll
    for (int nt = 0; nt < 2; ++nt) {
        float Pe[3], Qe[3], Pt[3], Qt[3];
#pragma unroll
        for (int mt = 0; mt < 3; ++mt) { float p = 1.f, q = 0.f;
#pragma unroll
            for (int ii = 0; ii < 4; ++ii) { const int i = REV ? 3 - ii : ii; const float a = acc[mt][0][nt][i]; q = a * q + acc[mt][1][nt][i]; p *= a; }
            { const float pp = __shfl(p, src1), qp = __shfl(q, src1); if (rank >= 1) { q = qp * p + q; p = pp * p; } }
            { const float pp = __shfl(p, src2), qp = __shfl(q, src2); if (rank >= 2) { q = qp * p + q; p = pp * p; } }
            Pt[mt] = __shfl(p, srcT); Qt[mt] = __shfl(q, srcT);
            if (FINAL) { const float pe = __shfl(p, src1), qe = __shfl(q, src1); Pe[mt] = rank >= 1 ? pe : 1.f; Qe[mt] = rank >= 1 ? qe : 0.f; } }
        if (!FINAL) { float A = 1.f, Bv = 0.f;
#pragma unroll
            for (int mm = 0; mm < 3; ++mm) { const int mt = REV ? 2 - mm : mm; Bv = Bv * Pt[mt] + Qt[mt]; A *= Pt[mt]; }
            if (fq == 0) SUMS[sbase + 16 * nt] = (f32x2){A, Bv};
        } else { float hseg = nt ? hin1 : hin0; const int ch = cq * 32 + nt * 16 + fr;
#pragma unroll
            for (int mm = 0; mm < 3; ++mm) { const int mt = REV ? 2 - mm : mm;
                float h = Pe[mt] * hseg + Qe[mt];
#pragma unroll
                for (int ii = 0; ii < 4; ++ii) { const int i = REV ? 3 - ii : ii; h = acc[mt][0][nt][i] * h + acc[mt][1][nt][i];
                    HF[(REV ? AB_PL : 0) + (mt * 16 + fq * 4 + i) * AB_RS + ch] = h; }
                hseg = Pt[mt] * hseg + Qt[mt]; } }
    }
}
#define LDS_BAR() do { asm volatile("s_waitcnt lgkmcnt(0)" ::: "memory"); __builtin_amdgcn_s_barrier(); asm volatile("" ::: "memory"); } while (0)
template <bool FINAL>
__device__ __forceinline__ void lru_pass(LAS unsigned char* lds, int slot, const bf16raw* Wg, const bf16raw* X, bf16raw* Y, const float* conv_w, const float* conv_b,
                                         const float* gate_b, const float* lam, f32x2* SUMS, const float* CARRY, int G, int bid, int tid0, int wid, int lane0) {
    constexpr int NTILES = 8 * NB * NCHUNK, PERN = NB * NCHUNK;
    const int lo = (int)(((long)bid * NTILES) / G), hi = (int)(((long)(bid + 1) * NTILES) / G);
    LAS float* XCF = (LAS float*)(lds + L_XCF); LAS unsigned char* XCB = lds + L_XCB; LAS float* CC = (LAS float*)(lds + L_CC); LAS float* HF = (LAS float*)(lds + L_AB);
    const int dir = wid >> 2, cq = wid & 3;
    LruW w; LruC cc; LruX xr; int curn = -1;
    if (lo < hi) { const int n = lo / PERN, rem = lo - n * PERN, b = rem / NCHUNK, c = rem - b * NCHUNK; lru_fetch_x(xr, X, b, c, n, tid0); }
    for (int tau = lo; tau < hi; ++tau) { const int n = tau / PERN, rem = tau - n * PERN, b = rem / NCHUNK, c = rem - b * NCHUNK;
        const size_t row0 = (size_t)b * LTOK + c * LT;
        int tid = tid0; asm volatile("" : "+v"(tid));
        const int lane = tid & 63, fr = lane & 15, fq = lane >> 4, cgp = tid & 15, pr = tid >> 4;
        if (n != curn) { lru_load_w(w, cc, Wg, gate_b, lam, slot, n, wid, lane); curn = n;
            for (int i = tid; i < 5 * 128; i += NTHREADS) CC[i] = (i < 512) ? conv_w[(size_t)slot * 4 * DM + (i >> 7) * DM + n * 128 + (i & 127)] : conv_b[(size_t)slot * DM + n * 128 + (i & 127)];
            __syncthreads(); }
        const size_t sbase = ((size_t)(b * NCHUNK + c) * 2 + dir) * DM + n * 128 + cq * 32 + fr;
        float hin0 = 0.f, hin1 = 0.f;
        if (FINAL) { hin0 = CARRY[sbase]; hin1 = CARRY[sbase + 16]; }
        if (pr < 24) {
            f32x4 xa[5], xb[5];
#pragma unroll
            for (int k = 0; k < 5; ++k) { const u32x4 v = xr.r[k]; xa[k] = (f32x4){bf_lo(v.x), bf_hi(v.x), bf_lo(v.y), bf_hi(v.y)}; xb[k] = (f32x4){bf_lo(v.z), bf_hi(v.z), bf_lo(v.w), bf_hi(v.w)}; }
#pragma unroll
            for (int j = 0; j < 2; ++j) { f32x4 a0 = *(const LAS f32x4*)(CC + 512 + cgp * 8), a1 = *(const LAS f32x4*)(CC + 512 + cgp * 8 + 4);
#pragma unroll
                for (int k = 0; k < 4; ++k) { a0 += *(const LAS f32x4*)(CC + k * 128 + cgp * 8) * xa[j + k]; a1 += *(const LAS f32x4*)(CC + k * 128 + cgp * 8 + 4) * xb[j + k]; }
                const int t = 2 * pr + j;
                *(LAS f32x4*)(XCF + t * 128 + cgp * 8) = a0; *(LAS f32x4*)(XCF + t * 128 + cgp * 8 + 4) = a1;
                u32x4 pk; pk.x = cvt_pk(a0[0], a0[1]); pk.y = cvt_pk(a0[2], a0[3]); pk.z = cvt_pk(a1[0], a1[1]); pk.w = cvt_pk(a1[2], a1[3]);
                *(LAS u32x4*)(XCB + t * 272 + cgp * 16) = pk; }
        }
        if (tau + 1 < hi) { const int t2 = tau + 1, n2 = t2 / PERN, rem2 = t2 - n2 * PERN, b2 = rem2 / NCHUNK, c2 = rem2 - b2 * NCHUNK; lru_fetch_x(xr, X, b2, c2, n2, tid); }
        LDS_BAR();
        f32x4 acc[3][2][2];
#pragma unroll
        for (int mt = 0; mt < 3; ++mt)
#pragma unroll
            for (int g = 0; g < 2; ++g)
#pragma unroll
                for (int nt = 0; nt < 2; ++nt) acc[mt][g][nt] = (f32x4){0.f, 0.f, 0.f, 0.f};
#pragma unroll
        for (int ks = 0; ks < 4; ++ks) {
#pragma unroll
            for (int mt = 0; mt < 3; ++mt) { const bf16x8 af = *(const LAS bf16x8*)(XCB + (mt * 16 + fr) * 272 + (ks * 32 + fq * 8) * 2);
#pragma unroll
                for (int g = 0; g < 2; ++g)
#pragma unroll
                    for (int nt = 0; nt < 2; ++nt) acc[mt][g][nt] = __builtin_amdgcn_mfma_f32_16x16x32_bf16(af, w.f[g][nt][ks], acc[mt][g][nt], 0, 0, 0); } }
#pragma unroll
        for (int nt = 0; nt < 2; ++nt) { const int ch = cq * 32 + nt * 16 + fr;
            const float nbr = -1.4426950408889634f * cc.br[nt], nbi = -1.4426950408889634f * cc.bi[nt], k8 = cc.k8[nt];
#pragma unroll
            for (int mt = 0; mt < 3; ++mt)
#pragma unroll
                for (int ip = 0; ip < 4; ip += 2) { const int tk = mt * 16 + fq * 4 + ip;
                    const f32x2 xr2 = (f32x2){acc[mt][0][nt][ip], acc[mt][0][nt][ip + 1]}, xi2 = (f32x2){acc[mt][1][nt][ip], acc[mt][1][nt][ip + 1]};
                    const f32x2 tr = xr2 * (-1.4426950408889634f) + nbr, ti = xi2 * (-1.4426950408889634f) + nbi;
                    f32x2 er, ei; er.x = __builtin_amdgcn_exp2f(tr.x); er.y = __builtin_amdgcn_exp2f(tr.y); ei.x = __builtin_amdgcn_exp2f(ti.x); ei.y = __builtin_amdgcn_exp2f(ti.y);
                    er = er + 1.0f; ei = ei + 1.0f;
                    f32x2 r, ig; r.x = __builtin_amdgcn_rcpf(er.x); r.y = __builtin_amdgcn_rcpf(er.y); ig.x = __builtin_amdgcn_rcpf(ei.x); ig.y = __builtin_amdgcn_rcpf(ei.y);
                    const f32x2 la = r * k8;
                    f32x2 a; a.x = __builtin_amdgcn_exp2f(la.x); a.y = __builtin_amdgcn_exp2f(la.y);
                    const f32x2 y = 1.0f - a * a;
                    f32x2 sq; sq.x = __builtin_amdgcn_sqrtf(y.x); sq.y = __builtin_amdgcn_sqrtf(y.y);
                    const f32x2 xc2 = (f32x2){XCF[tk * 128 + ch], XCF[(tk + 1) * 128 + ch]};
                    const f32x2 bb = sq * ig * xc2;
                    acc[mt][0][nt][ip] = a.x; acc[mt][0][nt][ip + 1] = a.y; acc[mt][1][nt][ip] = bb.x; acc[mt][1][nt][ip + 1] = bb.y; } }
        if (dir) lru_scan<FINAL, true>(acc, HF, SUMS, sbase, hin0, hin1, cq, fr, fq, lane);
        else     lru_scan<FINAL, false>(acc, HF, SUMS, sbase, hin0, hin1, cq, fr, fq, lane);
        if (FINAL) {
            const u32x4 yv0 = (pr < 24) ? *(const u32x4*)(Y + (row0 + 2 * pr) * DM + n * 128 + cgp * 8) : (u32x4){0u, 0u, 0u, 0u};
            const u32x4 yv1 = (pr < 24) ? *(const u32x4*)(Y + (row0 + 2 * pr + 1) * DM + n * 128 + cgp * 8) : (u32x4){0u, 0u, 0u, 0u};
            LDS_BAR();
            if (pr < 24) {
#pragma unroll
                for (int j = 0; j < 2; ++j) { const int t = 2 * pr + j; const u32x4 yv = j ? yv1 : yv0;
                    const LAS float* hf = HF + t * AB_RS + cgp * 8; const LAS float* hb = HF + AB_PL + t * AB_RS + cgp * 8;
                    const f32x4 f0 = *(const LAS f32x4*)hf, f1 = *(const LAS f32x4*)(hf + 4), b0 = *(const LAS f32x4*)hb, b1 = *(const LAS f32x4*)(hb + 4);
                    const f32x4 z0 = (f0 + b0) * (f32x4){bf_lo(yv.x), bf_hi(yv.x), bf_lo(yv.y), bf_hi(yv.y)}, z1 = (f1 + b1) * (f32x4){bf_lo(yv.z), bf_hi(yv.z), bf_lo(yv.w), bf_hi(yv.w)};
                    u32x4 o; o.x = cvt_pk(z0[0], z0[1]); o.y = cvt_pk(z0[2], z0[3]); o.z = cvt_pk(z1[0], z1[1]); o.w = cvt_pk(z1[2], z1[3]);
                    *(u32x4*)(Y + (row0 + t) * DM + n * 128 + cgp * 8) = o; } }
        }
        LDS_BAR();
    }
}
__device__ __forceinline__ void lru_carry(LAS unsigned char* lds, const f32x2* SUMS, float* CARRY, int G, int bid, int wid, int lane) {
    LAS f32x2* XS = (LAS f32x2*)lds;
    for (int cb = bid; cb < NB * 2 * (DM / 64); cb += G) { const int bd = cb >> 4, b = bd >> 1, sd = bd & 1, gch = (cb & 15) * 64 + lane;
        const int q0 = wid * 21 + (wid < 3 ? wid : 3), qn = 21 + (wid < 3 ? 1 : 0);
        f32x2 ab[22]; float P = 1.f, Q = 0.f;
#pragma unroll
        for (int i = 0; i < 22; ++i) { const int q = q0 + i, c = sd ? (NCHUNK - 1 - q) : q;
            ab[i] = (i < qn) ? SUMS[((size_t)(b * NCHUNK + c) * 2 + sd) * DM + gch] : (f32x2){1.f, 0.f}; }
#pragma unroll
        for (int i = 0; i < 22; ++i) { Q = ab[i].x * Q + ab[i].y; P *= ab[i].x; }
        XS[wid * 64 + lane] = (f32x2){P, Q};
        __syncthreads();
        float h = 0.f;
        for (int s2 = 0; s2 < wid; ++s2) { const f32x2 t = XS[s2 * 64 + lane]; h = t.x * h + t.y; }
#pragma unroll
        for (int i = 0; i < 22; ++i) { const int q = q0 + i, c = sd ? (NCHUNK - 1 - q) : q;
            if (i < qn) CARRY[((size_t)(b * NCHUNK + c) * 2 + sd) * DM + gch] = h;
            h = ab[i].x * h + ab[i].y; }
        __syncthreads();
    }
}

typedef unsigned v4u __attribute__((ext_vector_type(4)));
#define XB_TMO      128
#define XB_XCNT(j)  (256  + 64 * (j))
#define XB_XSUB(j)  (1280 + 64 * (j))
#define XB_XGEN(j)  (2304 + 64 * (j))
#define XB_TOP      3328
#define XB_TOPGEN   3392
#define XCD_BAR_WORDS 3456
#define XB_SPIN_CAP (1u << 18)

__device__ __forceinline__ unsigned xb_ld(unsigned* p)              { return __hip_atomic_load(p, __ATOMIC_RELAXED, __HIP_MEMORY_SCOPE_AGENT); }
__device__ __forceinline__ unsigned xb_add(unsigned* p, unsigned v) { return __hip_atomic_fetch_add(p, v, __ATOMIC_RELAXED, __HIP_MEMORY_SCOPE_AGENT); }
__device__ __forceinline__ unsigned xb_xcc_id() { return (unsigned)__builtin_amdgcn_s_getreg((3 << 11) | 20) & 0xFu; }
#define XB_SPIN(cond, bar) do { unsigned _sp = 0; while (cond) { __builtin_amdgcn_s_sleep(1); \
    if ((++_sp & 255u) == 0u) { if (xb_ld(&(bar)[XB_TMO])) break; if (_sp > XB_SPIN_CAP) { atomicAdd(&(bar)[XB_TMO], 1u); break; } } } } while (0)

struct XcdBarrier {
    unsigned* bar; unsigned x;
    volatile LAS unsigned* st;
};

__device__ __forceinline__ XcdBarrier xcd_barrier_post(unsigned* bar, volatile LAS unsigned* st) {
    XcdBarrier b; b.bar = bar; b.x = xb_xcc_id(); b.st = st;
    if (threadIdx.x == 0) (void)xb_add(&bar[XB_XCNT(b.x)], 1u);
    return b;
}
__device__ __forceinline__ void xcd_barrier_complete(unsigned* bar, unsigned x, unsigned& nloc, unsigned& nx) {
    const unsigned G = gridDim.x * gridDim.y * gridDim.z;
    unsigned sum, cnt, mine, sp = 0u;
    for (;;) {
        sum = 0u; cnt = 0u; mine = 0u;
#pragma unroll
        for (unsigned j = 0; j < 16; ++j) { const unsigned c = xb_ld(&bar[XB_XCNT(j)]); sum += c; cnt += (c > 0u) ? 1u : 0u; mine = (j == x) ? c : mine; }
        if (sum == G) break;
        __builtin_amdgcn_s_sleep(1);
        if ((++sp & 255u) == 0u) { if (xb_ld(&bar[XB_TMO])) break; if (sp > XB_SPIN_CAP) { atomicAdd(&bar[XB_TMO], 1u); break; } }
    }
    nloc = mine > 0u ? mine : 1u; nx = cnt > 0u ? cnt : 1u;
}

__device__ __forceinline__ void xcd_barrier(const XcdBarrier& b) {
    asm volatile("s_waitcnt vmcnt(0)" ::: "memory");
    __syncthreads();
    if (threadIdx.x == 0) {
        unsigned* bar = b.bar;
        __builtin_amdgcn_s_waitcnt(0);
        unsigned nloc = b.st[0], nx = b.st[1];
        if (nloc == 0u) { xcd_barrier_complete(bar, b.x, nloc, nx); b.st[0] = nloc; b.st[1] = nx; }
        const unsigned old = xb_add(&bar[XB_XSUB(b.x)], 1u);
        const unsigned gen = old / nloc;
        if (old + 1u == (gen + 1u) * nloc) {
            __builtin_amdgcn_fence(__ATOMIC_RELEASE, "agent");
            asm volatile("s_waitcnt vmcnt(0)" ::: "memory");
            const unsigned og = xb_add(&bar[XB_TOP], 1u);
            const unsigned tg = og / nx;
            if (og + 1u == (tg + 1u) * nx) xb_add(&bar[XB_TOPGEN], 1u);
            else XB_SPIN(xb_ld(&bar[XB_TOPGEN]) == tg, bar);
            __builtin_amdgcn_fence(__ATOMIC_ACQUIRE, "agent");
            xb_add(&bar[XB_XGEN(b.x)], 1u);
            asm volatile("s_waitcnt vmcnt(0)" ::: "memory");
        } else {
            XB_SPIN(xb_ld(&bar[XB_XGEN(b.x)]) == gen, bar);
            __builtin_amdgcn_fence(__ATOMIC_ACQUIRE, "agent");
            asm volatile("s_waitcnt vmcnt(0)" ::: "memory");
        }
    }
    __syncthreads();
}

#define LAUNDER(p) asm volatile("" : "+s"(p))
struct Args { const float* in[16]; float* out; unsigned char* ws; };
#ifdef NO_GEMM
#define GEMM_RUN(EPI, Aptr, Bptr, Nn, Kk, Eobj) do { } while (0)
#define GEMM_RUN_T(EPI, Aptr, Bptr, Nn, Kk, Eobj, TAIL) do { } while (0)
#define GEMM_RUN_S(EPI, Aptr, Bptr, Nn, Kk, Eobj, TAIL, SPL) do { } while (0)
#else
#define GEMM_RUN(EPI, Aptr, Bptr, Nn, Kk, Eobj) GEMM_RUN_S(EPI, Aptr, Bptr, Nn, Kk, Eobj, true, 1)
#define GEMM_RUN_T(EPI, Aptr, Bptr, Nn, Kk, Eobj, TAIL) GEMM_RUN_S(EPI, Aptr, Bptr, Nn, Kk, Eobj, TAIL, 1)
#define GEMM_RUN_S(EPI, Aptr, Bptr, Nn, Kk, Eobj, TAIL, SPL) do { pg8::Gemm g_{(const pg8::bf16_t*)(Aptr), (const pg8::bf16_t*)(Bptr), MPAD, (Nn), (Kk)}; int bid_ = blockIdx.x; asm volatile("" : "+s"(bid_)); int G_ = gridDim.x; asm volatile("" : "+s"(G_)); pg8::StaticOrder S_; S_.init(MPAD, (Nn), (Kk), G_, bid_, (TAIL), (SPL)); \
    pg8::gemm_phase<EPI, pg8::StaticOrder, EPI::ALIGN, true>((PG8_LAS unsigned char*)lds, g_, S_, (Eobj)); } while (0)
#endif

__global__ void __launch_bounds__(NTHREADS, 2) mega_fwd(Args args) {
    extern __shared__ __attribute__((aligned(16))) unsigned char lds[];
    cg::grid_group grid = cg::this_grid();
#define FRESH() int tid = threadIdx.x; asm volatile("" : "+v"(tid)); int bid = blockIdx.x; asm volatile("" : "+s"(bid)); int G = gridDim.x; asm volatile("" : "+s"(G)); const int NGW = G * 8; \
    const int lane = tid & 63, wid = __builtin_amdgcn_readfirstlane(tid >> 6), gw = bid * 8 + wid; (void)lane; (void)gw; (void)NGW
    unsigned char* ws = args.ws;
    const float* x = args.in[0]; const float* meta = args.in[1]; const float* gains = args.in[2];
    bf16raw* OB0 = (bf16raw*)(ws + WS_H); float* RS0 = (float*)(ws + WS_H + (size_t)MPAD * DM * 2); bf16raw* U0 = (bf16raw*)(ws + WS_U);
    bf16raw* BIG0 = (bf16raw*)(ws + WS_BIG); bf16raw* MB0 = (bf16raw*)(ws + WS_MB);
    bf16raw* Wb0 = (bf16raw*)(ws + WS_W); f32x2* SUMS = (f32x2*)(ws + WS_SUM); float* CARRY = (float*)(ws + WS_CARRY); f32x2* ROPE = (f32x2*)(ws + WS_ROPE);

    {
        FRESH();
        LAS float* scr = (LAS float*)((LAS unsigned char*)lds + wid * 16384);
        bf16raw* OB = OB0; float* RS = RS0; bf16raw* U = U0; bf16raw* Wb = Wb0;
        convert_group(args.in[3], 1024, 2048, 2, Wb + WO_LRU_IN, 0, gains, 8 * DM, scr, gw, NGW, lane);
        convert_group(args.in[9], 1024, 1024, 2, Wb + WO_LRU_OUT, 0, nullptr, 0, scr, gw, NGW, lane);
        convert_group(args.in[6], 128, 128, 64, Wb + WO_GATE, 0, nullptr, 0, scr, gw, NGW, lane);
        convert_group(args.in[10], 1024, 1536, 2, Wb + WO_QKV, 2, gains + 4 * DM, 8 * DM, scr, gw, NGW, lane);
        convert_group(args.in[13], 1024, 1024, 2, Wb + WO_AO, 0, nullptr, 0, scr, gw, NGW, lane);
        convert_group(args.in[14], 1024, 5632, 4, Wb + WO_F1, 1, gains + 2 * DM, 4 * DM, scr, gw, NGW, lane);
        convert_group(args.in[15], 2816, 1024, 4, Wb + WO_F2, 0, nullptr, 0, scr, gw, NGW, lane);
        for (int i = bid * NTHREADS + tid; i < 128 * 32; i += G * NTHREADS) { const int pos = i >> 5, p = i & 31;
            const float inv_freq = (float)exp(-(double)p * (9.210340371976184 / 32.0));
            const float ang = (float)pos * inv_freq;
            double rev = (double)ang * 0.15915494309189535; rev -= floor(rev);
            ROPE[i] = (f32x2){__builtin_amdgcn_cosf((float)rev), __builtin_amdgcn_sinf((float)rev)}; }
        resid_pass(0, x, meta, nullptr, U, RS, OB, nullptr, nullptr, gw, NGW, lane);
        if (bid == 0) for (int i = tid; i < 4096; i += NTHREADS) ((unsigned*)(ws + WS_CTL))[i] = 0u;
        if (tid < 2) ((volatile LAS unsigned*)((LAS unsigned char*)lds + LDS_MISC))[tid] = 0u;
    }
    grid.sync();
    const XcdBarrier xbar = xcd_barrier_post((unsigned*)(ws + WS_CTL), (volatile LAS unsigned*)((LAS unsigned char*)lds + LDS_MISC));
#define GSYNC() xcd_barrier(xbar)

    for (int layer = 0; layer < 4; ++layer) {
        const int slot = layer >> 1; const float* gl = gains + (size_t)layer * 4 * DM;
        size_t zl = 0; asm volatile("" : "+s"(zl));
        float* TAILP = (float*)(ws + WS_TAILP) + zl;
        bf16raw* OB = OB0 + zl; float* RS = RS0 + zl; bf16raw* U = U0 + zl; bf16raw* BIG = BIG0 + zl; bf16raw* MB = MB0 + zl; bf16raw* Wb = Wb0 + zl; bf16raw* Yb = BIG; bf16raw* Xb = BIG + (size_t)MPAD * DM;
        if ((layer & 1) == 0) {
            { EpiLruIn E{Yb, Xb, RS}; GEMM_RUN(EpiLruIn, U, Wb + WO_LRU_IN + (size_t)slot * 2048 * 1024, 2048, 1024, E); }
            GSYNC();
#ifndef NO_LRU
            { FRESH(); lru_pass<false>((LAS unsigned char*)lds, slot, Wb + WO_GATE, Xb, Yb, args.in[4], args.in[5], args.in[7], args.in[8], SUMS, CARRY, G, bid, tid, wid, lane); }
            GSYNC();
            { FRESH(); lru_carry((LAS unsigned char*)lds, SUMS, CARRY, G, bid, wid, lane); }
            GSYNC();
            { FRESH(); lru_pass<true>((LAS unsigned char*)lds, slot, Wb + WO_GATE, Xb, Yb, args.in[4], args.in[5], args.in[7], args.in[8], SUMS, CARRY, G, bid, tid, wid, lane); }
#endif
            GSYNC();
        } else {
            { EpiQkv E{BIG, RS, args.in[11] + slot * 128, args.in[12] + slot * 128, ROPE, (LAS float*)((LAS unsigned char*)lds + 131072)}; GEMM_RUN(EpiQkv, U, Wb + WO_QKV + (size_t)slot * 1536 * 1024, 1536, 1024, E); }
            GSYNC();
#ifndef NO_ATT
            { int bid = blockIdx.x; asm volatile("" : "+s"(bid)); int G = gridDim.x; asm volatile("" : "+s"(G));
              int tq = threadIdx.x; asm volatile("" : "+v"(tq));
#define ATT_IDS() int tq_ = threadIdx.x; asm volatile("" : "+v"(tq_)); const int qw = tq_ >> 6, qr32 = tq_ & 31, qhi = (tq_ >> 5) & 1
              bool fixed_ok;
              { const float* qg_ = args.in[11] + slot * 128; const float* kg_ = args.in[12] + slot * 128; const int l_ = tq & 63;
                float bq = fmaxf(fabsf(qg_[l_]), fabsf(qg_[l_ + 64])), bk = fmaxf(fabsf(kg_[l_]), fabsf(kg_[l_ + 64]));
#pragma unroll
                for (int o_ = 1; o_ < 64; o_ <<= 1) { bq = fmaxf(bq, __shfl_xor(bq, o_)); bk = fmaxf(bk, __shfl_xor(bk, o_)); }
                const float bound = 0.088388347648318440f * 1.4426950408889634f * 128.0f * bq * bk * 1.02f;
                fixed_ok = __builtin_amdgcn_readfirstlane((int)(bound <= 60.0f)) != 0; }
              float* PART = (float*)(ws + WS_SUM) + zl;
              if (layer < 3)   for (int it = bid; it < 16 * 43; it += G) { const int bk = it / 43, s = it - bk * 43, b = bk >> 1, kvh = bk & 1; const size_t rb = (size_t)b * LTOK;
                  ATT_IDS(); const int Rm = (qw * 32 + qr32) & 63, g4 = Rm >> 4, jm = Rm & 15;
                  if (fixed_ok) att::attn_unit<true, true>((const att::bf16*)(BIG + (rb + jm) * QKVD + (kvh * 4 + g4) * 128 + qhi * 8), (const att::bf16*)(BIG + (rb + 192 * s) * QKVD + 1024 + kvh * 128),
                                       (const att::bf16*)(BIG + (rb + 192 * s) * QKVD + 1280 + kvh * 128), nullptr, 3, s == 42, PART + (size_t)it * 8320, (char*)lds);
                  else att::attn_unit<true, false>((const att::bf16*)(BIG + (rb + jm) * QKVD + (kvh * 4 + g4) * 128 + qhi * 8), (const att::bf16*)(BIG + (rb + 192 * s) * QKVD + 1024 + kvh * 128),
                                       (const att::bf16*)(BIG + (rb + 192 * s) * QKVD + 1280 + kvh * 128), nullptr, 3, s == 42, PART + (size_t)it * 8320, (char*)lds); }
              for (int u = bid; u < NB * 8 * 32; u += G) { const int h = u & 7, kvh = h >> 2, qb = (u >> 3) & 31, b = u >> 8;
                  ATT_IDS(); const size_t rb = (size_t)b * LTOK, q0 = rb + NMETA + 256 * qb;
                  const int u2 = (u + G < NB * 8 * 32) ? u + G : u, h2 = u2 & 7, kvh2 = h2 >> 2; const size_t rb2 = (size_t)(u2 >> 8) * LTOK, q02 = rb2 + NMETA + 256 * ((u2 >> 3) & 31);
                  if (fixed_ok) att::attn_unit<false, true>((const att::bf16*)(BIG + (q0 + qw * 32 + qr32) * QKVD + h * 128 + qhi * 8), (const att::bf16*)(BIG + rb * QKVD + 1024 + kvh * 128),
                                        (const att::bf16*)(BIG + rb * QKVD + 1280 + kvh * 128), (att::bf16*)(OB + q0 * DM + h * 128), 129, true, nullptr, (char*)lds,
                                        (const att::bf16*)(BIG + q02 * QKVD + h2 * 128), (const att::bf16*)(BIG + rb2 * QKVD + 1024 + kvh2 * 128), (const att::bf16*)(BIG + rb2 * QKVD + 1280 + kvh2 * 128));
                  else att::attn_unit<false, false>((const att::bf16*)(BIG + (q0 + qw * 32 + qr32) * QKVD + h * 128 + qhi * 8), (const att::bf16*)(BIG + rb * QKVD + 1024 + kvh * 128),
                                        (const att::bf16*)(BIG + rb * QKVD + 1280 + kvh * 128), (att::bf16*)(OB + q0 * DM + h * 128), 129, true, nullptr, (char*)lds,
                                        (const att::bf16*)(BIG + q02 * QKVD + h2 * 128), (const att::bf16*)(BIG + rb2 * QKVD + 1024 + kvh2 * 128), (const att::bf16*)(BIG + rb2 * QKVD + 1280 + kvh2 * 128)); } }
            if (layer < 3) { GSYNC();
            { FRESH(); const float* PART = (const float*)(ws + WS_SUM) + zl; constexpr float C = 1.0f;
              for (int gt = bid * NTHREADS + tid; gt < 16 * 64 * 128; gt += G * NTHREADS) { const int bk = gt >> 13, R = (gt >> 7) & 63, d = gt & 127, b = bk >> 1, kvh = bk & 1;
                  const float* pb = PART + (size_t)bk * 43 * 8320;
                  float M = -3.0e38f;
                  for (int s = 0; s < 43; ++s) M = fmaxf(M, pb[(size_t)s * 8320 + 8192 + R * 2]);
                  float L = 0.f, O = 0.f;
                  for (int s = 0; s < 43; ++s) { const float w = __builtin_amdgcn_exp2f((pb[(size_t)s * 8320 + 8192 + R * 2] - M) * C);
                      L += w * pb[(size_t)s * 8320 + 8192 + R * 2 + 1]; O += w * pb[(size_t)s * 8320 + R * 128 + d]; }
                  const float v = O / L;
                  OB[((size_t)b * LTOK + (R & 15)) * DM + (kvh * 4 + (R >> 4)) * 128 + d] = (bf16raw)(cvt_pk(v, v) & 0xffffu); } } }
#endif
            GSYNC();
        }
        { const bf16raw* Ap = (layer & 1) ? OB : Yb; const bf16raw* Bp = (layer & 1) ? Wb + WO_AO + (size_t)slot * 1024 * 1024 : Wb + WO_LRU_OUT + (size_t)slot * 1024 * 1024;
          EpiPlain E{MB, DM, nullptr, TAILP}; GEMM_RUN_S(EpiPlain, Ap, Bp, 1024, 1024, E, true, TAIL_S); }
        GSYNC();
        { FRESH(); resid_pass(1, nullptr, nullptr, MB, U, RS, nullptr, gl + DM, nullptr, gw, NGW, lane, TAILP); }
        GSYNC();
        { EpiSwiglu E{BIG, RS}; GEMM_RUN_T(EpiSwiglu, U, Wb + WO_F1 + (size_t)layer * 5632 * 1024, 5632, 1024, E, true); }
        GSYNC();
        { EpiPlain E{MB, DM, nullptr, TAILP}; GEMM_RUN_S(EpiPlain, BIG, Wb + WO_F2 + (size_t)layer * 1024 * 2816, 1024, 2816, E, true, TAIL_S); }
        GSYNC();
        if (layer < 3) { { FRESH(); resid_pass(1, nullptr, nullptr, MB, U, RS, nullptr, gl + 3 * DM, nullptr, gw, NGW, lane, TAILP); } GSYNC(); }
        else { FRESH(); resid_pass(2, nullptr, nullptr, MB, U, RS, nullptr, gl + 3 * DM, args.out, gw, NGW, lane, TAILP); }
    }
}

extern "C" void kernel_launch(void* const* d_in, const int* in_sizes, int n_in, void* d_out, int out_size, void* d_ws, size_t ws_size, hipStream_t stream) {
    static int grid = 0;
    if (grid == 0) {
        if (n_in != 16 || ws_size < WS_END) { fprintf(stderr, "kernel_launch: n_in %d ws %zu (need %zu)\n", n_in, ws_size, (size_t)WS_END); grid = -1; return; }
        int dev = 0, cus = 0, per_cu = 0;
        hipGetDevice(&dev); hipDeviceGetAttribute(&cus, hipDeviceAttributeMultiprocessorCount, dev);
        if (hipFuncSetAttribute((const void*)mega_fwd, hipFuncAttributeMaxDynamicSharedMemorySize, LDS_BYTES) != hipSuccess) { fprintf(stderr, "kernel_launch: hipFuncSetAttribute failed\n"); grid = -1; return; }
        if (hipOccupancyMaxActiveBlocksPerMultiprocessor(&per_cu, (const void*)mega_fwd, NTHREADS, LDS_BYTES) != hipSuccess || per_cu < 1) { fprintf(stderr, "kernel_launch: occupancy query gave %d\n", per_cu); per_cu = 1; }
        (void)hipGetLastError();
        grid = cus * per_cu;
    }
    if (grid < 0) return;
    Args a{};
    for (int i = 0; i < 16; ++i) a.in[i] = (const float*)d_in[i];
    a.out = (float*)d_out; a.ws = (unsigned char*)d_ws;
    void* kargs[] = {&a};
    hipError_t e = hipLaunchCooperativeKernel((const void*)mega_fwd, dim3(grid), dim3(NTHREADS), kargs, LDS_BYTES, stream);
    if (e != hipSuccess) fprintf(stderr, "kernel_launch: cooperative launch failed: %s (grid %d)\n", hipGetErrorString(e), grid);
}
```

```cpp
#include <hip/hip_runtime.h>
#include <hip/hip_bf16.h>
#include <hip/hip_cooperative_groups.h>
#include <cstdio>
#include <cstdint>
#include <cmath>
namespace cg = cooperative_groups;

#define PG8_ROWS_VALID 65664
namespace pg8 {
#define PG8_LAS __attribute__((address_space(3)))
typedef unsigned short bf16_t;
typedef short bf16x8 __attribute__((ext_vector_type(8)));
typedef float f32x4 __attribute__((ext_vector_type(4)));
typedef unsigned u32x4 __attribute__((ext_vector_type(4)));
constexpr int BM = 256, BK = 64, HALF = 128, HTB = HALF * BK * 2  , STAGE_BYTES = 8 * HTB, NXCD = 8, WGM = 8;

__host__ __device__ __forceinline__ int lds_byte(int r, int c) { const int st = (r >> 4) * 2 + (c >> 5), rr = r & 15, cc = c & 31, ob = rr * 64 + cc * 2; return st * 1024 + (ob ^ (((ob >> 9) & 1) << 5)); }
__host__ __device__ __forceinline__ void stage_rc(int b, int& R, int& C) { const int st = b / 1024, sb = b % 1024, swz = sb ^ (((sb >> 9) & 1) << 5); R = (st >> 1) * 16 + swz / 64; C = (st & 1) * 32 + (swz % 64) / 2; }
__host__ __device__ __forceinline__ int perm32(int rho) { const int n = rho >> 4, i = rho & 15; return 8 * (i >> 2) + 4 * n + (i & 3); }

struct Unit { int pm, pn, k0, nt, part; };
struct Gemm { const bf16_t* A; const bf16_t* Bt; int M, N, K; };

struct StaticOrder {
    int nM, nN, nwg, G, c, ntail, ntK, S;
    __host__ __device__ void init(int M, int N, int K, int G_, int c_, bool with_tail = true, int S_ = 1) { nM = M / BM - 1; nN = N / BM; nwg = nM * nN; G = G_; c = c_; ntK = K / BK; S = S_; ntail = with_tail ? nN * S : 0; }
    __host__ __device__ bool next(int i, Unit& u) const {
        const long L = (long)i * G + c; if (L >= nwg + ntail) return false;
        u.k0 = 0; u.nt = ntK; u.part = 0;
        if (L >= nwg) { const int j = (int)(L - nwg); u.pm = nM; u.pn = j / S; const int p = j % S; u.part = p;
            if (S > 1) { const int pairs = ntK / 2, q = pairs / S, r = pairs % S; u.nt = 2 * (q + (p < r ? 1 : 0)); u.k0 = 2 * (p * q + (p < r ? p : r)); }
            return true; }
        int wgid = (int)L; { const int q = nwg / NXCD, r = nwg % NXCD, xcd = wgid % NXCD, off = wgid / NXCD; wgid = (xcd < r ? xcd * (q + 1) : r * (q + 1) + (xcd - r) * q) + off; }
        const int nig = WGM * nN, gid = wgid / nig, fm = gid * WGM, gsz = (nM - fm) < WGM ? (nM - fm) : WGM;
        u.pm = fm + ((wgid % nig) % gsz); u.pn = (wgid % nig) / gsz; return true;
    }
    __device__ __forceinline__ void a_ready(const Unit&) const {}
    __device__ __forceinline__ void done(const Unit&) const {}
};

__device__ __forceinline__ unsigned cvt_pk_bf16(float lo, float hi) { unsigned r; asm volatile("v_cvt_pk_bf16_f32 %0, %1, %2" : "=v"(r) : "v"(lo), "v"(hi)); return r; }
typedef float f32x2 __attribute__((ext_vector_type(2)));
__device__ __forceinline__ f32x2 gelu_pk(f32x2 v) {
    const f32x2 av = __builtin_elementwise_abs(v), d = av * 0.2316418882f + 1.0f;
    f32x2 t; t.x = __builtin_amdgcn_rcpf(d.x); t.y = __builtin_amdgcn_rcpf(d.y);
    f32x2 q = t * 0.5307027145f + (-0.7265760135f); q = q * t + 0.7107068705f; q = q * t + (-0.142248368f); q = q * t + 0.127414796f; q = q * t;
    const f32x2 s = (v * v) * (-0.72134752044f);
    f32x2 e; e.x = __builtin_amdgcn_exp2f(s.x); e.y = __builtin_amdgcn_exp2f(s.y);
    const f32x2 m = v * (q * e), r = v - m;
    f32x2 o; o.x = v.x < 0.f ? m.x : r.x; o.y = v.y < 0.f ? m.y : r.y; return o;
}

template <int ACT  > struct EpiBf16 {
    static constexpr bool PERM = true, AFTER_DRAIN = false; static_assert(ACT == 0 || ACT == 1, "EpiBf16: ACT is 0 (none) or 1 (gelu_pk)");
    bf16_t* O; int ldc; const float* bias; int split_cols; size_t split_stride; float scale0;
    __device__ __forceinline__ void operator()(const f32x4 (&acc)[2][2][4][2], const Unit& u, int wr, int wc, int fr, int fq) const {
        const int row0 = u.pm * BM + wr * 64 + fr; int colt = u.pn * BM; bf16_t* base = O;
        float sc = 1.f; if (split_cols) { const int t = colt / split_cols; base += (size_t)t * split_stride; colt -= t * split_cols; if (t == 0) sc = scale0; }
        const int col0 = colt + wc * 32 + 8 * fq, bcol0 = u.pn * BM + wc * 32 + 8 * fq;
        f32x4 bv[2][2];
#pragma unroll
        for (int bj = 0; bj < 2; ++bj)
#pragma unroll
            for (int n = 0; n < 2; ++n) bv[bj][n] = bias ? *(const f32x4*)(bias + bcol0 + bj * HALF + 4 * n) : (f32x4){0.f, 0.f, 0.f, 0.f};
#pragma unroll
        for (int ai = 0; ai < 2; ++ai)
#pragma unroll
            for (int m = 0; m < 4; ++m) { bf16_t* rowp = base + (size_t)(row0 + ai * HALF + m * 16) * ldc + col0;
#pragma unroll
                for (int bj = 0; bj < 2; ++bj) { f32x4 v0 = acc[ai][bj][m][0] + bv[bj][0], v1 = acc[ai][bj][m][1] + bv[bj][1];
                    if (ACT == 1) { f32x2 a = gelu_pk((f32x2){v0[0], v0[1]}), b = gelu_pk((f32x2){v0[2], v0[3]}), c = gelu_pk((f32x2){v1[0], v1[1]}), d = gelu_pk((f32x2){v1[2], v1[3]});
                        v0 = (f32x4){a.x, a.y, b.x, b.y}; v1 = (f32x4){c.x, c.y, d.x, d.y}; }
                    v0 = v0 * sc; v1 = v1 * sc; u32x4 w; w.x = cvt_pk_bf16(v0[0], v0[1]); w.y = cvt_pk_bf16(v0[2], v0[3]); w.z = cvt_pk_bf16(v1[0], v1[1]); w.w = cvt_pk_bf16(v1[2], v1[3]);
                    *(u32x4*)(rowp + bj * HALF) = w; } }
    }
};
template <class Epi, class Sched, bool ALIGN_EPI = false, bool SP2 = false>
__device__ __forceinline__ void gemm_phase(PG8_LAS unsigned char* lds, const Gemm g, const Sched& S, const Epi& E) {
    int tid_ = threadIdx.x; asm volatile("" : "+v"(tid_));
    const int tid = tid_, wid = __builtin_amdgcn_readfirstlane(tid >> 6), lane = tid & 63, wr = wid >> 2, wc = wid & 3, fr = lane & 15, fq = lane >> 4;
    const int K = g.K, nt = K / BK;
    unsigned voffA[2], voffB[2];
#pragma unroll
    for (int i = 0; i < 2; ++i) { int R, C; stage_rc(tid * 16 + i * 8192, R, C); const int Rb = Epi::PERM ? ((R & ~31) + perm32(R & 31)) : R;
        voffA[i] = (unsigned)(R * K + C) * 2u; voffB[i] = (unsigned)(Rb * K + C) * 2u; }
    const size_t kstep = (size_t)(BK * 2);
    const size_t hstep = (size_t)HALF * K * 2;
    const size_t tstep = 2 * hstep;
    const unsigned ldsw = (unsigned)wid * 1024u;
    const int aoff = lds_byte(wr * 64 + fr, fq * 8), boff = lds_byte(wc * 32 + fr, fq * 8);
#define PG8_SA(b, h) (((b) * 2 + (h)) * HTB)
#define PG8_SB(b, h) ((4 + (b) * 2 + (h)) * HTB)
#define PG8_STAGE(bufoff, gbase, voff) do { _Pragma("unroll") for (int _i = 0; _i < 2; ++_i) \
        __builtin_amdgcn_global_load_lds((const unsigned*)((const char*)(gbase) + (voff)[_i]), (PG8_LAS unsigned*)(lds + (bufoff) + ldsw + _i * 8192), 16, 0, 0); } while (0)
#define PG8_LDA(dst, b, h) do { _Pragma("unroll") for (int m = 0; m < 4; ++m) _Pragma("unroll") for (int k = 0; k < 2; ++k) dst[m][k] = *(const PG8_LAS bf16x8*)(lds + PG8_SA(b, h) + aoff + m * 2048 + k * 1024); } while (0)
#define PG8_LDB(dst, b, h) do { _Pragma("unroll") for (int n = 0; n < 2; ++n) _Pragma("unroll") for (int k = 0; k < 2; ++k) dst[n][k] = *(const PG8_LAS bf16x8*)(lds + PG8_SB(b, h) + boff + n * 2048 + k * 1024); } while (0)
#define PG8_MMA(ai, bj, At, Bt) do { __builtin_amdgcn_s_setprio(1); _Pragma("unroll") for (int m = 0; m < 4; ++m) _Pragma("unroll") for (int n = 0; n < 2; ++n) _Pragma("unroll") for (int k = 0; k < 2; ++k) \
        acc[ai][bj][m][n] = __builtin_amdgcn_mfma_f32_16x16x32_bf16(Bt[n][k], At[m][k], acc[ai][bj][m][n], 0, 0, 0); __builtin_amdgcn_s_setprio(0); } while (0)
#define PG8_WAIT_V(n) asm volatile("s_waitcnt vmcnt(" #n ")" ::: "memory")
#define PG8_WAIT_L(n) asm volatile("s_waitcnt lgkmcnt(" #n ")" ::: "memory")
#define PG8_BAR __builtin_amdgcn_s_barrier()
#define PG8_SCHED __builtin_amdgcn_sched_barrier(0)
    Unit cur, nxt; int ui = 0;
    if (!S.next(0, cur)) return;
    f32x4 acc[2][2][4][2];
#pragma unroll
    for (int a = 0; a < 2; ++a)
#pragma unroll
        for (int b = 0; b < 2; ++b)
#pragma unroll
            for (int m = 0; m < 4; ++m)
#pragma unroll
                for (int n = 0; n < 2; ++n) acc[a][b][m][n] = (f32x4){0.f, 0.f, 0.f, 0.f};
    bf16x8 At[4][2], B0[2][2], B1[2][2];
    const char* cA = (const char*)g.A + (size_t)cur.pm * tstep + (size_t)cur.k0 * kstep; const char* cB = (const char*)g.Bt + (size_t)cur.pn * tstep + (size_t)cur.k0 * kstep;
    S.a_ready(cur);
    if constexpr (SP2) {
        PG8_STAGE(PG8_SB(0, 0), cB, voffB); PG8_STAGE(PG8_SB(0, 1), cB + hstep, voffB); PG8_STAGE(PG8_SA(0, 0), cA, voffA); PG8_STAGE(PG8_SA(0, 1), cA + hstep, voffA);
        if (wr == 1) PG8_BAR;
        PG8_WAIT_V(2); PG8_BAR;
        PG8_STAGE(PG8_SB(1, 0), cB + kstep, voffB); PG8_STAGE(PG8_SA(1, 0), cA + kstep, voffA); PG8_STAGE(PG8_SB(1, 1), cB + hstep + kstep, voffB);
        PG8_WAIT_V(6); PG8_BAR;
    } else {
        PG8_STAGE(PG8_SB(0, 0), cB, voffB); PG8_STAGE(PG8_SA(0, 0), cA, voffA); PG8_STAGE(PG8_SB(0, 1), cB + hstep, voffB); PG8_STAGE(PG8_SA(0, 1), cA + hstep, voffA);
        if (wr == 1) PG8_BAR;
        PG8_WAIT_V(4); PG8_BAR;
        PG8_STAGE(PG8_SB(1, 0), cB + kstep, voffB); PG8_STAGE(PG8_SA(1, 0), cA + kstep, voffA); PG8_STAGE(PG8_SB(1, 1), cB + hstep + kstep, voffB);
        PG8_WAIT_V(6); PG8_BAR;
    }
    for (;;) {
        const bool has_next = S.next(ui + 1, nxt);
        const bool full = (cur.pm * BM + HALF) < PG8_ROWS_VALID;
        const char* nA = has_next ? (const char*)g.A + (size_t)nxt.pm * tstep + (size_t)nxt.k0 * kstep : cA; const char* nB = has_next ? (const char*)g.Bt + (size_t)nxt.pn * tstep + (size_t)nxt.k0 * kstep : cB;
        const int ntu = cur.nt;
        for (int t = 0; t < ntu; t += 2) {
            const bool last = (t == ntu - 2);
            const char* a1 = cA + (size_t)(t + 1) * kstep;
            const char* a2 = last ? nA : cA + (size_t)(t + 2) * kstep; const char* b2 = last ? nB : cB + (size_t)(t + 2) * kstep;
            const char* a3 = a2 + kstep; const char* b3 = b2 + kstep;
            if (last && has_next) S.a_ready(nxt);
            if constexpr (SP2) {
            PG8_LDB(B0, 0, 0); PG8_LDB(B1, 0, 1); PG8_SCHED; PG8_LDA(At, 0, 0); PG8_STAGE(PG8_SA(1, 1), a1 + hstep, voffA);
            PG8_WAIT_V(8); PG8_WAIT_L(0); PG8_BAR; PG8_MMA(0, 0, At, B0); PG8_MMA(0, 1, At, B1); PG8_BAR; PG8_SCHED;
            PG8_LDA(At, 0, 1); PG8_STAGE(PG8_SB(0, 0), b2, voffB); PG8_STAGE(PG8_SB(0, 1), b2 + hstep, voffB); PG8_STAGE(PG8_SA(0, 0), a2, voffA);
            PG8_WAIT_V(8); PG8_WAIT_L(0); PG8_BAR; if (full) { PG8_MMA(1, 0, At, B0); PG8_MMA(1, 1, At, B1); } PG8_BAR; PG8_SCHED;
            PG8_LDB(B0, 1, 0); PG8_LDB(B1, 1, 1); PG8_SCHED; PG8_LDA(At, 1, 0); PG8_STAGE(PG8_SA(0, 1), a2 + hstep, voffA);
            PG8_WAIT_V(8); PG8_WAIT_L(0); PG8_BAR; PG8_MMA(0, 0, At, B0); PG8_MMA(0, 1, At, B1); PG8_BAR; PG8_SCHED;
            PG8_LDA(At, 1, 1); PG8_STAGE(PG8_SB(1, 0), b3, voffB); PG8_STAGE(PG8_SB(1, 1), b3 + hstep, voffB); PG8_STAGE(PG8_SA(1, 0), a3, voffA);
            PG8_WAIT_V(8); PG8_WAIT_L(0); PG8_BAR; if (full) { PG8_MMA(1, 0, At, B0); PG8_MMA(1, 1, At, B1); } PG8_BAR; PG8_SCHED;
            } else {
            PG8_LDB(B0, 0, 0); PG8_SCHED; PG8_LDA(At, 0, 0); PG8_STAGE(PG8_SA(1, 1), a1 + hstep, voffA);
            PG8_WAIT_L(8); PG8_BAR; PG8_WAIT_L(0); PG8_MMA(0, 0, At, B0); PG8_BAR; PG8_SCHED;
            PG8_LDB(B1, 0, 1); PG8_STAGE(PG8_SB(0, 0), b2, voffB);
            PG8_BAR; PG8_WAIT_L(0); PG8_MMA(0, 1, At, B1); PG8_BAR;
            PG8_LDA(At, 0, 1); PG8_STAGE(PG8_SA(0, 0), a2, voffA);
            PG8_BAR; PG8_WAIT_L(0); PG8_MMA(1, 0, At, B0); PG8_BAR; PG8_SCHED;
            PG8_STAGE(PG8_SB(0, 1), b2 + hstep, voffB);
            PG8_WAIT_V(6); PG8_BAR; PG8_MMA(1, 1, At, B1); PG8_BAR;
            PG8_LDB(B0, 1, 0); PG8_SCHED; PG8_LDA(At, 1, 0); PG8_STAGE(PG8_SA(0, 1), a2 + hstep, voffA);
            PG8_WAIT_L(8); PG8_BAR; PG8_WAIT_L(0); PG8_MMA(0, 0, At, B0); PG8_BAR; PG8_SCHED;
            PG8_LDB(B1, 1, 1); PG8_STAGE(PG8_SB(1, 0), b3, voffB);
            PG8_BAR; PG8_WAIT_L(0); PG8_MMA(0, 1, At, B1); PG8_BAR;
            PG8_LDA(At, 1, 1); PG8_STAGE(PG8_SA(1, 0), a3, voffA);
            PG8_BAR; PG8_WAIT_L(0); PG8_MMA(1, 0, At, B0); PG8_BAR; PG8_SCHED;
            PG8_STAGE(PG8_SB(1, 1), b3 + hstep, voffB);
            PG8_WAIT_V(6); PG8_BAR; PG8_MMA(1, 1, At, B1); PG8_BAR;
            }
        }
        if constexpr (ALIGN_EPI) { if (wr == 0) PG8_BAR; }
        if constexpr (!Epi::AFTER_DRAIN) { E(acc, cur, wr, wc, fr, fq); S.done(cur); }
        if (!has_next) break;
#pragma unroll
        for (int a = 0; a < 2; ++a)
#pragma unroll
            for (int b = 0; b < 2; ++b)
#pragma unroll
                for (int m = 0; m < 4; ++m)
#pragma unroll
                    for (int n = 0; n < 2; ++n) acc[a][b][m][n] = (f32x4){0.f, 0.f, 0.f, 0.f};
        cur = nxt; cA = nA; cB = nB; ++ui;
        if constexpr (ALIGN_EPI) { if (wr == 1) PG8_BAR; }
    }
    PG8_WAIT_V(0);
    if constexpr (!ALIGN_EPI) { if (wr == 0) PG8_BAR; }
    PG8_BAR;
    if constexpr (Epi::AFTER_DRAIN) { E.fused(acc, cur, wr, wc, fr, fq, lds, wid, lane); S.done(cur); }
#undef PG8_SA
#undef PG8_SB
#undef PG8_STAGE
#undef PG8_LDA
#undef PG8_LDB
#undef PG8_MMA
#undef PG8_WAIT_V
#undef PG8_WAIT_L
#undef PG8_BAR
#undef PG8_SCHED
}
}

namespace att {
using bf16 = __hip_bfloat16;
constexpr int D = 128, NW = 8, QBLK = 32, KVBLK = 64;
constexpr float SCALE = 0.088388347648318440f;
constexpr float THR = 8.f;
constexpr int SDEPTH = 2;
constexpr int LDQ = 1536, LDK = 1536, LDO = 1024;
constexpr size_t SHM_V = KVBLK * D * 2, SHM_K = KVBLK * D * 2, SHM_ATTN = 2 * SHM_V + 2 * SHM_K + NW * 64 * 4;
using bf16x8 = __attribute__((ext_vector_type(8))) short;
using s16x4  = __attribute__((ext_vector_type(4))) short;
using f32x16 = __attribute__((ext_vector_type(16))) float;
using u32x4  = __attribute__((ext_vector_type(4))) unsigned;
#define KSWZ(row, colB) ((row) * 256 + ((colB) ^ (((row) & 7) << 4)))
#define SBAR() __builtin_amdgcn_sched_barrier(0)
__device__ __forceinline__ int crow(int r, int hi) { return (r & 3) + 8 * (r >> 2) + 4 * hi; }
__device__ __forceinline__ unsigned cvtpk(float lo, float hi) {
  unsigned r; asm volatile("v_cvt_pk_bf16_f32 %0, %1, %2" : "=v"(r) : "v"(lo), "v"(hi)); return r;
}
__device__ __forceinline__ bf16x8 ld8(const bf16* p) { return *reinterpret_cast<const bf16x8*>(p); }

__device__ __forceinline__ void partialSM(f32x16& p0, f32x16& p1, float& m_reg, float& mn, float& alpha) {
  constexpr float THRL = THR * 1.4426950408889634f;
  float pmax = p0[0]; for (int r = 1; r < 16; ++r) pmax = fmaxf(pmax, p0[r]); for (int r = 0; r < 16; ++r) pmax = fmaxf(pmax, p1[r]);
  { auto rr = __builtin_amdgcn_permlane32_swap(__float_as_uint(pmax), __float_as_uint(pmax), false, false);
    pmax = fmaxf(__uint_as_float(rr[0]), __uint_as_float(rr[1])); }
  if (__builtin_expect(__all(pmax - m_reg <= THRL), 1)) { mn = m_reg; alpha = 1.f; }
  else { mn = fmaxf(m_reg, pmax); alpha = __builtin_amdgcn_exp2f(m_reg - mn); m_reg = mn; }
  for (int r = 0; r < 16; ++r) p0[r] = p0[r] - mn; for (int r = 0; r < 16; ++r) p1[r] = p1[r] - mn;
  for (int r = 0; r < 16; ++r) p0[r] = __builtin_amdgcn_exp2f(p0[r]);
}
__device__ __forceinline__ void partialSM_fixed(f32x16& p0) {
  for (int r = 0; r < 16; ++r) p0[r] = __builtin_amdgcn_exp2f(p0[r]);
}
__device__ __forceinline__ void finishSM(f32x16& p0, f32x16& p1, float alpha, float& l_reg, bf16x8& pa0, bf16x8& pa1, bf16x8& pa2, bf16x8& pa3) {
  for (int r = 0; r < 16; ++r) p1[r] = __builtin_amdgcn_exp2f(p1[r]);
  float ps = 0; for (int r = 0; r < 16; ++r) ps += p0[r]; for (int r = 0; r < 16; ++r) ps += p1[r];
  { auto rr = __builtin_amdgcn_permlane32_swap(__float_as_uint(ps), __float_as_uint(ps), false, false);
    ps = __uint_as_float(rr[0]) + __uint_as_float(rr[1]); }
  l_reg = l_reg * alpha + ps;
#define PK4(P, BASE, OUT) do { unsigned a0 = cvtpk(P[BASE + 0], P[BASE + 1]), a1 = cvtpk(P[BASE + 2], P[BASE + 3]);   \
    unsigned b0 = cvtpk(P[BASE + 4], P[BASE + 5]), b1 = cvtpk(P[BASE + 6], P[BASE + 7]);                              \
    auto r0 = __builtin_amdgcn_permlane32_swap(a0, b0, false, false); auto r1 = __builtin_amdgcn_permlane32_swap(a1, b1, false, false); \
    u32x4 w = {r0[0], r1[0], r0[1], r1[1]}; OUT = *reinterpret_cast<bf16x8*>(&w); } while (0)
  PK4(p0, 0, pa0); PK4(p0, 8, pa1); PK4(p1, 0, pa2); PK4(p1, 8, pa3);
#undef PK4
}
__device__ __forceinline__ void qkt(f32x16& p0, f32x16& p1, const bf16* Ks, const bf16x8* qr, int r32, int hi) {
  p0 = f32x16{}; p1 = f32x16{};
  for (int d0 = 0; d0 < 8; ++d0) { int cb = (d0 * 16 + hi * 8) * 2;
    bf16x8 b0 = *reinterpret_cast<const bf16x8*>((const char*)Ks + KSWZ(r32, cb));
    bf16x8 b1 = *reinterpret_cast<const bf16x8*>((const char*)Ks + KSWZ(32 + r32, cb));
    p0 = __builtin_amdgcn_mfma_f32_32x32x16_bf16(b0, qr[d0], p0, 0, 0, 0);
    p1 = __builtin_amdgcn_mfma_f32_32x32x16_bf16(b1, qr[d0], p1, 0, 0, 0); }
}
__device__ __forceinline__ int v_st(int k, int c) { const int kk = (k & ~0xC) | ((k & 4) << 1) | ((k & 8) >> 1); return ((kk >> 3) * 4 + (c >> 5)) * 512 + ((kk & 7) * 32 + (c & 31)) * 2; }
__device__ __forceinline__ int v_rd_base(int lane) { return ((lane & 3) << 3) | (((lane >> 2) & 3) << 6) | (((lane >> 4) & 1) << 5) | (((lane >> 5) & 1) << 8); }
constexpr int v_rd_off(int d0, int ks, int half) { return d0 * 512 + ks * 4096 + half * 2048; }
template <int OFF> __device__ __forceinline__ s16x4 tr_read(int vb) {
  s16x4 r; asm volatile("ds_read_b64_tr_b16 %0, %1 offset:%2" : "=&v"(r) : "v"(vb), "i"(OFF) : "memory"); return r;
}
template <int D0> __device__ __forceinline__ void pv_one(f32x16& od, int vb, bf16x8 pa0, bf16x8 pa1, bf16x8 pa2, bf16x8 pa3) {
  const s16x4 l0 = tr_read<v_rd_off(D0, 0, 0)>(vb), h0 = tr_read<v_rd_off(D0, 0, 1)>(vb), l1 = tr_read<v_rd_off(D0, 1, 0)>(vb), h1 = tr_read<v_rd_off(D0, 1, 1)>(vb);
  const s16x4 l2 = tr_read<v_rd_off(D0, 2, 0)>(vb), h2 = tr_read<v_rd_off(D0, 2, 1)>(vb), l3 = tr_read<v_rd_off(D0, 3, 0)>(vb), h3 = tr_read<v_rd_off(D0, 3, 1)>(vb);
  asm volatile("s_waitcnt lgkmcnt(0)" ::: "memory"); SBAR();
#define PK(L, H) (bf16x8){L[0], L[1], L[2], L[3], H[0], H[1], H[2], H[3]}
  od = __builtin_amdgcn_mfma_f32_32x32x16_bf16(pa0, PK(l0, h0), od, 0, 0, 0);
  od = __builtin_amdgcn_mfma_f32_32x32x16_bf16(pa1, PK(l1, h1), od, 0, 0, 0);
  od = __builtin_amdgcn_mfma_f32_32x32x16_bf16(pa2, PK(l2, h2), od, 0, 0, 0);
  od = __builtin_amdgcn_mfma_f32_32x32x16_bf16(pa3, PK(l3, h3), od, 0, 0, 0);
#undef PK
}
__device__ __forceinline__ void pv_d0(f32x16* o, int vb, bf16x8 pa0, bf16x8 pa1, bf16x8 pa2, bf16x8 pa3) {
  pv_one<0>(o[0], vb, pa0, pa1, pa2, pa3); pv_one<1>(o[1], vb, pa0, pa1, pa2, pa3); pv_one<2>(o[2], vb, pa0, pa1, pa2, pa3); pv_one<3>(o[3], vb, pa0, pa1, pa2, pa3);
}

typedef __attribute__((address_space(3))) bf16x8 lds_bf16x8;
#define LDSV(addr) (*(lds_bf16x8*)(unsigned)(addr))
template <int BOFF> __device__ __forceinline__ void qkt_i(f32x16& p0, f32x16& p1, const int (&kb)[4], const bf16x8* qr) {
  p0 = f32x16{}; p1 = f32x16{};
#pragma unroll
  for (int d0 = 0; d0 < 8; ++d0) { const int off = BOFF + (d0 >> 2) * 128;
    const bf16x8 b0 = LDSV(kb[d0 & 3] + off), b1 = LDSV(kb[d0 & 3] + off + 8192);
    p0 = __builtin_amdgcn_mfma_f32_32x32x16_bf16(b0, qr[d0], p0, 0, 0, 0);
    p1 = __builtin_amdgcn_mfma_f32_32x32x16_bf16(b1, qr[d0], p1, 0, 0, 0); }
}
template <int D0, int BOFF> __device__ __forceinline__ void pv_one_i(f32x16& od, int vb, bf16x8 pa0, bf16x8 pa1, bf16x8 pa2, bf16x8 pa3) {
  const s16x4 l0 = tr_read<BOFF + v_rd_off(D0, 0, 0)>(vb), h0 = tr_read<BOFF + v_rd_off(D0, 0, 1)>(vb), l1 = tr_read<BOFF + v_rd_off(D0, 1, 0)>(vb), h1 = tr_read<BOFF + v_rd_off(D0, 1, 1)>(vb);
  const s16x4 l2 = tr_read<BOFF + v_rd_off(D0, 2, 0)>(vb), h2 = tr_read<BOFF + v_rd_off(D0, 2, 1)>(vb), l3 = tr_read<BOFF + v_rd_off(D0, 3, 0)>(vb), h3 = tr_read<BOFF + v_rd_off(D0, 3, 1)>(vb);
  asm volatile("s_waitcnt lgkmcnt(0)" ::: "memory"); SBAR();
#define PK(L, H) (bf16x8){L[0], L[1], L[2], L[3], H[0], H[1], H[2], H[3]}
  od = __builtin_amdgcn_mfma_f32_32x32x16_bf16(pa0, PK(l0, h0), od, 0, 0, 0);
  od = __builtin_amdgcn_mfma_f32_32x32x16_bf16(pa1, PK(l1, h1), od, 0, 0, 0);
  od = __builtin_amdgcn_mfma_f32_32x32x16_bf16(pa2, PK(l2, h2), od, 0, 0, 0);
  od = __builtin_amdgcn_mfma_f32_32x32x16_bf16(pa3, PK(l3, h3), od, 0, 0, 0);
#undef PK
}
template <int BOFF> __device__ __forceinline__ void pv_i(f32x16* o, int vb, bf16x8 pa0, bf16x8 pa1, bf16x8 pa2, bf16x8 pa3) {
  pv_one_i<0, BOFF>(o[0], vb, pa0, pa1, pa2, pa3); pv_one_i<1, BOFF>(o[1], vb, pa0, pa1, pa2, pa3); pv_one_i<2, BOFF>(o[2], vb, pa0, pa1, pa2, pa3); pv_one_i<3, BOFF>(o[3], vb, pa0, pa1, pa2, pa3);
}
struct AttSlot { bf16x8 vs0, vs1, ks0, ks1; };
struct AttCarry { bf16x8 qr[8]; AttSlot s[2]; };
__device__ __forceinline__ void att_preload(AttCarry& cy, const bf16* Qrow, const bf16* Kh, const bf16* Vh) {
  const int tid = threadIdx.x, sr = tid >> 4, sc = (tid & 15) * 8;
#pragma unroll
  for (int d0 = 0; d0 < 8; ++d0) cy.qr[d0] = ld8(Qrow + d0 * 16);
#pragma unroll
  for (int i = 0; i < 2; ++i) { const int k0 = i * KVBLK;
    cy.s[i].vs0 = ld8(&Vh[(long)(k0 + sr) * LDK + sc]); cy.s[i].vs1 = ld8(&Vh[(long)(k0 + 32 + sr) * LDK + sc]);
    cy.s[i].ks0 = ld8(&Kh[(long)(k0 + sr) * LDK + sc]); cy.s[i].ks1 = ld8(&Kh[(long)(k0 + 32 + sr) * LDK + sc]); }
}
template <bool PARTIAL, bool FIXED>
__device__ __forceinline__ void attn_unit(const bf16* __restrict__ Qrow, const bf16* __restrict__ Kh, const bf16* __restrict__ Vh,
                                          bf16* __restrict__ Ob, int NT, bool mask_last, float* __restrict__ PO, char* lds,
                                          const bf16* Qb_n = nullptr, const bf16* Kh_n = nullptr, const bf16* Vh_n = nullptr) {
  AttCarry cy; unsigned warm0 = 0u, warm1 = 0u;
  int tid_ = threadIdx.x; asm volatile("" : "+v"(tid_));
  const int tid = tid_, wid = tid >> 6, lane = tid & 63, r32 = lane & 31, hi = lane >> 5;
  bf16* V_lds = (bf16*)lds; bf16* K_lds = (bf16*)(lds + 3 * SHM_V);
  float* ws = (float*)(lds + 3 * SHM_V + 3 * SHM_K) + wid * 64; float* li_l = ws; float* al_l = ws + 32;
  float m_reg = FIXED ? 0.f : -1e30f, l_reg = 0; f32x16 o[4] = {}; bf16x8 (&qr)[8] = cy.qr;
  const bf16* Qw = Qrow;
  const int sr = tid >> 4, sc = (tid & 15) * 8, vst0 = v_st(sr, sc), vst1 = v_st(32 + sr, sc);
  const int vb0 = (int)(uintptr_t)V_lds + v_rd_base(lane);
  AttSlot (&sr_)[2] = cy.s;
#define SLOAD(i, k0) do { sr_[i].vs0 = ld8(&Vh[(long)((k0) + sr) * LDK + sc]); sr_[i].vs1 = ld8(&Vh[(long)((k0) + 32 + sr) * LDK + sc]); \
    sr_[i].ks0 = ld8(&Kh[(long)((k0) + sr) * LDK + sc]); sr_[i].ks1 = ld8(&Kh[(long)((k0) + 32 + sr) * LDK + sc]); } while (0)
#define SLOADP(i, Kp, Vp, k0) do { sr_[i].vs0 = ld8(&(Vp)[(long)((k0) + sr) * LDK + sc]); sr_[i].vs1 = ld8(&(Vp)[(long)((k0) + 32 + sr) * LDK + sc]); \
    sr_[i].ks0 = ld8(&(Kp)[(long)((k0) + sr) * LDK + sc]); sr_[i].ks1 = ld8(&(Kp)[(long)((k0) + 32 + sr) * LDK + sc]); } while (0)
#define SWRITE(b, i) do { *(bf16x8*)((char*)V_lds + (b) * SHM_V + vst0) = sr_[i].vs0;          \
    *(bf16x8*)((char*)V_lds + (b) * SHM_V + vst1) = sr_[i].vs1; int kc = sc * 2;               \
    *(bf16x8*)((char*)K_lds + (b) * SHM_K + KSWZ(sr, kc)) = sr_[i].ks0;                       \
    *(bf16x8*)((char*)K_lds + (b) * SHM_K + KSWZ(32 + sr, kc)) = sr_[i].ks1; } while (0)
#define SWAIT() asm volatile("s_waitcnt vmcnt(4)" ::: "memory")
#define RESC(a) do { if (__any((a) < 1.f)) { if (hi == 0) al_l[r32] = (a); asm volatile("s_waitcnt lgkmcnt(0)" ::: "memory"); \
    for (int d = 0; d < 4; ++d) for (int r = 0; r < 16; ++r) o[d][r] *= al_l[crow(r, hi)]; } } while (0)
  f32x16 pA0, pA1, pB0, pB1; float mnA, mnB, alA, alB; bf16x8 pa0, pa1, pa2, pa3;
  constexpr int KR = 3 * (int)SHM_V;
  const int ldsb = (int)(uintptr_t)lds, xs = (hi * 16) ^ ((r32 & 7) << 4);
  int kb[4];
#pragma unroll
  for (int k = 0; k < 4; ++k) { kb[k] = ldsb + KR + r32 * 256 + ((k * 32) ^ xs); asm volatile("" : "+v"(kb[k])); }
  int vbi = ldsb + v_rd_base(lane), wv0 = ldsb + vst0, wv1 = ldsb + vst1, wk0 = ldsb + KR + KSWZ(sr, sc * 2), wk1 = ldsb + KR + KSWZ(32 + sr, sc * 2);
  asm volatile("" : "+v"(vbi)); asm volatile("" : "+v"(wv0)); asm volatile("" : "+v"(wv1)); asm volatile("" : "+v"(wk0)); asm volatile("" : "+v"(wk1));
#define SWRITE_I(B, i) do { LDSV(wv0 + (B) * 16384) = sr_[i].vs0; LDSV(wv1 + (B) * 16384) = sr_[i].vs1; LDSV(wk0 + (B) * 16384) = sr_[i].ks0; LDSV(wk1 + (B) * 16384) = sr_[i].ks1; } while (0)
  if ((NT - 3) % 6 != 0) return;
#pragma unroll
  for (int d0 = 0; d0 < 8; ++d0) qr[d0] = ld8(Qw + d0 * 16);
  SLOAD(0, 0); SLOAD(1, KVBLK);
  SWRITE_I(0, 0); __syncthreads();
  qkt_i<0>(pA0, pA1, kb, qr);
  SLOAD(0, 2 * KVBLK); SBAR();
  if constexpr (FIXED) { partialSM_fixed(pA0); alA = 1.f; } else partialSM(pA0, pA1, m_reg, mnA, alA);
  SWAIT(); SWRITE_I(1, 1);
#define HALF_B(BC, BP, LOADSTMT, WRITESTMT) do { __syncthreads(); \
    SBAR(); qkt_i<(BC) * 16384>(pB0, pB1, kb, qr); \
    finishSM(pA0, pA1, alA, l_reg, pa0, pa1, pa2, pa3); SBAR(); \
    LOADSTMT; SBAR(); \
    pv_i<(BP) * 16384>(o, vbi, pa0, pa1, pa2, pa3); \
    if constexpr (FIXED) { partialSM_fixed(pB0); alB = 1.f; } else { partialSM(pB0, pB1, m_reg, mnB, alB); RESC(alB); } \
    WRITESTMT; } while (0)
#define HALF_A(BC, BP, MASKSTMT, LOADSTMT, WRITESTMT) do { __syncthreads(); \
    SBAR(); qkt_i<(BC) * 16384>(pA0, pA1, kb, qr); \
    MASKSTMT; \
    finishSM(pB0, pB1, alB, l_reg, pa0, pa1, pa2, pa3); SBAR(); \
    LOADSTMT; SBAR(); \
    pv_i<(BP) * 16384>(o, vbi, pa0, pa1, pa2, pa3); \
    if constexpr (FIXED) { partialSM_fixed(pA0); alA = 1.f; } else { partialSM(pA0, pA1, m_reg, mnA, alA); RESC(alA); } \
    WRITESTMT; } while (0)
#define NOP_() do { } while (0)
  int j = 1;
  for (; j + 6 < NT; j += 6) {
    HALF_B(1, 0, SLOAD(1, (j + 2) * KVBLK), do { SWAIT(); SWRITE_I(2, 0); } while (0));
    HALF_A(2, 1, NOP_(), SLOAD(0, (j + 3) * KVBLK), do { SWAIT(); SWRITE_I(0, 1); } while (0));
    HALF_B(0, 2, SLOAD(1, (j + 4) * KVBLK), do { SWAIT(); SWRITE_I(1, 0); } while (0));
    HALF_A(1, 0, NOP_(), SLOAD(0, (j + 5) * KVBLK), do { SWAIT(); SWRITE_I(2, 1); } while (0));
    HALF_B(2, 1, SLOAD(1, (j + 6) * KVBLK), do { SWAIT(); SWRITE_I(0, 0); } while (0));
    HALF_A(0, 2, NOP_(), SLOAD(0, (j + 7) * KVBLK), do { SWAIT(); SWRITE_I(1, 1); } while (0));
  }
  if constexpr (!PARTIAL) { const int i1 = tid & 255;
    warm0 = *(const unsigned*)(Qb_n + (long)(tid >> 1) * LDQ + (tid & 1) * 64);
    warm1 = *(const unsigned*)((tid < 256 ? Kh_n : Vh_n) + (long)(i1 >> 1) * LDK + (i1 & 1) * 64); }
  HALF_B(1, 0, NOP_(), SWRITE_I(2, 0));
  HALF_A(2, 1, do { if (mask_last) { asm volatile("; masked tail tile" ::: "memory"); const float NEG = -INFINITY; \
      _Pragma("unroll") for (int r = 8; r < 16; ++r) pA0[r] = NEG; _Pragma("unroll") for (int r = 0; r < 16; ++r) pA1[r] = NEG; } } while (0), NOP_(), NOP_());
#undef HALF_A
#undef HALF_B
#undef NOP_
  SBAR(); finishSM(pA0, pA1, alA, l_reg, pa0, pa1, pa2, pa3); SBAR();
  pv_i<2 * 16384>(o, vbi, pa0, pa1, pa2, pa3);
#undef SWRITE_I
  if (PARTIAL) {
    if (wid < 2) { float* po = PO + (wid * QBLK) * 128;
#pragma unroll
      for (int r = 0; r < 16; ++r) { const int orow = crow(r, hi);
#pragma unroll
        for (int d0 = 0; d0 < 4; ++d0) po[orow * 128 + d0 * 32 + r32] = o[d0][r]; }
      if (hi == 0) { PO[8192 + (wid * QBLK + r32) * 2] = m_reg; PO[8192 + (wid * QBLK + r32) * 2 + 1] = l_reg; } }
    __syncthreads();
    return;
  }
  if (hi == 0) li_l[r32] = l_reg; asm volatile("s_waitcnt lgkmcnt(0)" ::: "memory");
  float rli[16];
#pragma unroll
  for (int r = 0; r < 16; ++r) rli[r] = __builtin_amdgcn_rcpf(li_l[crow(r, hi)]);
  __syncthreads();
  unsigned short* stg = (unsigned short*)(lds + wid * 8192);
#pragma unroll
  for (int r = 0; r < 16; ++r) { const int orow = crow(r, hi);
#pragma unroll
    for (int d0 = 0; d0 < 4; ++d0) { const float v = o[d0][r] * rli[r]; stg[orow * 128 + d0 * 32 + r32] = (unsigned short)(cvtpk(v, v) & 0xffffu); } }
  asm volatile("s_waitcnt lgkmcnt(0)" ::: "memory");
#pragma unroll
  for (int it = 0; it < 8; ++it) { const int row = it * 4 + (lane >> 4), c16 = lane & 15;
    const bf16x8 v = *reinterpret_cast<const bf16x8*>((const char*)stg + row * 256 + c16 * 16);
    *reinterpret_cast<bf16x8*>(Ob + (long)(wid * QBLK + row) * LDO + c16 * 8) = v; }
  asm volatile("" :: "v"(warm0 ^ warm1));
  __syncthreads();
#undef SLOAD
#undef SLOADP
#undef SWRITE
#undef SWAIT
#undef RESC
}
#undef KSWZ
#undef SBAR
}

#define LAS __attribute__((address_space(3)))
typedef unsigned short bf16raw;
typedef short bf16x8 __attribute__((ext_vector_type(8)));
typedef float f32x4 __attribute__((ext_vector_type(4)));
typedef float f32x2 __attribute__((ext_vector_type(2)));
typedef unsigned u32x4 __attribute__((ext_vector_type(4)));
typedef unsigned u32x2 __attribute__((ext_vector_type(2)));

constexpr int DM = 1024, NB = 8, SEQ = 8192, NMETA = 16, LTOK = SEQ + NMETA, MTOK = NB * LTOK, MPAD = 65792;
constexpr int DFF = 2816, QKVD = 1536, NTHREADS = 512;
constexpr float RMS_EPS = 1e-6f;
constexpr int LDS_BYTES = 147456;
static_assert(MPAD % 256 == 0 && MPAD >= MTOK + 128, "row padding");
constexpr size_t WS_H = 0;
constexpr size_t WS_U = WS_H + (size_t)MPAD * DM * 4;
constexpr size_t WS_BIG = WS_U + (size_t)MPAD * DM * 2;
constexpr size_t WS_MB = WS_BIG + (size_t)MPAD * DFF * 2;
constexpr size_t WS_W = WS_MB + (size_t)MPAD * DM * 2;
constexpr size_t WO_LRU_IN = 0, WO_LRU_OUT = WO_LRU_IN + 2ul * 2048 * 1024, WO_GATE = WO_LRU_OUT + 2ul * 1024 * 1024, WO_QKV = WO_GATE + 64ul * 128 * 128,
                 WO_AO = WO_QKV + 2ul * 1536 * 1024, WO_F1 = WO_AO + 2ul * 1024 * 1024, WO_F2 = WO_F1 + 4ul * 5632 * 1024, WO_END = WO_F2 + 4ul * 1024 * 2816;
constexpr int LT = 48, NCHUNK = LTOK / LT;
static_assert(NCHUNK * LT == LTOK, "chunking");
constexpr size_t WS_SUM = WS_W + WO_END * 2;
constexpr size_t WS_CARRY = WS_SUM + (size_t)NB * NCHUNK * 2 * 1024 * 8;
constexpr size_t WS_ROPE = WS_CARRY + (size_t)NB * NCHUNK * 2 * 1024 * 4;
constexpr size_t WS_CTL = WS_ROPE + 128 * 32 * 8;
constexpr size_t WS_TAILP = WS_CTL + 16384;
constexpr size_t WS_END = WS_TAILP + 8ul * 128 * 1024 * 4;
constexpr int MREG = 65536, TAIL_S = 4, TAIL_S2 = 8;
constexpr int LDS_MISC = 147200;

__device__ __forceinline__ unsigned cvt_pk(float lo, float hi) { unsigned r; asm volatile("v_cvt_pk_bf16_f32 %0, %1, %2" : "=v"(r) : "v"(lo), "v"(hi)); return r; }
__device__ __forceinline__ float bf_lo(unsigned w) { return __uint_as_float(w << 16); }
__device__ __forceinline__ float bf_hi(unsigned w) { return __uint_as_float(w & 0xffff0000u); }
__device__ __forceinline__ float wave_sum(float v) {
#pragma unroll
    for (int o = 1; o < 64; o <<= 1) v += __shfl_xor(v, o);
    return v;
}
__device__ __forceinline__ float sigmoidf_fast(float x) { return __builtin_amdgcn_rcpf(1.0f + __builtin_amdgcn_exp2f(-1.4426950408889634f * x)); }
__device__ __forceinline__ float gelu_tanh(float x) {
    const float z = x * (1.0f + 0.044715f * x * x) * (2.0f * 0.7978845608028654f);
    return x * sigmoidf_fast(z);
}

struct EpiPlain {
    static constexpr bool PERM = true, AFTER_DRAIN = false, ALIGN = true;
    bf16raw* O; int ldc; const float* rs; float* tailp;
    __device__ __forceinline__ void operator()(const f32x4 (&acc)[2][2][4][2], const pg8::Unit& u, int wr, int wc, int fr, int fq) const {
        const int row0 = u.pm * 256 + wr * 64 + fr, col0 = u.pn * 256 + wc * 32 + 8 * fq;
        if (tailp && u.pm * 256 >= MREG) {
#pragma unroll
            for (int m = 0; m < 4; ++m) { float* rowp = tailp + ((size_t)u.part * 128 + wr * 64 + m * 16 + fr) * 1024 + col0;
#pragma unroll
                for (int bj = 0; bj < 2; ++bj) { *(f32x4*)(rowp + bj * 128) = acc[0][bj][m][0]; *(f32x4*)(rowp + bj * 128 + 4) = acc[0][bj][m][1]; } }
            return; }
#pragma unroll
        for (int ai = 0; ai < 2; ++ai)
#pragma unroll
            for (int m = 0; m < 4; ++m) { bf16raw* rowp = O + (size_t)(row0 + ai * 128 + m * 16) * ldc + col0; const float sc = rs ? rs[row0 + ai * 128 + m * 16] : 1.0f;
#pragma unroll
                for (int bj = 0; bj < 2; ++bj) { const f32x4 v0 = acc[ai][bj][m][0] * sc, v1 = acc[ai][bj][m][1] * sc;
                    u32x4 w; w.x = cvt_pk(v0[0], v0[1]); w.y = cvt_pk(v0[2], v0[3]); w.z = cvt_pk(v1[0], v1[1]); w.w = cvt_pk(v1[2], v1[3]);
                    *(u32x4*)(rowp + bj * 128) = w; } }
    }
};
struct EpiLruIn {
    static constexpr bool PERM = true, AFTER_DRAIN = false, ALIGN = true;
    bf16raw* Y; bf16raw* X; const float* rs;
    __device__ __forceinline__ void operator()(const f32x4 (&acc)[2][2][4][2], const pg8::Unit& u, int wr, int wc, int fr, int fq) const {
        const bool isy = u.pn < 4; bf16raw* base = isy ? Y : X;
        const int row0 = u.pm * 256 + wr * 64 + fr, col0 = (isy ? u.pn : u.pn - 4) * 256 + wc * 32 + 8 * fq;
#pragma unroll
        for (int ai = 0; ai < 2; ++ai)
#pragma unroll
            for (int m = 0; m < 4; ++m) { bf16raw* rowp = base + (size_t)(row0 + ai * 128 + m * 16) * DM + col0; const float sc = rs[row0 + ai * 128 + m * 16];
#pragma unroll
                for (int bj = 0; bj < 2; ++bj) { f32x4 v0 = acc[ai][bj][m][0] * sc, v1 = acc[ai][bj][m][1] * sc;
                    if (isy) {
#pragma unroll
                        for (int i = 0; i < 4; ++i) { v0[i] = gelu_tanh(v0[i]); v1[i] = gelu_tanh(v1[i]); } }
                    u32x4 w; w.x = cvt_pk(v0[0], v0[1]); w.y = cvt_pk(v0[2], v0[3]); w.z = cvt_pk(v1[0], v1[1]); w.w = cvt_pk(v1[2], v1[3]);
                    *(u32x4*)(rowp + bj * 128) = w; } }
    }
};
struct EpiSwiglu {
    static constexpr bool PERM = true, AFTER_DRAIN = false, ALIGN = true;
    bf16raw* O; const float* rs;
    __device__ __forceinline__ void operator()(const f32x4 (&acc)[2][2][4][2], const pg8::Unit& u, int wr, int wc, int fr, int fq) const {
        const int row0 = u.pm * 256 + wr * 64 + fr, col0 = u.pn * 128 + wc * 32 + 8 * fq;
#pragma unroll
        for (int ai = 0; ai < 2; ++ai)
#pragma unroll
            for (int m = 0; m < 4; ++m) { bf16raw* rowp = O + (size_t)(row0 + ai * 128 + m * 16) * DFF + col0; const float sc = rs[row0 + ai * 128 + m * 16];
                unsigned wv[4];
#pragma unroll
                for (int n = 0; n < 2; ++n)
#pragma unroll
                    for (int ip = 0; ip < 4; ip += 2) {
                        const f32x2 g = (f32x2){acc[ai][0][m][n][ip], acc[ai][0][m][n][ip + 1]} * sc, up = (f32x2){acc[ai][1][m][n][ip], acc[ai][1][m][n][ip + 1]} * sc;
                        const f32x2 t = g * (-1.4426950408889634f);
                        f32x2 ex; ex.x = __builtin_amdgcn_exp2f(t.x); ex.y = __builtin_amdgcn_exp2f(t.y);
                        ex = ex + 1.0f;
                        f32x2 rc; rc.x = __builtin_amdgcn_rcpf(ex.x); rc.y = __builtin_amdgcn_rcpf(ex.y);
                        const f32x2 r = g * rc * up;
                        wv[n * 2 + (ip >> 1)] = cvt_pk(r.x, r.y); }
                u32x4 w; w.x = wv[0]; w.y = wv[1]; w.z = wv[2]; w.w = wv[3];
                *(u32x4*)rowp = w; }
    }
};

struct EpiQkv {
    static constexpr bool PERM = true, AFTER_DRAIN = false, ALIGN = true;
    bf16raw* O; const float* rs; const float* qg; const float* kg; const f32x2* tab; LAS float* ss;
    __device__ __forceinline__ void operator()(const f32x4 (&acc)[2][2][4][2], const pg8::Unit& u, int wr, int wc, int fr, int fq) const {
        const int row0 = u.pm * 256 + wr * 64 + fr, col0 = u.pn * 256 + wc * 32 + 8 * fq;
        if (u.pn == 5) {
#pragma unroll
            for (int ai = 0; ai < 2; ++ai)
#pragma unroll
                for (int m = 0; m < 4; ++m) { bf16raw* rowp = O + (size_t)(row0 + ai * 128 + m * 16) * QKVD + col0; const float sc = rs[row0 + ai * 128 + m * 16];
#pragma unroll
                    for (int bj = 0; bj < 2; ++bj) { const f32x4 v0 = acc[ai][bj][m][0] * sc, v1 = acc[ai][bj][m][1] * sc;
                        u32x4 w; w.x = cvt_pk(v0[0], v0[1]); w.y = cvt_pk(v0[2], v0[3]); w.z = cvt_pk(v1[0], v1[1]); w.w = cvt_pk(v1[2], v1[3]);
                        *(u32x4*)(rowp + bj * 128) = w; } }
            return; }
#pragma unroll
        for (int ai = 0; ai < 2; ++ai)
#pragma unroll
            for (int m = 0; m < 4; ++m) { const float sc = rs[row0 + ai * 128 + m * 16];
#pragma unroll
                for (int bj = 0; bj < 2; ++bj) { const f32x4 v0 = acc[ai][bj][m][0] * sc, v1 = acc[ai][bj][m][1] * sc;
                    float s = (v0[0] * v0[0] + v0[1] * v0[1]) + (v0[2] * v0[2] + v0[3] * v0[3]) + (v1[0] * v1[0] + v1[1] * v1[1]) + (v1[2] * v1[2] + v1[3] * v1[3]);
                    s += __shfl_xor(s, 16); s += __shfl_xor(s, 32);
                    if (fq == 0) ss[(bj * 4 + wc) * 256 + ai * 128 + wr * 64 + m * 16 + fr] = s; } }
        asm volatile("s_waitcnt lgkmcnt(0)" ::: "memory"); __builtin_amdgcn_s_barrier(); asm volatile("" ::: "memory");
        const int axis = wc >> 1, p0 = (wc & 1) * 16 + 4 * fq, d1 = axis * 64 + p0;
        const float* gsrc = (u.pn == 4) ? kg : qg; const float qsc = (u.pn == 4) ? 1.0f : 0.088388347648318440f * 1.4426950408889634f;
        const f32x4 g1 = *(const f32x4*)(gsrc + d1), g2 = *(const f32x4*)(gsrc + d1 + 32);
#pragma unroll
        for (int ai = 0; ai < 2; ++ai)
#pragma unroll
            for (int m = 0; m < 4; ++m) { const int row = row0 + ai * 128 + m * 16, rl = ai * 128 + wr * 64 + m * 16 + fr; const float sc = rs[row];
                const int rr = row < MTOK ? row : 0, b = rr / LTOK, t = rr - b * LTOK;
                f32x4 cc = (f32x4){1.f, 1.f, 1.f, 1.f}, sn = (f32x4){0.f, 0.f, 0.f, 0.f};
                if (t >= NMETA) { const int s = t - NMETA, pos = axis ? (s & 63) : (s >> 6); const f32x4 t0 = *(const f32x4*)(tab + pos * 32 + p0), t1 = *(const f32x4*)(tab + pos * 32 + p0 + 2);
                    cc = (f32x4){t0[0], t0[2], t1[0], t1[2]}; sn = (f32x4){t0[1], t0[3], t1[1], t1[3]}; }
                bf16raw* rowp = O + (size_t)row * QKVD + col0;
#pragma unroll
                for (int bj = 0; bj < 2; ++bj) { const LAS float* sp = ss + bj * 1024 + rl;
                    const float tot = (sp[0] + sp[256]) + (sp[512] + sp[768]);
                    const float rn = (1.0f / sqrtf(tot * (1.0f / 128.0f) + RMS_EPS)) * sc * qsc;
                    const f32x4 n1 = acc[ai][bj][m][0] * rn * g1, n2 = acc[ai][bj][m][1] * rn * g2;
                    const f32x4 o1 = n1 * cc - n2 * sn, o2 = n2 * cc + n1 * sn;
                    u32x4 w; w.x = cvt_pk(o1[0], o1[1]); w.y = cvt_pk(o1[2], o1[3]); w.z = cvt_pk(o2[0], o2[1]); w.w = cvt_pk(o2[2], o2[3]);
                    *(u32x4*)(rowp + bj * 128) = w; } }
    }
};

__device__ __forceinline__ void transpose_item(const float* W, int K, int N, bf16raw* WT, int perm, const float* gk, LAS float* scr, int item, int lane) {
    const int nblk = N / 32, kb = item / nblk, nb = item % nblk, k0 = 64 * kb, n0 = 32 * nb;
    int d0 = n0;
    if (perm == 1) { const int j = n0 < DFF ? n0 : n0 - DFF; d0 = (j >> 7) * 256 + (j & 127) + (n0 < DFF ? 0 : 128); }
#pragma unroll 8
    for (int i = 0; i < 32; ++i) { const int kk = 2 * i + (lane >> 5); const float gsc = gk ? gk[k0 + kk] : 1.0f; scr[kk * 33 + (lane & 31)] = W[(size_t)(k0 + kk) * N + n0 + (lane & 31)] * gsc; }
    asm volatile("s_waitcnt lgkmcnt(0)" ::: "memory");
    const int c = lane & 7;
#pragma unroll
    for (int j = 0; j < 4; ++j) { const int n = (lane >> 3) + 8 * j; const LAS float* s = scr + (8 * c) * 33 + n;
        u32x4 o; o.x = cvt_pk(s[0 * 33], s[1 * 33]); o.y = cvt_pk(s[2 * 33], s[3 * 33]); o.z = cvt_pk(s[4 * 33], s[5 * 33]); o.w = cvt_pk(s[6 * 33], s[7 * 33]);
        int dr = d0 + n;
        if (perm == 2) { const int ns = n0 + n; if (ns < 1280) { const int hd = ns >> 7, d = ns & 127, ax = d >> 6, hf = (d >> 5) & 1, p = d & 31;
                dr = hd * 128 + 32 * (ax * 2 + (p >> 4)) + 8 * ((p >> 2) & 3) + 4 * hf + (p & 3); } }
        *(u32x4*)(WT + (size_t)dr * K + k0 + 8 * c) = o; }
    asm volatile("s_waitcnt lgkmcnt(0)" ::: "memory");
}
__device__ __forceinline__ void convert_group(const float* W, int K, int N, int nmat, bf16raw* WT, int perm, const float* gbase, int gstride, LAS float* scr, int gw, int NGW, int lane) {
    const int per = (K / 64) * (N / 32), total = per * nmat;
    for (int it = gw; it < total; it += NGW) { const int mt = it / per, r = it % per;
        transpose_item(W + (size_t)mt * K * N, K, N, WT + (size_t)mt * K * N, perm, gbase ? gbase + (size_t)mt * gstride : nullptr, scr, r, lane); }
}

struct Row16 { f32x4 v[4]; };
__device__ __forceinline__ void ld_row_f32(Row16& r, const float* p, int lane) {
    const f32x4* q = (const f32x4*)(p + 8 * lane); r.v[0] = q[0]; r.v[1] = q[1]; r.v[2] = q[128]; r.v[3] = q[129];
}
__device__ __forceinline__ void st_row_f32(const Row16& r, float* p, int lane) {
    f32x4* q = (f32x4*)(p + 8 * lane); q[0] = r.v[0]; q[1] = r.v[1]; q[128] = r.v[2]; q[129] = r.v[3];
}
__device__ __forceinline__ void ld_row_bf16(Row16& r, const bf16raw* p, int lane) {
    const u32x4 a = *(const u32x4*)(p + 8 * lane), b = *(const u32x4*)(p + 512 + 8 * lane);
    r.v[0] = (f32x4){bf_lo(a.x), bf_hi(a.x), bf_lo(a.y), bf_hi(a.y)}; r.v[1] = (f32x4){bf_lo(a.z), bf_hi(a.z), bf_lo(a.w), bf_hi(a.w)};
    r.v[2] = (f32x4){bf_lo(b.x), bf_hi(b.x), bf_lo(b.y), bf_hi(b.y)}; r.v[3] = (f32x4){bf_lo(b.z), bf_hi(b.z), bf_lo(b.w), bf_hi(b.w)};
}
__device__ __forceinline__ void st_row_bf16(const Row16& r, bf16raw* p, int lane) {
    u32x4 a, b; a.x = cvt_pk(r.v[0][0], r.v[0][1]); a.y = cvt_pk(r.v[0][2], r.v[0][3]); a.z = cvt_pk(r.v[1][0], r.v[1][1]); a.w = cvt_pk(r.v[1][2], r.v[1][3]);
    b.x = cvt_pk(r.v[2][0], r.v[2][1]); b.y = cvt_pk(r.v[2][2], r.v[2][3]); b.z = cvt_pk(r.v[3][0], r.v[3][1]); b.w = cvt_pk(r.v[3][2], r.v[3][3]);
    *(u32x4*)(p + 8 * lane) = a; *(u32x4*)(p + 512 + 8 * lane) = b;
}
__device__ __forceinline__ float row_rstd(const Row16& r) {
    float s = 0.f;
#pragma unroll
    for (int j = 0; j < 4; ++j) s += (r.v[j][0] * r.v[j][0] + r.v[j][1] * r.v[j][1]) + (r.v[j][2] * r.v[j][2] + r.v[j][3] * r.v[j][3]);
    return 1.0f / sqrtf(wave_sum(s) * (1.0f / DM) + RMS_EPS);
}
struct RawPair { u32x4 r[8]; };
__device__ __forceinline__ void rp_load(RawPair& p, const bf16raw* MB, const bf16raw* U, int m0, int NGW, int lane) {
    const int m1 = m0 + NGW, m1c = m1 < MREG ? m1 : m0;
    p.r[0] = *(const u32x4*)(MB + (size_t)m0 * DM + 8 * lane); p.r[1] = *(const u32x4*)(MB + (size_t)m0 * DM + 512 + 8 * lane);
    p.r[2] = *(const u32x4*)(U + (size_t)m0 * DM + 8 * lane);  p.r[3] = *(const u32x4*)(U + (size_t)m0 * DM + 512 + 8 * lane);
    p.r[4] = *(const u32x4*)(MB + (size_t)m1c * DM + 8 * lane); p.r[5] = *(const u32x4*)(MB + (size_t)m1c * DM + 512 + 8 * lane);
    p.r[6] = *(const u32x4*)(U + (size_t)m1c * DM + 8 * lane);  p.r[7] = *(const u32x4*)(U + (size_t)m1c * DM + 512 + 8 * lane);
}
__device__ __forceinline__ void rp_unpack(Row16& r, const u32x4 a, const u32x4 b) {
    r.v[0] = (f32x4){bf_lo(a.x), bf_hi(a.x), bf_lo(a.y), bf_hi(a.y)}; r.v[1] = (f32x4){bf_lo(a.z), bf_hi(a.z), bf_lo(a.w), bf_hi(a.w)};
    r.v[2] = (f32x4){bf_lo(b.x), bf_hi(b.x), bf_lo(b.y), bf_hi(b.y)}; r.v[3] = (f32x4){bf_lo(b.z), bf_hi(b.z), bf_lo(b.w), bf_hi(b.w)};
}
__device__ __forceinline__ void rp_process(const RawPair& p, int mode, int m0, int NGW, bf16raw* U, float* RS, const Row16& gp, float* out, int lane) {
    const int m1 = m0 + NGW; const bool has1 = m1 < MREG;
    Row16 mv0, h0, mv1, h1;
    rp_unpack(mv0, p.r[0], p.r[1]); rp_unpack(h0, p.r[2], p.r[3]); rp_unpack(mv1, p.r[4], p.r[5]); rp_unpack(h1, p.r[6], p.r[7]);
    const float ra = row_rstd(mv0), rb = row_rstd(mv1);
#pragma unroll
    for (int j = 0; j < 4; ++j) { h0.v[j] = h0.v[j] + mv0.v[j] * ra * gp.v[j]; h1.v[j] = h1.v[j] + mv1.v[j] * rb * gp.v[j]; }
    if (mode == 2) {
        { const int b = m0 / LTOK, t = m0 - b * LTOK; if (t >= NMETA) st_row_f32(h0, out + ((size_t)b * SEQ + (t - NMETA)) * DM, lane); }
        if (has1) { const int b = m1 / LTOK, t = m1 - b * LTOK; if (t >= NMETA) st_row_f32(h1, out + ((size_t)b * SEQ + (t - NMETA)) * DM, lane); }
        return; }
    st_row_bf16(h0, U + (size_t)m0 * DM, lane);
    if (has1) st_row_bf16(h1, U + (size_t)m1 * DM, lane);
    const float r0 = row_rstd(h0), r1 = row_rstd(h1);
    if (lane == 0) { RS[m0] = r0; if (has1) RS[m1] = r1; }
}
__device__ __forceinline__ void resid_pass(int mode, const float* x, const float* meta, const bf16raw* MB, bf16raw* U, float* RS, bf16raw* OB, const float* g_post, float* out,
                                           int gw, int NGW, int lane, const float* tailp = nullptr, int nparts = TAIL_S) {
    Row16 gp;
    if (mode != 0) ld_row_f32(gp, g_post, lane);
    if (mode == 0) {
        for (int m0 = gw; m0 < MPAD; m0 += 2 * NGW) {
            const int m1 = m0 + NGW; const bool has1 = m1 < MPAD; const int m1c = has1 ? m1 : m0;
            const bool pad0 = m0 >= MTOK, pad1 = m1c >= MTOK;
            const int mm0 = pad0 ? 0 : m0, mm1 = pad1 ? 0 : m1c;
            const int b0 = mm0 / LTOK, t0 = mm0 - b0 * LTOK, b1 = mm1 / LTOK, t1 = mm1 - b1 * LTOK;
            Row16 h0, h1;
            ld_row_f32(h0, (t0 < NMETA) ? meta + (size_t)t0 * DM : x + ((size_t)b0 * SEQ + (t0 - NMETA)) * DM, lane);
            ld_row_f32(h1, (t1 < NMETA) ? meta + (size_t)t1 * DM : x + ((size_t)b1 * SEQ + (t1 - NMETA)) * DM, lane);
#pragma unroll
            for (int k = 0; k < 2; ++k) { const int m = k ? m1 : m0; const bool pad = k ? pad1 : pad0; if (k && !has1) break;
                const Row16& h = k ? h1 : h0;
                if (pad) {
                    const u32x4 z = (u32x4){0u, 0u, 0u, 0u};
                    *(u32x4*)(U + (size_t)m * DM + 8 * lane) = z; *(u32x4*)(U + (size_t)m * DM + 512 + 8 * lane) = z;
                    *(u32x4*)(OB + (size_t)m * DM + 8 * lane) = z; *(u32x4*)(OB + (size_t)m * DM + 512 + 8 * lane) = z;
                    if (lane == 0) RS[m] = 0.f;
                } else {
                    st_row_bf16(h, U + (size_t)m * DM, lane);
                    const float rs2 = row_rstd(h);
                    if (lane == 0) RS[m] = rs2; } }
        }
        return;
    }
    if (gw < MTOK - MREG) { const int m = MREG + gw; Row16 mv, t1, h;
        ld_row_f32(mv, tailp + (size_t)gw * DM, lane);
        for (int p = 1; p < nparts; ++p) { ld_row_f32(t1, tailp + ((size_t)p * 128 + gw) * DM, lane);
#pragma unroll
            for (int j = 0; j < 4; ++j) mv.v[j] = mv.v[j] + t1.v[j]; }
        ld_row_bf16(h, U + (size_t)m * DM, lane);
        const float ra = row_rstd(mv);
#pragma unroll
        for (int j = 0; j < 4; ++j) h.v[j] = h.v[j] + mv.v[j] * ra * gp.v[j];
        if (mode == 2) { const int b = m / LTOK, t = m - b * LTOK; if (t >= NMETA) st_row_f32(h, out + ((size_t)b * SEQ + (t - NMETA)) * DM, lane); }
        else { st_row_bf16(h, U + (size_t)m * DM, lane); const float r2 = row_rstd(h); if (lane == 0) RS[m] = r2; }
    }
    RawPair A, B; const int S = 2 * NGW; int m0 = gw;
    if (m0 < MREG) rp_load(A, MB, U, m0, NGW, lane);
    while (m0 < MREG) {
        if (m0 + S < MREG) rp_load(B, MB, U, m0 + S, NGW, lane);
        rp_process(A, mode, m0, NGW, U, RS, gp, out, lane);
        m0 += S; if (m0 >= MREG) break;
        if (m0 + S < MREG) rp_load(A, MB, U, m0 + S, NGW, lane);
        rp_process(B, mode, m0, NGW, U, RS, gp, out, lane);
        m0 += S;
    }
}

__device__ __forceinline__ void rope_pass(bf16raw* QKV, const float* qg, const float* kg, const f32x2* tab, int gw, int NGW, int lane) {
    const int hsel = lane >> 5, within = lane & 31, axis = within >> 4, s16 = within & 15, d1 = axis * 64 + 2 * s16, d2 = d1 + 32;
    const f32x2 gq1 = *(const f32x2*)(qg + d1), gq2 = *(const f32x2*)(qg + d2), gk1 = *(const f32x2*)(kg + d1), gk2 = *(const f32x2*)(kg + d2);
    for (int m = gw; m < MTOK; m += NGW) {
        const int b = m / LTOK, t = m - b * LTOK;
        f32x2 cs0 = (f32x2){1.f, 0.f}, cs1 = (f32x2){1.f, 0.f};
        if (t >= NMETA) { const int s = t - NMETA, pos = axis ? (s & 63) : (s >> 6); cs0 = tab[pos * 32 + 2 * s16]; cs1 = tab[pos * 32 + 2 * s16 + 1]; }
        bf16raw* rowp = QKV + (size_t)m * QKVD;
        unsigned w1[5], w2[5];
#pragma unroll
        for (int st = 0; st < 5; ++st) { const int hd = 2 * st + hsel; w1[st] = *(const unsigned*)(rowp + hd * 128 + d1); w2[st] = *(const unsigned*)(rowp + hd * 128 + d2); }
#pragma unroll
        for (int st = 0; st < 5; ++st) { const int hd = 2 * st + hsel;
            const float x1a = bf_lo(w1[st]), x1b = bf_hi(w1[st]), x2a = bf_lo(w2[st]), x2b = bf_hi(w2[st]);
            float ss = (x1a * x1a + x1b * x1b) + (x2a * x2a + x2b * x2b);
            ss += __shfl_xor(ss, 1); ss += __shfl_xor(ss, 2); ss += __shfl_xor(ss, 4); ss += __shfl_xor(ss, 8); ss += __shfl_xor(ss, 16);
            const float rs = 1.0f / sqrtf(ss * (1.0f / 128.0f) + RMS_EPS);
            const bool isq = (st < 4);
            const f32x2 g1 = isq ? gq1 : gk1, g2 = isq ? gq2 : gk2;
            const float n1a = x1a * rs * g1.x, n1b = x1b * rs * g1.y, n2a = x2a * rs * g2.x, n2b = x2b * rs * g2.y;
            const float o1a = n1a * cs0.x - n2a * cs0.y, o2a = n2a * cs0.x + n1a * cs0.y;
            const float o1b = n1b * cs1.x - n2b * cs1.y, o2b = n2b * cs1.x + n1b * cs1.y;
            *(unsigned*)(rowp + hd * 128 + d1) = cvt_pk(o1a, o1b); *(unsigned*)(rowp + hd * 128 + d2) = cvt_pk(o2a, o2b); }
    }
}

constexpr int L_XCF = 0, L_XCB = 24576, L_CC = 37632, L_AB = 40960, AB_RS = 132, AB_PL = LT * AB_RS;
static_assert(L_AB + 2 * AB_PL * 4 <= LDS_MISC && L_CC + 5 * 128 * 4 <= L_AB, "LRU LDS");
struct LruW { bf16x8 f[2][2][4]; };
struct LruC { float br[2], bi[2], k8[2]; };
__device__ __forceinline__ void lru_load_w(LruW& w, LruC& cc, const bf16raw* Wg, const float* gate_b, const float* lam, int slot, int n, int wid, int lane) {
    const int dir = wid >> 2, cq = wid & 3, fr = lane & 15, fq = lane >> 4;
#pragma unroll
    for (int g = 0; g < 2; ++g)
#pragma unroll
        for (int nt = 0; nt < 2; ++nt)
#pragma unroll
            for (int ks = 0; ks < 4; ++ks)
                w.f[g][nt][ks] = *(const bf16x8*)(Wg + ((size_t)((((slot * 2 + dir) * 2 + g) * 8 + n) * 128 + cq * 32 + nt * 16 + fr)) * 128 + ks * 32 + fq * 8);
#pragma unroll
    for (int nt = 0; nt < 2; ++nt) { const int gch = n * 128 + cq * 32 + nt * 16 + fr;
        cc.br[nt] = gate_b[((size_t)(slot * 2 + dir) * 2 + 0) * DM + gch]; cc.bi[nt] = gate_b[((size_t)(slot * 2 + dir) * 2 + 1) * DM + gch];
        const float lm = lam[(size_t)(slot * 2 + dir) * DM + gch];
        const float sp = (lm > 15.f) ? __expf(-lm) : log1pf(__expf(-lm));
        cc.k8[nt] = -8.0f * sp * 1.4426950408889634f; }
}
struct LruX { u32x4 r[5]; };
__device__ __forceinline__ void lru_fetch_x(LruX& xr, const bf16raw* X, int b, int c, int n, int tid) {
    const int cgp = tid & 15, pr = tid >> 4;
    if (pr < 24) {
#pragma unroll
        for (int k = 0; k < 5; ++k) { const int tt = c * LT + 2 * pr - 2 + k;
            xr.r[k] = (tt >= 0 && tt < LTOK) ? *(const u32x4*)(X + ((size_t)b * LTOK + tt) * DM + n * 128 + cgp * 8) : (u32x4){0u, 0u, 0u, 0u}; } }
}
template <bool FINAL, bool REV>
__device__ __forceinline__ void lru_scan(const f32x4 (&acc)[3][2][2], LAS float* HF, f32x2* SUMS, size_t sbase, float hin0, float hin1, int cq, int fr, int fq, int lane) {
    const int rank = REV ? 3 - fq : fq;
    const int src1 = (REV ? lane + 16 : lane - 16) & 63, src2 = (REV ? lane + 32 : lane - 32) & 63, srcT = REV ? fr : fr + 48;
#pragma unroll
    for (int nt = 0; nt < 2; ++nt) {
        float Pe[3], Qe[3], Pt[3], Qt[3];
#pragma unroll
        for (int mt = 0; mt < 3; ++mt) { float p = 1.f, q = 0.f;
#pragma unroll
            for (int ii = 0; ii < 4; ++ii) { const int i = REV ? 3 - ii : ii; const float a = acc[mt][0][nt][i]; q = a * q + acc[mt][1][nt][i]; p *= a; }
            { const float pp = __shfl(p, src1), qp = __shfl(q, src1); if (rank >= 1) { q = qp * p + q; p = pp * p; } }
            { const float pp = __shfl(p, src2), qp = __shfl(q, src2); if (rank >= 2) { q = qp * p + q; p = pp * p; } }
            Pt[mt] = __shfl(p, srcT); Qt[mt] = __shfl(q, srcT);
            if (FINAL) { const float pe = __shfl(p, src1), qe = __shfl(q, src1); Pe[mt] = rank >= 1 ? pe : 1.f; Qe[mt] = rank >= 1 ? qe : 0.f; } }
        if (!FINAL) { float A = 1.f, Bv = 0.f;
#pragma unroll
            for (int mm = 0; mm < 3; ++mm) { const int mt = REV ? 2 - mm : mm; Bv = Bv * Pt[mt] + Qt[mt]; A *= Pt[mt]; }
            if (fq == 0) SUMS[sbase + 16 * nt] = (f32x2){A, Bv};
        } else { float hseg = nt ? hin1 : hin0; const int ch = cq * 32 + nt * 16 + fr;
#pragma unroll
            for (int mm = 0; mm < 3; ++mm) { const int mt = REV ? 2 - mm : mm;
                float h = Pe[mt] * hseg + Qe[mt];
#pragma unroll
                for (int ii = 0; ii < 4; ++ii) { const int i = REV ? 3 - ii : ii; h = acc[mt][0][nt][i] * h + acc[mt][1][nt][i];
                    HF[(REV ? AB_PL : 0) + (mt * 16 + fq * 4 + i) * AB_RS + ch] = h; }
                hseg = Pt[mt] * hseg + Qt[mt]; } }
    }
}
#define LDS_BAR() do { asm volatile("s_waitcnt lgkmcnt(0)" ::: "memory"); __builtin_amdgcn_s_barrier(); asm volatile("" ::: "memory"); } while (0)
template <bool FINAL>
__device__ __forceinline__ void lru_pass(LAS unsigned char* lds, int slot, const bf16raw* Wg, const bf16raw* X, bf16raw* Y, const float* conv_w, const float* conv_b,
                                         const float* gate_b, const float* lam, f32x2* SUMS, const float* CARRY, int G, int bid, int tid0, int wid, int lane0) {
    constexpr int NTILES = 8 * NB * NCHUNK, PERN = NB * NCHUNK;
    const int lo = (int)(((long)bid * NTILES) / G), hi = (int)(((long)(bid + 1) * NTILES) / G);
    LAS float* XCF = (LAS float*)(lds + L_XCF); LAS unsigned char* XCB = lds + L_XCB; LAS float* CC = (LAS float*)(lds + L_CC); LAS float* HF = (LAS float*)(lds + L_AB);
    const int dir = wid >> 2, cq = wid & 3;
    LruW w; LruC cc; LruX xr; int curn = -1;
    if (lo < hi) { const int n = lo / PERN, rem = lo - n * PERN, b = rem / NCHUNK, c = rem - b * NCHUNK; lru_fetch_x(xr, X, b, c, n, tid0); }
    for (int tau = lo; tau < hi; ++tau) { const int n = tau / PERN, rem = tau - n * PERN, b = rem / NCHUNK, c = rem - b * NCHUNK;
        const size_t row0 = (size_t)b * LTOK + c * LT;
        int tid = tid0; asm volatile("" : "+v"(tid));
        const int lane = tid & 63, fr = lane & 15, fq = lane >> 4, cgp = tid & 15, pr = tid >> 4;
        if (n != curn) { lru_load_w(w, cc, Wg, gate_b, lam, slot, n, wid, lane); curn = n;
            for (int i = tid; i < 5 * 128; i += NTHREADS) CC[i] = (i < 512) ? conv_w[(size_t)slot * 4 * DM + (i >> 7) * DM + n * 128 + (i & 127)] : conv_b[(size_t)slot * DM + n * 128 + (i & 127)];
            __syncthreads(); }
        const size_t sbase = ((size_t)(b * NCHUNK + c) * 2 + dir) * DM + n * 128 + cq * 32 + fr;
        float hin0 = 0.f, hin1 = 0.f;
        if (FINAL) { hin0 = CARRY[sbase]; hin1 = CARRY[sbase + 16]; }
        if (pr < 24) {
            f32x4 xa[5], xb[5];
#pragma unroll
            for (int k = 0; k < 5; ++k) { const u32x4 v = xr.r[k]; xa[k] = (f32x4){bf_lo(v.x), bf_hi(v.x), bf_lo(v.y), bf_hi(v.y)}; xb[k] = (f32x4){bf_lo(v.z), bf_hi(v.z), bf_lo(v.w), bf_hi(v.w)}; }
#pragma unroll
            for (int j = 0; j < 2; ++j) { f32x4 a0 = *(const LAS f32x4*)(CC + 512 + cgp * 8), a1 = *(const LAS f32x4*)(CC + 512 + cgp * 8 + 4);
#pragma unroll
                for (int k = 0; k < 4; ++k) { a0 += *(const LAS f32x4*)(CC + k * 128 + cgp * 8) * xa[j + k]; a1 += *(const LAS f32x4*)(CC + k * 128 + cgp * 8 + 4) * xb[j + k]; }
                const int t = 2 * pr + j;
                *(LAS f32x4*)(XCF + t * 128 + cgp * 8) = a0; *(LAS f32x4*)(XCF + t * 128 + cgp * 8 + 4) = a1;
                u32x4 pk; pk.x = cvt_pk(a0[0], a0[1]); pk.y = cvt_pk(a0[2], a0[3]); pk.z = cvt_pk(a1[0], a1[1]); pk.w = cvt_pk(a1[2], a1[3]);
                *(LAS u32x4*)(XCB + t * 272 + cgp * 16) = pk; }
        }
        if (tau + 1 < hi) { const int t2 = tau + 1, n2 = t2 / PERN, rem2 = t2 - n2 * PERN, b2 = rem2 / NCHUNK, c2 = rem2 - b2 * NCHUNK; lru_fetch_x(xr, X, b2, c2, n2, tid); }
        LDS_BAR();
        f32x4 acc[3][2][2];
#pragma unroll
        for (int mt = 0; mt < 3; ++mt)
#pragma unroll
            for (int g = 0; g < 2; ++g)
#pragma unroll
                for (int nt = 0; nt < 2; ++nt) acc[mt][g][nt] = (f32x4){0.f, 0.f, 0.f, 0.f};
#pragma unroll
        for (int ks = 0; ks < 4; ++ks) {
#pragma unroll
            for (int mt = 0; mt < 3; ++mt) { const bf16x8 af = *(const LAS bf16x8*)(XCB + (mt * 16 + fr) * 272 + (ks * 32 + fq * 8) * 2);
#pragma unroll
                for (int g = 0; g < 2; ++g)
#pragma unroll
                    for (int nt = 0; nt < 2; ++nt) acc[mt][g][nt] = __builtin_amdgcn_mfma_f32_16x16x32_bf16(af, w.f[g][nt][ks], acc[mt][g][nt], 0, 0, 0); } }
#pragma unroll
        for (int nt = 0; nt < 2; ++nt) { const int ch = cq * 32 + nt * 16 + fr;
            const float nbr = -1.4426950408889634f * cc.br[nt], nbi = -1.4426950408889634f * cc.bi[nt], k8 = cc.k8[nt];
#pragma unroll
            for (int mt = 0; mt < 3; ++mt)
#pragma unroll
                for (int ip = 0; ip < 4; ip += 2) { const int tk = mt * 16 + fq * 4 + ip;
                    const f32x2 xr2 = (f32x2){acc[mt][0][nt][ip], acc[mt][0][nt][ip + 1]}, xi2 = (f32x2){acc[mt][1][nt][ip], acc[mt][1][nt][ip + 1]};
                    const f32x2 tr = xr2 * (-1.4426950408889634f) + nbr, ti = xi2 * (-1.4426950408889634f) + nbi;
                    f32x2 er, ei; er.x = __builtin_amdgcn_exp2f(tr.x); er.y = __builtin_amdgcn_exp2f(tr.y); ei.x = __builtin_amdgcn_exp2f(ti.x); ei.y = __builtin_amdgcn_exp2f(ti.y);
                    er = er + 1.0f; ei = ei + 1.0f;
                    f32x2 r, ig; r.x = __builtin_amdgcn_rcpf(er.x); r.y = __builtin_amdgcn_rcpf(er.y); ig.x = __builtin_amdgcn_rcpf(ei.x); ig.y = __builtin_amdgcn_rcpf(ei.y);
                    const f32x2 la = r * k8;
                    f32x2 a; a.x = __builtin_amdgcn_exp2f(la.x); a.y = __builtin_amdgcn_exp2f(la.y);
                    const f32x2 y = 1.0f - a * a;
                    f32x2 sq; sq.x = __builtin_amdgcn_sqrtf(y.x); sq.y = __builtin_amdgcn_sqrtf(y.y);
                    const f32x2 xc2 = (f32x2){XCF[tk * 128 + ch], XCF[(tk + 1) * 128 + ch]};
                    const f32x2 bb = sq * ig * xc2;
                    acc[mt][0][nt][ip] = a.x; acc[mt][0][nt][ip + 1] = a.y; acc[mt][1][nt][ip] = bb.x; acc[mt][1][nt][ip + 1] = bb.y; } }
        if (dir) lru_scan<FINAL, true>(acc, HF, SUMS, sbase, hin0, hin1, cq, fr, fq, lane);
        else     lru_scan<FINAL, false>(acc, HF, SUMS, sbase, hin0, hin1, cq, fr, fq, lane);
        if (FINAL) {
            const u32x4 yv0 = (pr < 24) ? *(const u32x4*)(Y + (row0 + 2 * pr) * DM + n * 128 + cgp * 8) : (u32x4){0u, 0u, 0u, 0u};
            const u32x4 yv1 = (pr < 24) ? *(const u32x4*)(Y + (row0 + 2 * pr + 1) * DM + n * 128 + cgp * 8) : (u32x4){0u, 0u, 0u, 0u};
            LDS_BAR();
            if (pr < 24) {
#pragma unroll
                for (int j = 0; j < 2; ++j) { const int t = 2 * pr + j; const u32x4 yv = j ? yv1 : yv0;
                    const LAS float* hf = HF + t * AB_RS + cgp * 8; const LAS float* hb = HF + AB_PL + t * AB_RS + cgp * 8;
                    const f32x4 f0 = *(const LAS f32x4*)hf, f1 = *(const LAS f32x4*)(hf + 4), b0 = *(const LAS f32x4*)hb, b1 = *(const LAS f32x4*)(hb + 4);
                    const f32x4 z0 = (f0 + b0) * (f32x4){bf_lo(yv.x), bf_hi(yv.x), bf_lo(yv.y), bf_hi(yv.y)}, z1 = (f1 + b1) * (f32x4){bf_lo(yv.z), bf_hi(yv.z), bf_lo(yv.w), bf_hi(yv.w)};
                    u32x4 o; o.x = cvt_pk(z0[0], z0[1]); o.y = cvt_pk(z0[2], z0[3]); o.z = cvt_pk(z1[0], z1[1]); o.w = cvt_pk(z1[2], z1[3]);
                    *(u32x4*)(Y + (row0 + t) * DM + n * 128 + cgp * 8) = o; } }
        }
        LDS_BAR();
    }
}
__device__ __forceinline__ void lru_carry(LAS unsigned char* lds, const f32x2* SUMS, float* CARRY, int G, int bid, int wid, int lane) {
    LAS f32x2* XS = (LAS f32x2*)lds;
    for (int cb = bid; cb < NB * 2 * (DM / 64); cb += G) { const int bd = cb >> 4, b = bd >> 1, sd = bd & 1, gch = (cb & 15) * 64 + lane;
        const int q0 = wid * 21 + (wid < 3 ? wid : 3), qn = 21 + (wid < 3 ? 1 : 0);
        f32x2 ab[22]; float P = 1.f, Q = 0.f;
#pragma unroll
        for (int i = 0; i < 22; ++i) { const int q = q0 + i, c = sd ? (NCHUNK - 1 - q) : q;
            ab[i] = (i < qn) ? SUMS[((size_t)(b * NCHUNK + c) * 2 + sd) * DM + gch] : (f32x2){1.f, 0.f}; }
#pragma unroll
        for (int i = 0; i < 22; ++i) { Q = ab[i].x * Q + ab[i].y; P *= ab[i].x; }
        XS[wid * 64 + lane] = (f32x2){P, Q};
        __syncthreads();
        float h = 0.f;
        for (int s2 = 0; s2 < wid; ++s2) { const f32x2 t = XS[s2 * 64 + lane]; h = t.x * h + t.y; }
#pragma unroll
        for (int i = 0; i < 22; ++i) { const int q = q0 + i, c = sd ? (NCHUNK - 1 - q) : q;
            if (i < qn) CARRY[((size_t)(b * NCHUNK + c) * 2 + sd) * DM + gch] = h;
            h = ab[i].x * h + ab[i].y; }
        __syncthreads();
    }
}

typedef unsigned v4u __attribute__((ext_vector_type(4)));
#define XB_TMO      128
#define XB_XCNT(j)  (256  + 64 * (j))
#define XB_XSUB(j)  (1280 + 64 * (j))
#define XB_XGEN(j)  (2304 + 64 * (j))
#define XB_TOP      3328
#define XB_TOPGEN   3392
#define XCD_BAR_WORDS 3456
#define XB_SPIN_CAP (1u << 18)

__device__ __forceinline__ unsigned xb_ld(unsigned* p)              { return __hip_atomic_load(p, __ATOMIC_RELAXED, __HIP_MEMORY_SCOPE_AGENT); }
__device__ __forceinline__ unsigned xb_add(unsigned* p, unsigned v) { return __hip_atomic_fetch_add(p, v, __ATOMIC_RELAXED, __HIP_MEMORY_SCOPE_AGENT); }
__device__ __forceinline__ unsigned xb_xcc_id() { return (unsigned)__builtin_amdgcn_s_getreg((3 << 11) | 20) & 0xFu; }
#define XB_SPIN(cond, bar) do { unsigned _sp = 0; while (cond) { __builtin_amdgcn_s_sleep(1); \
    if ((++_sp & 255u) == 0u) { if (xb_ld(&(bar)[XB_TMO])) break; if (_sp > XB_SPIN_CAP) { atomicAdd(&(bar)[XB_TMO], 1u); break; } } } } while (0)

struct XcdBarrier {
    unsigned* bar; unsigned x;
    volatile LAS unsigned* st;
};

__device__ __forceinline__ XcdBarrier xcd_barrier_post(unsigned* bar, volatile LAS unsigned* st) {
    XcdBarrier b; b.bar = bar; b.x = xb_xcc_id(); b.st = st;
    if (threadIdx.x == 0) (void)xb_add(&bar[XB_XCNT(b.x)], 1u);
    return b;
}
__device__ __forceinline__ void xcd_barrier_complete(unsigned* bar, unsigned x, unsigned& nloc, unsigned& nx) {
    const unsigned G = gridDim.x * gridDim.y * gridDim.z;
    unsigned sum, cnt, mine, sp = 0u;
    for (;;) {
        sum = 0u; cnt = 0u; mine = 0u;
#pragma unroll
        for (unsigned j = 0; j < 16; ++j) { const unsigned c = xb_ld(&bar[XB_XCNT(j)]); sum += c; cnt += (c > 0u) ? 1u : 0u; mine = (j == x) ? c : mine; }
        if (sum == G) break;
        __builtin_amdgcn_s_sleep(1);
        if ((++sp & 255u) == 0u) { if (xb_ld(&bar[XB_TMO])) break; if (sp > XB_SPIN_CAP) { atomicAdd(&bar[XB_TMO], 1u); break; } }
    }
    nloc = mine > 0u ? mine : 1u; nx = cnt > 0u ? cnt : 1u;
}

__device__ __forceinline__ void xcd_barrier(const XcdBarrier& b) {
    asm volatile("s_waitcnt vmcnt(0)" ::: "memory");
    __syncthreads();
    if (threadIdx.x == 0) {
        unsigned* bar = b.bar;
        __builtin_amdgcn_s_waitcnt(0);
        unsigned nloc = b.st[0], nx = b.st[1];
        if (nloc == 0u) { xcd_barrier_complete(bar, b.x, nloc, nx); b.st[0] = nloc; b.st[1] = nx; }
        const unsigned old = xb_add(&bar[XB_XSUB(b.x)], 1u);
        const unsigned gen = old / nloc;
        if (old + 1u == (gen + 1u) * nloc) {
            __builtin_amdgcn_fence(__ATOMIC_RELEASE, "agent");
            asm volatile("s_waitcnt vmcnt(0)" ::: "memory");
            const unsigned og = xb_add(&bar[XB_TOP], 1u);
            const unsigned tg = og / nx;
            if (og + 1u == (tg + 1u) * nx) xb_add(&bar[XB_TOPGEN], 1u);
            else XB_SPIN(xb_ld(&bar[XB_TOPGEN]) == tg, bar);
            __builtin_amdgcn_fence(__ATOMIC_ACQUIRE, "agent");
            xb_add(&bar[XB_XGEN(b.x)], 1u);
            asm volatile("s_waitcnt vmcnt(0)" ::: "memory");
        } else {
            XB_SPIN(xb_ld(&bar[XB_XGEN(b.x)]) == gen, bar);
            __builtin_amdgcn_fence(__ATOMIC_ACQUIRE, "agent");
            asm volatile("s_waitcnt vmcnt(0)" ::: "memory");
        }
    }
    __syncthreads();
}

#define LAUNDER(p) asm volatile("" : "+s"(p))
struct Args { const float* in[16]; float* out; unsigned char* ws; };
#ifdef NO_GEMM
#define GEMM_RUN(EPI, Aptr, Bptr, Nn, Kk, Eobj) do { } while (0)
#define GEMM_RUN_T(EPI, Aptr, Bptr, Nn, Kk, Eobj, TAIL) do { } while (0)
#define GEMM_RUN_S(EPI, Aptr, Bptr, Nn, Kk, Eobj, TAIL, SPL) do { } while (0)
#else
#define GEMM_RUN(EPI, Aptr, Bptr, Nn, Kk, Eobj) GEMM_RUN_S(EPI, Aptr, Bptr, Nn, Kk, Eobj, true, 1)
#define GEMM_RUN_T(EPI, Aptr, Bptr, Nn, Kk, Eobj, TAIL) GEMM_RUN_S(EPI, Aptr, Bptr, Nn, Kk, Eobj, TAIL, 1)
#define GEMM_RUN_S(EPI, Aptr, Bptr, Nn, Kk, Eobj, TAIL, SPL) do { pg8::Gemm g_{(const pg8::bf16_t*)(Aptr), (const pg8::bf16_t*)(Bptr), MPAD, (Nn), (Kk)}; int bid_ = blockIdx.x; asm volatile("" : "+s"(bid_)); int G_ = gridDim.x; asm volatile("" : "+s"(G_)); pg8::StaticOrder S_; S_.init(MPAD, (Nn), (Kk), G_, bid_, (TAIL), (SPL)); \
    pg8::gemm_phase<EPI, pg8::StaticOrder, EPI::ALIGN, true>((PG8_LAS unsigned char*)lds, g_, S_, (Eobj)); } while (0)
#endif

__global__ void __launch_bounds__(NTHREADS, 2) mega_fwd(Args args) {
    extern __shared__ __attribute__((aligned(16))) unsigned char lds[];
    cg::grid_group grid = cg::this_grid();
#define FRESH() int tid = threadIdx.x; asm volatile("" : "+v"(tid)); int bid = blockIdx.x; asm volatile("" : "+s"(bid)); int G = gridDim.x; asm volatile("" : "+s"(G)); const int NGW = G * 8; \
    const int lane = tid & 63, wid = __builtin_amdgcn_readfirstlane(tid >> 6), gw = bid * 8 + wid; (void)lane; (void)gw; (void)NGW
    unsigned char* ws = args.ws;
    const float* x = args.in[0]; const float* meta = args.in[1]; const float* gains = args.in[2];
    bf16raw* OB0 = (bf16raw*)(ws + WS_H); float* RS0 = (float*)(ws + WS_H + (size_t)MPAD * DM * 2); bf16raw* U0 = (bf16raw*)(ws + WS_U);
    bf16raw* BIG0 = (bf16raw*)(ws + WS_BIG); bf16raw* MB0 = (bf16raw*)(ws + WS_MB);
    bf16raw* Wb0 = (bf16raw*)(ws + WS_W); f32x2* SUMS = (f32x2*)(ws + WS_SUM); float* CARRY = (float*)(ws + WS_CARRY); f32x2* ROPE = (f32x2*)(ws + WS_ROPE);

    {
        FRESH();
        LAS float* scr = (LAS float*)((LAS unsigned char*)lds + wid * 16384);
        bf16raw* OB = OB0; float* RS = RS0; bf16raw* U = U0; bf16raw* Wb = Wb0;
        convert_group(args.in[3], 1024, 2048, 2, Wb + WO_LRU_IN, 0, gains, 8 * DM, scr, gw, NGW, lane);
        convert_group(args.in[9], 1024, 1024, 2, Wb + WO_LRU_OUT, 0, nullptr, 0, scr, gw, NGW, lane);
        convert_group(args.in[6], 128, 128, 64, Wb + WO_GATE, 0, nullptr, 0, scr, gw, NGW, lane);
        convert_group(args.in[10], 1024, 1536, 2, Wb + WO_QKV, 2, gains + 4 * DM, 8 * DM, scr, gw, NGW, lane);
        convert_group(args.in[13], 1024, 1024, 2, Wb + WO_AO, 0, nullptr, 0, scr, gw, NGW, lane);
        convert_group(args.in[14], 1024, 5632, 4, Wb + WO_F1, 1, gains + 2 * DM, 4 * DM, scr, gw, NGW, lane);
        convert_group(args.in[15], 2816, 1024, 4, Wb + WO_F2, 0, nullptr, 0, scr, gw, NGW, lane);
        for (int i = bid * NTHREADS + tid; i < 128 * 32; i += G * NTHREADS) { const int pos = i >> 5, p = i & 31;
            const float inv_freq = (float)exp(-(double)p * (9.210340371976184 / 32.0));
            const float ang = (float)pos * inv_freq;
            double rev = (double)ang * 0.15915494309189535; rev -= floor(rev);
            ROPE[i] = (f32x2){__builtin_amdgcn_cosf((float)rev), __builtin_amdgcn_sinf((float)rev)}; }
        resid_pass(0, x, meta, nullptr, U, RS, OB, nullptr, nullptr, gw, NGW, lane);
        if (bid == 0) for (int i = tid; i < 4096; i += NTHREADS) ((unsigned*)(ws + WS_CTL))[i] = 0u;
        if (tid < 2) ((volatile LAS unsigned*)((LAS unsigned char*)lds + LDS_MISC))[tid] = 0u;
    }
    grid.sync();
    const XcdBarrier xbar = xcd_barrier_post((unsigned*)(ws + WS_CTL), (volatile LAS unsigned*)((LAS unsigned char*)lds + LDS_MISC));
#define GSYNC() xcd_barrier(xbar)

    for (int layer = 0; layer < 4; ++layer) {
        const int slot = layer >> 1; const float* gl = gains + (size_t)layer * 4 * DM;
        size_t zl = 0; asm volatile("" : "+s"(zl));
        float* TAILP = (float*)(ws + WS_TAILP) + zl;
        bf16raw* OB = OB0 + zl; float* RS = RS0 + zl; bf16raw* U = U0 + zl; bf16raw* BIG = BIG0 + zl; bf16raw* MB = MB0 + zl; bf16raw* Wb = Wb0 + zl; bf16raw* Yb = BIG; bf16raw* Xb = BIG + (size_t)MPAD * DM;
        if ((layer & 1) == 0) {
            { EpiLruIn E{Yb, Xb, RS}; GEMM_RUN(EpiLruIn, U, Wb + WO_LRU_IN + (size_t)slot * 2048 * 1024, 2048, 1024, E); }
            GSYNC();
#ifndef NO_LRU
            { FRESH(); lru_pass<false>((LAS unsigned char*)lds, slot, Wb + WO_GATE, Xb, Yb, args.in[4], args.in[5], args.in[7], args.in[8], SUMS, CARRY, G, bid, tid, wid, lane); }
            GSYNC();
            { FRESH(); lru_carry((LAS unsigned char*)lds, SUMS, CARRY, G, bid, wid, lane); }
            GSYNC();
            { FRESH(); lru_pass<true>((LAS unsigned char*)lds, slot, Wb + WO_GATE, Xb, Yb, args.in[4], args.in[5], args.in[7], args.in[8], SUMS, CARRY, G, bid, tid, wid, lane); }
#endif
            GSYNC();
        } else {
            { EpiQkv E{BIG, RS, args.in[11] + slot * 128, args.in[12] + slot * 128, ROPE, (LAS float*)((LAS unsigned char*)lds + 131072)}; GEMM_RUN(EpiQkv, U, Wb + WO_QKV + (size_t)slot * 1536 * 1024, 1536, 1024, E); }
            GSYNC();
#ifndef NO_ATT
            { int bid = blockIdx.x; asm volatile("" : "+s"(bid)); int G = gridDim.x; asm volatile("" : "+s"(G));
              int tq = threadIdx.x; asm volatile("" : "+v"(tq));
#define ATT_IDS() int tq_ = threadIdx.x; asm volatile("" : "+v"(tq_)); const int qw = tq_ >> 6, qr32 = tq_ & 31, qhi = (tq_ >> 5) & 1
              bool fixed_ok;
              { const float* qg_ = args.in[11] + slot * 128; const float* kg_ = args.in[12] + slot * 128; const int l_ = tq & 63;
                float bq = fmaxf(fabsf(qg_[l_]), fabsf(qg_[l_ + 64])), bk = fmaxf(fabsf(kg_[l_]), fabsf(kg_[l_ + 64]));
#pragma unroll
                for (int o_ = 1; o_ < 64; o_ <<= 1) { bq = fmaxf(bq, __shfl_xor(bq, o_)); bk = fmaxf(bk, __shfl_xor(bk, o_)); }
                const float bound = 0.088388347648318440f * 1.4426950408889634f * 128.0f * bq * bk * 1.02f;
                fixed_ok = __builtin_amdgcn_readfirstlane((int)(bound <= 60.0f)) != 0; }
              float* PART = (float*)(ws + WS_SUM) + zl;
              if (layer < 3)   for (int it = bid; it < 16 * 43; it += G) { const int bk = it / 43, s = it - bk * 43, b = bk >> 1, kvh = bk & 1; const size_t rb = (size_t)b * LTOK;
                  ATT_IDS(); const int Rm = (qw * 32 + qr32) & 63, g4 = Rm >> 4, jm = Rm & 15;
                  if (fixed_ok) att::attn_unit<true, true>((const att::bf16*)(BIG + (rb + jm) * QKVD + (kvh * 4 + g4) * 128 + qhi * 8), (const att::bf16*)(BIG + (rb + 192 * s) * QKVD + 1024 + kvh * 128),
                                       (const att::bf16*)(BIG + (rb + 192 * s) * QKVD + 1280 + kvh * 128), nullptr, 3, s == 42, PART + (size_t)it * 8320, (char*)lds);
                  else att::attn_unit<true, false>((const att::bf16*)(BIG + (rb + jm) * QKVD + (kvh * 4 + g4) * 128 + qhi * 8), (const att::bf16*)(BIG + (rb + 192 * s) * QKVD + 1024 + kvh * 128),
                                       (const att::bf16*)(BIG + (rb + 192 * s) * QKVD + 1280 + kvh * 128), nullptr, 3, s == 42, PART + (size_t)it * 8320, (char*)lds); }
              for (int u = bid; u < NB * 8 * 32; u += G) { const int h = u & 7, kvh = h >> 2, qb = (u >> 3) & 31, b = u >> 8;
                  ATT_IDS(); const size_t rb = (size_t)b * LTOK, q0 = rb + NMETA + 256 * qb;
                  const int u2 = (u + G < NB * 8 * 32) ? u + G : u, h2 = u2 & 7, kvh2 = h2 >> 2; const size_t rb2 = (size_t)(u2 >> 8) * LTOK, q02 = rb2 + NMETA + 256 * ((u2 >> 3) & 31);
                  if (fixed_ok) att::attn_unit<false, true>((const att::bf16*)(BIG + (q0 + qw * 32 + qr32) * QKVD + h * 128 + qhi * 8), (const att::bf16*)(BIG + rb * QKVD + 1024 + kvh * 128),
                                        (const att::bf16*)(BIG + rb * QKVD + 1280 + kvh * 128), (att::bf16*)(OB + q0 * DM + h * 128), 129, true, nullptr, (char*)lds,
                                        (const att::bf16*)(BIG + q02 * QKVD + h2 * 128), (const att::bf16*)(BIG + rb2 * QKVD + 1024 + kvh2 * 128), (const att::bf16*)(BIG + rb2 * QKVD + 1280 + kvh2 * 128));
                  else att::attn_unit<false, false>((const att::bf16*)(BIG + (q0 + qw * 32 + qr32) * QKVD + h * 128 + qhi * 8), (const att::bf16*)(BIG + rb * QKVD + 1024 + kvh * 128),
                                        (const att::bf16*)(BIG + rb * QKVD + 1280 + kvh * 128), (att::bf16*)(OB + q0 * DM + h * 128), 129, true, nullptr, (char*)lds,
                                        (const att::bf16*)(BIG + q02 * QKVD + h2 * 128), (const att::bf16*)(BIG + rb2 * QKVD + 1024 + kvh2 * 128), (const att::bf16*)(BIG + rb2 * QKVD + 1280 + kvh2 * 128)); } }
            if (layer < 3) { GSYNC();
            { FRESH(); const float* PART = (const float*)(ws + WS_SUM) + zl; constexpr float C = 1.0f;
              for (int gt = bid * NTHREADS + tid; gt < 16 * 64 * 128; gt += G * NTHREADS) { const int bk = gt >> 13, R = (gt >> 7) & 63, d = gt & 127, b = bk >> 1, kvh = bk & 1;
                  const float* pb = PART + (size_t)bk * 43 * 8320;
                  float M = -3.0e38f;
                  for (int s = 0; s < 43; ++s) M = fmaxf(M, pb[(size_t)s * 8320 + 8192 + R * 2]);
                  float L = 0.f, O = 0.f;
                  for (int s = 0; s < 43; ++s) { const float w = __builtin_amdgcn_exp2f((pb[(size_t)s * 8320 + 8192 + R * 2] - M) * C);
                      L += w * pb[(size_t)s * 8320 + 8192 + R * 2 + 1]; O += w * pb[(size_t)s * 8320 + R * 128 + d]; }
                  const float v = O / L;
                  OB[((size_t)b * LTOK + (R & 15)) * DM + (kvh * 4 + (R >> 4)) * 128 + d] = (bf16raw)(cvt_pk(v, v) & 0xffffu); } } }
#endif
            GSYNC();
        }
        { const bf16raw* Ap = (layer & 1) ? OB : Yb; const bf16raw* Bp = (layer & 1) ? Wb + WO_AO + (size_t)slot * 1024 * 1024 : Wb + WO_LRU_OUT + (size_t)slot * 1024 * 1024;
          EpiPlain E{MB, DM, nullptr, TAILP}; GEMM_RUN_S(EpiPlain, Ap, Bp, 1024, 1024, E, true, TAIL_S); }
        GSYNC();
        { FRESH(); resid_pass(1, nullptr, nullptr, MB, U, RS, nullptr, gl + DM, nullptr, gw, NGW, lane, TAILP); }
        GSYNC();
        { EpiSwiglu E{BIG, RS}; GEMM_RUN_T(EpiSwiglu, U, Wb + WO_F1 + (size_t)layer * 5632 * 1024, 5632, 1024, E, true); }
        GSYNC();
        { EpiPlain E{MB, DM, nullptr, TAILP}; GEMM_RUN_S(EpiPlain, BIG, Wb + WO_F2 + (size_t)layer * 1024 * 2816, 1024, 2816, E, true, TAIL_S2); }
        GSYNC();
        if (layer < 3) { { FRESH(); resid_pass(1, nullptr, nullptr, MB, U, RS, nullptr, gl + 3 * DM, nullptr, gw, NGW, lane, TAILP, TAIL_S2); } GSYNC(); }
        else { FRESH(); resid_pass(2, nullptr, nullptr, MB, U, RS, nullptr, gl + 3 * DM, args.out, gw, NGW, lane, TAILP, TAIL_S2); }
    }
}

extern "C" void kernel_launch(void* const* d_in, const int* in_sizes, int n_in, void* d_out, int out_size, void* d_ws, size_t ws_size, hipStream_t stream) {
    static int grid = 0;
    if (grid == 0) {
        if (n_in != 16 || ws_size < WS_END) { fprintf(stderr, "kernel_launch: n_in %d ws %zu (need %zu)\n", n_in, ws_size, (size_t)WS_END); grid = -1; return; }
        int dev = 0, cus = 0, per_cu = 0;
        hipGetDevice(&dev); hipDeviceGetAttribute(&cus, hipDeviceAttributeMultiprocessorCount, dev);
        if (hipFuncSetAttribute((const void*)mega_fwd, hipFuncAttributeMaxDynamicSharedMemorySize, LDS_BYTES) != hipSuccess) { fprintf(stderr, "kernel_launch: hipFuncSetAttribute failed\n"); grid = -1; return; }
        if (hipOccupancyMaxActiveBlocksPerMultiprocessor(&per_cu, (const void*)mega_fwd, NTHREADS, LDS_BYTES) != hipSuccess || per_cu < 1) { fprintf(stderr, "kernel_launch: occupancy query gave %d\n", per_cu); per_cu = 1; }
        (void)hipGetLastError();
        grid = cus * per_cu;
    }
    if (grid < 0) return;
    Args a{};
    for (int i = 0; i < 16; ++i) a.in[i] = (const float*)d_in[i];
    a.out = (float*)d_out; a.ws = (unsigned char*)d_ws;
    void* kargs[] = {&a};
    hipError_t e = hipLaunchCooperativeKernel((const void*)mega_fwd, dim3(grid), dim3(NTHREADS), kargs, LDS_BYTES, stream);
    if (e != hipSuccess) fprintf(stderr, "kernel_launch: cooperative launch failed: %s (grid %d)\n", hipGetErrorString(e), grid);
}
```
